# Optimizing an MI355X kernel written in HIP

```python
import math
import jax, jax.numpy as jnp
from jax import lax
import numpy as np

D_MODEL = 1024
BATCH = 8
SEQ = 4096
DEPTH = 1

CHUNK = 64
Q_BLOCK = 128
N_DIFF_HEADS = 4
DIFF_HEAD_DIM = 64
ATTN_WIDTH = N_DIFF_HEADS * 2 * DIFF_HEAD_DIM
SSM_WIDTH = D_MODEL - ATTN_WIDTH
SSM_GROUP_CH = 16
SSM_GROUPS = SSM_WIDTH // SSM_GROUP_CH
SSM_STATE = 64
MIX_WIDTH = ATTN_WIDTH + SSM_WIDTH
IN_PROJ_WIDTH = 3 * ATTN_WIDTH + SSM_WIDTH
N_EXPERT_GROUPS = 4
EXPERTS_PER_GROUP = 8
N_EXPERTS = N_EXPERT_GROUPS * EXPERTS_PER_GROUP
INNER_TOP_K = 2
D_EXPERT = D_MODEL // 2
MOE_BLOCK = 128
LN_EPS = 1e-5
RMS_EPS = 1e-5

kernel_name = "hymba_style_diffattn_s5_hiermoe_deepnorm"


def _layernorm(x, g, b):
    xf = x.astype(jnp.float32)
    mu = jnp.mean(xf, axis=-1, keepdims=True)
    var = jnp.mean(jnp.square(xf - mu), axis=-1, keepdims=True)
    y = (xf - mu) * lax.rsqrt(var + LN_EPS) * g.astype(jnp.float32) + b.astype(jnp.float32)
    return y.astype(x.dtype)


def _lambda_init(layer_idx):
    return 0.8 - 0.6 * math.exp(-0.3 * layer_idx)


def _diff_attention(q, k, v, lam, lam_init, subln_g):
    b_, s_ = q.shape[0], q.shape[1]
    nb = s_ // Q_BLOCK
    scale = DIFF_HEAD_DIM ** -0.5
    qb = q.reshape(b_, nb, Q_BLOCK, N_DIFF_HEADS, 2, DIFF_HEAD_DIM).swapaxes(0, 1)
    k_chunk = jnp.arange(s_) // CHUNK

    def block(args):
        qi, bi = args
        sc = jnp.einsum('bqhcd,bkhcd->bhcqk', qi, k).astype(jnp.float32) * scale
        q_chunk = (bi * Q_BLOCK + jnp.arange(Q_BLOCK)) // CHUNK
        mask = k_chunk[None, :] <= q_chunk[:, None]
        sc = jnp.where(mask, sc, -jnp.inf)
        p = jax.nn.softmax(sc, axis=-1)
        attn = p[:, :, 0] - lam * p[:, :, 1]
        return jnp.einsum('bhqk,bkhe->bqhe', attn.astype(v.dtype), v)

    o = lax.map(block, (qb, jnp.arange(nb)))
    o = o.swapaxes(0, 1).reshape(b_, s_, N_DIFF_HEADS, 2 * DIFF_HEAD_DIM).astype(jnp.float32)
    o = o * lax.rsqrt(jnp.mean(jnp.square(o), axis=-1, keepdims=True) + RMS_EPS)
    o = o * subln_g.astype(jnp.float32) * (1.0 - lam_init)
    return o.reshape(b_, s_, ATTN_WIDTH).astype(q.dtype)


def _scan_op(e1, e2):
    a1, b1 = e1
    a2, b2 = e2
    return a1 * a2, a2 * b1 + b2


def _s5_mixer(u, a_re, a_im, log_dt, b_re, b_im, c_re, c_im, d, w_glu, b_glu):
    b_, s_ = u.shape[0], u.shape[1]
    nc = s_ // CHUNK
    f32 = jnp.float32
    uf = u.astype(f32).reshape(b_, nc, CHUNK, SSM_GROUPS, SSM_GROUP_CH).swapaxes(0, 1)
    lam = lax.complex(a_re.astype(f32), a_im.astype(f32))
    dt = jnp.exp(log_dt.astype(f32))[:, None]
    lam_bar = jnp.exp(lam * dt)
    b_bar = ((lam_bar - 1.0) / lam)[..., None] * lax.complex(b_re.astype(f32), b_im.astype(f32))
    c = lax.complex(c_re.astype(f32), c_im.astype(f32))
    dd = d.astype(f32)

    def step(h_prev, u_c):
        bu = jnp.einsum('gpc,bsgc->bsgp', b_bar, u_c.astype(jnp.complex64))
        a = jnp.broadcast_to(lam_bar, bu.shape)
        a_cum, h_loc = lax.associative_scan(_scan_op, (a, bu), axis=1)
        h = a_cum * h_prev[:, None] + h_loc
        y = jnp.real(jnp.einsum('gcp,bsgp->bsgc', c, h)) + dd * u_c
        return h[:, -1], y

    h0 = jnp.zeros((b_, SSM_GROUPS, SSM_STATE), jnp.complex64)
    _, y = lax.scan(step, h0, uf)
    y = y.swapaxes(0, 1).reshape(b_, s_, SSM_WIDTH)
    z = jax.nn.gelu(y)
    z = z * jax.nn.sigmoid(z @ w_glu.astype(f32) + b_glu.astype(f32))
    return z.astype(u.dtype)


def _hier_moe(h2d, w_rg, w_re, w_gate, w_up, w_down):
    t = h2d.shape[0]
    tk = t * INNER_TOP_K
    g_prob = jax.nn.softmax((h2d @ w_rg).astype(jnp.float32), axis=-1)
    g_p, g_idx = lax.top_k(g_prob, 1)
    e_logits = (h2d @ w_re).astype(jnp.float32).reshape(t, N_EXPERT_GROUPS, EXPERTS_PER_GROUP)
    e_logits = jnp.take_along_axis(e_logits, g_idx[:, :, None], axis=1)[:, 0]
    e_prob = jax.nn.softmax(e_logits, axis=-1)
    p2, i2 = lax.top_k(e_prob, INNER_TOP_K)
    p2 = p2 / jnp.sum(p2, axis=-1, keepdims=True)
    expert = g_idx * EXPERTS_PER_GROUP + i2
    weight = g_p * p2

    flat_e = expert.reshape(-1)
    flat_tok = jnp.repeat(jnp.arange(t, dtype=jnp.int32), INNER_TOP_K)
    flat_w = weight.reshape(-1)
    order = jnp.argsort(flat_e, stable=True)
    se = flat_e[order]
    counts = jnp.bincount(flat_e, length=N_EXPERTS)
    starts = jnp.cumsum(counts) - counts
    pcounts = (counts + MOE_BLOCK - 1) // MOE_BLOCK * MOE_BLOCK
    pends = jnp.cumsum(pcounts)
    pstarts = pends - pcounts
    dest = pstarts[se] + jnp.arange(tk) - starts[se]
    n_rows = tk + N_EXPERTS * MOE_BLOCK
    n_blocks = n_rows // MOE_BLOCK
    row_tok = jnp.zeros((n_rows,), jnp.int32).at[dest].set(flat_tok[order])
    row_w = jnp.zeros((n_rows,), jnp.float32).at[dest].set(flat_w[order])
    block_e = jnp.minimum(jnp.searchsorted(pends, jnp.arange(n_blocks) * MOE_BLOCK, side='right'),
                          N_EXPERTS - 1)

    def block_fn(args):
        tok, w, e = args
        xb = h2d[tok]
        hid = jax.nn.silu(xb @ w_gate[e]) * (xb @ w_up[e])
        yb = hid @ w_down[e]
        return yb * w[:, None].astype(yb.dtype)

    ys = lax.map(block_fn, (row_tok.reshape(n_blocks, MOE_BLOCK),
                            row_w.reshape(n_blocks, MOE_BLOCK), block_e))
    out = jnp.zeros_like(h2d).at[row_tok].add(ys.reshape(n_rows, -1).astype(h2d.dtype))
    return out


def setup_inputs(seed: int = 0) -> dict:
    key = jax.random.key(seed)
    ks = jax.random.split(key, 32)
    L = DEPTH
    beta = (8.0 * DEPTH) ** -0.25
    f32 = jnp.float32

    def nrm(k, shape, scale):
        return jax.random.normal(k, shape, f32) * scale

    a_im_base = jnp.pi * jnp.arange(SSM_STATE, dtype=f32)
    return {
        "x": nrm(ks[0], (BATCH, SEQ, D_MODEL), 1.0),
        "w_in": nrm(ks[1], (L, D_MODEL, IN_PROJ_WIDTH), D_MODEL ** -0.5),
        "lam_q1": nrm(ks[2], (L, DIFF_HEAD_DIM), 0.1),
        "lam_k1": nrm(ks[3], (L, DIFF_HEAD_DIM), 0.1),
        "lam_q2": nrm(ks[4], (L, DIFF_HEAD_DIM), 0.1),
        "lam_k2": nrm(ks[5], (L, DIFF_HEAD_DIM), 0.1),
        "subln_g": 1.0 + nrm(ks[6], (L, 2 * DIFF_HEAD_DIM), 0.02),
        "ssm_a_re": -0.5 + nrm(ks[7], (L, SSM_GROUPS, SSM_STATE), 0.01),
        "ssm_a_im": a_im_base + nrm(ks[8], (L, SSM_GROUPS, SSM_STATE), 0.01),
        "ssm_log_dt": jax.random.uniform(ks[9], (L, SSM_GROUPS), f32, math.log(1e-3), math.log(1e-1)),
        "ssm_b_re": nrm(ks[10], (L, SSM_GROUPS, SSM_STATE, SSM_GROUP_CH), (2 * SSM_GROUP_CH) ** -0.5),
        "ssm_b_im": nrm(ks[11], (L, SSM_GROUPS, SSM_STATE, SSM_GROUP_CH), (2 * SSM_GROUP_CH) ** -0.5),
        "ssm_c_re": nrm(ks[12], (L, SSM_GROUPS, SSM_GROUP_CH, SSM_STATE), SSM_STATE ** -0.5),
        "ssm_c_im": nrm(ks[13], (L, SSM_GROUPS, SSM_GROUP_CH, SSM_STATE), SSM_STATE ** -0.5),
        "ssm_d": nrm(ks[14], (L, SSM_GROUPS, SSM_GROUP_CH), 1.0),
        "w_glu": nrm(ks[15], (L, SSM_WIDTH, SSM_WIDTH), SSM_WIDTH ** -0.5),
        "b_glu": nrm(ks[16], (L, SSM_WIDTH), 0.01),
        "w_out": nrm(ks[17], (L, MIX_WIDTH, D_MODEL), MIX_WIDTH ** -0.5 * beta),
        "ln1_g": 1.0 + nrm(ks[18], (L, D_MODEL), 0.02),
        "ln1_b": nrm(ks[19], (L, D_MODEL), 0.01),
        "w_router_group": nrm(ks[20], (L, D_MODEL, N_EXPERT_GROUPS), D_MODEL ** -0.5),
        "w_router_expert": nrm(ks[21], (L, D_MODEL, N_EXPERTS), D_MODEL ** -0.5),
        "w_exp_gate": nrm(ks[22], (L, N_EXPERTS, D_MODEL, D_EXPERT), D_MODEL ** -0.5),
        "w_exp_up": nrm(ks[23], (L, N_EXPERTS, D_MODEL, D_EXPERT), D_MODEL ** -0.5),
        "w_exp_down": nrm(ks[24], (L, N_EXPERTS, D_EXPERT, D_MODEL), D_EXPERT ** -0.5 * beta),
        "ln2_g": 1.0 + nrm(ks[25], (L, D_MODEL), 0.02),
        "ln2_b": nrm(ks[26], (L, D_MODEL), 0.01),
    }


def reference(x, w_in, lam_q1, lam_k1, lam_q2, lam_k2, subln_g, ssm_a_re, ssm_a_im, ssm_log_dt,
              ssm_b_re, ssm_b_im, ssm_c_re, ssm_c_im, ssm_d, w_glu, b_glu, w_out, ln1_g, ln1_b,
              w_router_group, w_router_expert, w_exp_gate, w_exp_up, w_exp_down, ln2_g, ln2_b):
    alpha = (2.0 * DEPTH) ** 0.25
    b_, s_, d_ = x.shape
    for i in range(DEPTH):
        proj = x @ w_in[i]
        q, k, v, u = jnp.split(proj, [ATTN_WIDTH, 2 * ATTN_WIDTH, 3 * ATTN_WIDTH], axis=-1)
        q = q.reshape(b_, s_, N_DIFF_HEADS, 2, DIFF_HEAD_DIM)
        k = k.reshape(b_, s_, N_DIFF_HEADS, 2, DIFF_HEAD_DIM)
        v = v.reshape(b_, s_, N_DIFF_HEADS, 2 * DIFF_HEAD_DIM)
        lam_init = _lambda_init(i)
        lam = (jnp.exp(jnp.sum(lam_q1[i].astype(jnp.float32) * lam_k1[i].astype(jnp.float32)))
               - jnp.exp(jnp.sum(lam_q2[i].astype(jnp.float32) * lam_k2[i].astype(jnp.float32)))
               + lam_init)
        a_out = _diff_attention(q, k, v, lam, lam_init, subln_g[i])
        s_out = _s5_mixer(u, ssm_a_re[i], ssm_a_im[i], ssm_log_dt[i], ssm_b_re[i], ssm_b_im[i],
                          ssm_c_re[i], ssm_c_im[i], ssm_d[i], w_glu[i], b_glu[i])
        mix = jnp.concatenate([a_out, s_out], axis=-1) @ w_out[i]
        h = _layernorm(alpha * x + mix, ln1_g[i], ln1_b[i])
        moe = _hier_moe(h.reshape(b_ * s_, d_), w_router_group[i], w_router_expert[i],
                        w_exp_gate[i], w_exp_up[i], w_exp_down[i]).reshape(b_, s_, d_)
        x = _layernorm(alpha * h + moe, ln2_g[i], ln2_b[i])
    return x
```

```cpp
#include <hip/hip_runtime.h>
#include <cstdio>
#include <cstdint>
#include <cmath>

#ifndef MK_N_LAUNCHES
#define MK_N_LAUNCHES 1
#endif
#ifndef PROBE_DUP
#define PROBE_DUP (-1)
#endif

constexpr int BATCH = 8, SEQ = 4096, DM = 1024, TOK = BATCH * SEQ;
constexpr int NPROJ = 2048, QKV_PITCH = 1536;
constexpr int NGRP = 32, GCH = 16, NSTATE = 64, SSMW = 512;
constexpr int NEXP = 32, DEXP = 512;
constexpr int UP_PITCH = 1280;
constexpr float LN_EPS = 1e-5f, RMS_EPS = 1e-5f;
constexpr float ALPHA = 1.189207115002721f;
constexpr float QSCALE = 0.125f * 1.4426950408889634f;
constexpr float LAM_INIT = 0.2f;
constexpr int MOE_MAXTILES = 288;
constexpr int MOE_MAXROWS = MOE_MAXTILES * 256;

constexpr size_t MiB = 1u << 20;
constexpr size_t WS_CTL = 0, CTL_ZERO_BYTES = 64 * 1024;
constexpr size_t WS_STATS = 1 * MiB;
constexpr size_t WS_LAMB = 7 * MiB + 512 * 1024;
constexpr size_t WS_WIN_T = 8 * MiB;
constexpr size_t WS_WOUT_T = 12 * MiB;
constexpr size_t WS_WGLU_T = 14 * MiB;
constexpr size_t WS_WG1 = 24 * MiB;
constexpr size_t WS_WD = 88 * MiB;
constexpr size_t WS_TOEP = 120 * MiB;
constexpr size_t WS_HB = 120 * MiB;
constexpr size_t WS_WSIN = 200 * MiB;
constexpr size_t WS_ESLOT = 200 * MiB;
constexpr size_t WS_EW = 208 * MiB;
constexpr size_t WS_XB = 216 * MiB;
constexpr size_t WS_PROJ = 280 * MiB;
constexpr size_t WS_UPERM = 376 * MiB;
constexpr size_t WS_PREB = 280 * MiB;
constexpr size_t WS_Y2 = 280 * MiB;
constexpr size_t WS_Z = 416 * MiB;
constexpr size_t WS_CAT = 448 * MiB;
constexpr size_t WS_HID = 416 * MiB;
constexpr size_t WS_END = 512 * MiB;
static_assert(WS_Y2 + (size_t)(65536 + 256) * 1024 * 2 <= WS_Z && WS_TOEP + (size_t)32 * 1024 * UP_PITCH * 2 <= WS_WSIN && WS_XB + (size_t)TOK * DM * 2 <= WS_PROJ && WS_PROJ + (size_t)TOK * 1536 * 2 <= WS_UPERM, "ws map");
static_assert(WS_HID + (size_t)MOE_MAXROWS * 512 * 2 <= WS_END, "HID overlay");
static_assert(WS_UPERM + (size_t)32 * 512 * UP_PITCH * 2 <= WS_Z, "UPERM");
constexpr int CW_TMO = 0, CW_CODE = 1;
constexpr int CW_GCNT = 64;
constexpr int CW_TAILCNT = 128;
constexpr int CW_BAR = 4096;

constexpr int RING_BYTES = 131072;
constexpr int LDSCTL_OFF = RING_BYTES, MISC_OFF = LDSCTL_OFF + 320, TILE_E_OFF = LDSCTL_OFF + 512;
constexpr int LDS_BYTES = 147456;

#define GAS __attribute__((address_space(1)))
#define LAS __attribute__((address_space(3)))
typedef unsigned short bf16;
typedef unsigned v4u __attribute__((ext_vector_type(4)));
typedef unsigned v2u __attribute__((ext_vector_type(2)));
typedef float f32x4 __attribute__((ext_vector_type(4)));
typedef float f32x2 __attribute__((ext_vector_type(2)));
typedef float f32x16 __attribute__((ext_vector_type(16)));
typedef short bf16x8 __attribute__((ext_vector_type(8)));
typedef short s16x4 __attribute__((ext_vector_type(4)));
typedef _Float16 f16x8 __attribute__((ext_vector_type(8)));
typedef __bf16 bf16x2_t __attribute__((ext_vector_type(2)));
typedef GAS unsigned gu32;
#define RLX_AGENT __ATOMIC_RELAXED, __HIP_MEMORY_SCOPE_AGENT
#define LDS_WAIT() asm volatile("s_waitcnt lgkmcnt(0)" ::: "memory")
#define VM_WAIT() asm volatile("s_waitcnt vmcnt(0)" ::: "memory")

__device__ __forceinline__ unsigned cvtpk(float lo, float hi) { f32x2 v = {lo, hi}; bf16x2_t b = __builtin_convertvector(v, bf16x2_t); return __builtin_bit_cast(unsigned, b); }
__device__ __forceinline__ float bf_lo(unsigned w) { return __uint_as_float(w << 16); }
__device__ __forceinline__ float bf_hi(unsigned w) { return __uint_as_float(w & 0xffff0000u); }
__device__ __forceinline__ float fexp2(float x) { return __builtin_amdgcn_exp2f(x); }
__device__ __forceinline__ float frcp(float x) { return __builtin_amdgcn_rcpf(x); }
__device__ __forceinline__ float sigmoidf_(float x) { return frcp(1.0f + fexp2(-1.4426950408889634f * x)); }
__device__ __forceinline__ float gelu_tanh(float y) { const float t = y * (1.0f + 0.044715f * y * y) * (-2.302208198f); return y * frcp(1.0f + fexp2(t)); }
__device__ __forceinline__ float wave_sum(float v) {
#pragma unroll
    for (int o = 1; o < 64; o <<= 1) v += __shfl_xor(v, o);
    return v;
}

namespace pg8 {
#define PG8_LAS __attribute__((address_space(3)))
constexpr int BM = 256, BK = 64, HALF = 128, HTB = HALF * BK * 2, STAGE_BYTES = 8 * HTB, NXCD = 8, WGM = 8;
__host__ __device__ __forceinline__ int lds_byte(int r, int c) { const int st = (r >> 4) * 2 + (c >> 5), rr = r & 15, cc = c & 31, ob = rr * 64 + cc * 2; return st * 1024 + (ob ^ (((ob >> 9) & 1) << 5)); }
__host__ __device__ __forceinline__ void stage_rc(int b, int& R, int& C) { const int st = b / 1024, sb = b % 1024, swz = sb ^ (((sb >> 9) & 1) << 5); R = (st >> 1) * 16 + swz / 64; C = (st & 1) * 32 + (swz % 64) / 2; }
__host__ __device__ __forceinline__ int perm32(int rho) { const int n = rho >> 4, i = rho & 15; return 8 * (i >> 2) + 4 * n + (i & 3); }

struct Unit { int pm, pn, aux; };

struct DenseOrder {
    static constexpr bool GATHER = false, KMAP = false;
    __device__ __forceinline__ int nt() const { return 0; }
    __device__ __forceinline__ size_t koff(int t) const { return (size_t)t * 128; }
    __device__ __forceinline__ bool half(const Unit&) const { return false; }
    const char* A; const char* Bt; int lda, ldb; int nM, nN, nwg, G, c;
    __device__ void init(const void* A_, const void* Bt_, int lda_, int ldb_, int M, int N, int G_, int c_) { A = (const char*)A_; Bt = (const char*)Bt_; lda = lda_; ldb = ldb_; nM = M / BM; nN = N / BM; nwg = nM * nN; G = G_; c = c_; }
    __device__ bool next(int i, Unit& u) const {
        const long L = (long)i * G + c; if (L >= nwg) return false;
        int wgid = (int)L; { const int q = nwg / NXCD, r = nwg % NXCD, xcd = wgid % NXCD, off = wgid / NXCD; wgid = (xcd < r ? xcd * (q + 1) : r * (q + 1) + (xcd - r) * q) + off; }
        const int nig = WGM * nN, gid = wgid / nig, fm = gid * WGM, gsz = (nM - fm) < WGM ? (nM - fm) : WGM;
        u.pm = fm + ((wgid % nig) % gsz); u.pn = (wgid % nig) / gsz; u.aux = 0; return true;
    }
    __device__ __forceinline__ const char* a_ptr(const Unit& u) const { return A + (size_t)u.pm * BM * lda * 2; }
    __device__ __forceinline__ const char* b_ptr(const Unit& u) const { return Bt + (size_t)u.pn * BM * ldb * 2; }
    __device__ __forceinline__ void gather(const Unit&, const int*, const int*, unsigned*, unsigned*) const {}
};
struct OneUnit {
    static constexpr bool GATHER = false, KMAP = false;
    __device__ __forceinline__ int nt() const { return 0; }
    __device__ __forceinline__ size_t koff(int t) const { return (size_t)t * 128; }
    __device__ __forceinline__ bool half(const Unit&) const { return false; }
    const char* A; const char* Bt; Unit u0;
    __device__ bool next(int i, Unit& u) const { if (i > 0) return false; u = u0; return true; }
    __device__ __forceinline__ const char* a_ptr(const Unit&) const { return A; }
    __device__ __forceinline__ const char* b_ptr(const Unit&) const { return Bt; }
    __device__ __forceinline__ void gather(const Unit&, const int*, const int*, unsigned*, unsigned*) const {}
};
struct SsmUnit {
    static constexpr bool GATHER = false, KMAP = true;
    const char* A; const char* Bt; Unit u0; int first, cnt, st;
    __device__ bool next(int i, Unit& u) const { if (i > 0) return false; u = u0; return true; }
    __device__ __forceinline__ const char* a_ptr(const Unit&) const { return A; }
    __device__ __forceinline__ const char* b_ptr(const Unit&) const { return Bt; }
    __device__ __forceinline__ void gather(const Unit&, const int*, const int*, unsigned*, unsigned*) const {}
    __device__ __forceinline__ int nt() const { return cnt + 2; }
    __device__ __forceinline__ bool half(const Unit&) const { return false; }
    __device__ __forceinline__ size_t koff(int t) const { return (size_t)((t < cnt) ? first + t : st + (t - cnt)) * 128; }
};
template <bool GATHER_> struct MoeOrder {
    static constexpr bool GATHER = GATHER_, KMAP = false;
    __device__ __forceinline__ int nt() const { return 0; }
    __device__ __forceinline__ size_t koff(int t) const { return (size_t)t * 128; }
    const char* A; const char* W; const int* eslot; const PG8_LAS int* tile_e; const PG8_LAS int* ecnt; int ntiles, G, c, lda, ldb, lt_lim;
    __device__ bool next(int i, Unit& u) const { const int x = c & 7, j = c >> 3, per = G >> 5;
        const int chunk = (ntiles + 7) >> 3; const int lt = i * per + (j >> 2); const int rt = x * chunk + lt;
        if ((j >> 2) >= per || lt >= chunk || lt >= lt_lim || rt >= ntiles) return false; u.pm = rt; u.pn = j & 3; u.aux = tile_e[rt]; return true; }
    __device__ __forceinline__ bool half(const Unit& u) const { return ecnt[u.aux & 255] - (u.aux >> 8) * BM <= HALF; }
    __device__ __forceinline__ const char* a_ptr(const Unit& u) const { return GATHER_ ? A : A + (size_t)u.pm * BM * lda * 2; }
    __device__ __forceinline__ const char* b_ptr(const Unit& u) const { return W + ((size_t)(u.aux & 255) * 1024 + (size_t)u.pn * BM) * ldb * 2; }
    __device__ __forceinline__ void gather(const Unit& u, const int* RA, const int* CA, unsigned* v0, unsigned* v1) const {
        const int e = u.aux & 255, r0 = (u.aux >> 8) * BM, cnt = ecnt[e];
#pragma unroll
        for (int i = 0; i < 2; ++i) { const int i0 = r0 + RA[i], i1 = i0 + HALF;
            const int t0 = (i0 < cnt) ? (eslot[e * 65536 + i0] >> 1) : 0, t1 = (i1 < cnt) ? (eslot[e * 65536 + i1] >> 1) : 0;
            v0[i] = (unsigned)(t0 * lda + CA[i]) * 2u; v1[i] = (unsigned)(t1 * lda + CA[i]) * 2u; }
    }
};

template <bool GATHER_> struct MoeUnits {
    static constexpr bool GATHER = GATHER_, KMAP = false;
    __device__ __forceinline__ int nt() const { return 0; }
    __device__ __forceinline__ size_t koff(int t) const { return (size_t)t * 128; }
    const char* A; const char* W; const int* eslot; const PG8_LAS int* tile_e; const PG8_LAS int* ecnt; int tile0, u_lo, u_hi, lda, ldb;
    __device__ bool next(int i, Unit& u) const { const int q = u_lo + i; if (q >= u_hi) return false; u.pm = tile0 + (q >> 2); u.pn = q & 3; u.aux = tile_e[u.pm]; return true; }
    __device__ __forceinline__ bool half(const Unit& u) const { return ecnt[u.aux & 255] - (u.aux >> 8) * BM <= HALF; }
    __device__ __forceinline__ const char* a_ptr(const Unit& u) const { return GATHER_ ? A : A + (size_t)u.pm * BM * lda * 2; }
    __device__ __forceinline__ const char* b_ptr(const Unit& u) const { return W + ((size_t)(u.aux & 255) * 1024 + (size_t)u.pn * BM) * ldb * 2; }
    __device__ __forceinline__ void gather(const Unit& u, const int* RA, const int* CA, unsigned* v0, unsigned* v1) const {
        const int e = u.aux & 255, r0 = (u.aux >> 8) * BM, cnt = ecnt[e];
#pragma unroll
        for (int i = 0; i < 2; ++i) { const int i0 = r0 + RA[i], i1 = i0 + HALF;
            const int t0 = (i0 < cnt) ? (eslot[e * 65536 + i0] >> 1) : 0, t1 = (i1 < cnt) ? (eslot[e * 65536 + i1] >> 1) : 0;
            v0[i] = (unsigned)(t0 * lda + CA[i]) * 2u; v1[i] = (unsigned)(t1 * lda + CA[i]) * 2u; }
    }
};

struct MoeRounds {
    static constexpr bool GATHER = false, KMAP = false;
    __device__ __forceinline__ int nt() const { return 0; }
    __device__ __forceinline__ size_t koff(int t) const { return (size_t)t * 128; }
    const char* A; const char* W; const PG8_LAS int* tile_e; const PG8_LAS int* ecnt; int tile0, j, E, sA, sB, r_lo, r_hi, lda, ldb;
    __device__ __forceinline__ int lt_of(int r) const { const int s = r < E - 1 ? 0 : (r == E - 1 ? sA : sB); const int base = r < E ? 8 * r : 8 * (E - 1) + ((32 - sA) >> 2); return base + ((j - s) >> 2); }
    __device__ bool next(int i, Unit& u) const { const int r = r_lo + i; if (r >= r_hi) return false; const int s = r < E - 1 ? 0 : (r == E - 1 ? sA : sB);
        u.pm = tile0 + lt_of(r); u.pn = (j - s) & 3; u.aux = tile_e[u.pm]; return true; }
    __device__ __forceinline__ bool half(const Unit& u) const { return ecnt[u.aux & 255] - (u.aux >> 8) * BM <= HALF; }
    __device__ __forceinline__ const char* a_ptr(const Unit& u) const { return A + (size_t)u.pm * BM * lda * 2; }
    __device__ __forceinline__ const char* b_ptr(const Unit& u) const { return W + ((size_t)(u.aux & 255) * 1024 + (size_t)u.pn * BM) * ldb * 2; }
    __device__ __forceinline__ void gather(const Unit&, const int*, const int*, unsigned*, unsigned*) const {}
};

template <class Epi, class Sched, bool ALIGN_EPI>
__device__ __forceinline__ void gemm_phase(PG8_LAS unsigned char* lds, const int K, const int lda, const int ldb, const Sched& S, const Epi& E) {
    int tid = threadIdx.x; asm volatile("" : "+v"(tid));
    const int wid = __builtin_amdgcn_readfirstlane(tid >> 6), lane = tid & 63, wr = wid >> 2, wc = wid & 3, fr = lane & 15, fq = lane >> 4;
    int nt = K / BK; if constexpr (Sched::KMAP) nt = S.nt();
#define PG8_KOFF(t) (Sched::KMAP ? S.koff(t) : (size_t)(t) * kstep)
    unsigned vA0[2], vA1[2], nvA0[2], nvA1[2], voffB[2]; int RA[2], CA[2];
#pragma unroll
    for (int i = 0; i < 2; ++i) { int R, C; stage_rc(tid * 16 + i * 8192, R, C); const int Rb = Epi::PERM ? ((R & ~31) + perm32(R & 31)) : R;
        RA[i] = R; CA[i] = C; vA0[i] = (unsigned)(R * lda + C) * 2u; vA1[i] = (unsigned)((R + HALF) * lda + C) * 2u; voffB[i] = (unsigned)(Rb * ldb + C) * 2u; nvA0[i] = vA0[i]; nvA1[i] = vA1[i]; }
    const size_t kstep = (size_t)(BK * 2);
    const size_t hstepB = (size_t)HALF * ldb * 2;
    const unsigned ldsw = (unsigned)wid * 1024u;
    const int aoff = lds_byte(wr * 64 + fr, fq * 8), boff = lds_byte(wc * 32 + fr, fq * 8);
#define PG8_SA(b, h) (((b) * 2 + (h)) * HTB)
#define PG8_SB(b, h) ((4 + (b) * 2 + (h)) * HTB)
#define PG8_STAGE2(bufoff, gbase, o0, o1) do { \
        __builtin_amdgcn_global_load_lds((const unsigned*)((const char*)(gbase) + (o0)), (PG8_LAS unsigned*)(lds + (bufoff) + ldsw), 16, 0, 0); \
        __builtin_amdgcn_global_load_lds((const unsigned*)((const char*)(gbase) + (o1)), (PG8_LAS unsigned*)(lds + (bufoff) + ldsw + 8192), 16, 0, 0); } while (0)
#define PG8_STAGEB(bufoff, gbase) PG8_STAGE2(bufoff, gbase, voffB[0], voffB[1])
#define PG8_LDA(dst, b, h) do { _Pragma("unroll") for (int m = 0; m < 4; ++m) _Pragma("unroll") for (int k = 0; k < 2; ++k) dst[m][k] = *(const PG8_LAS bf16x8*)(lds + PG8_SA(b, h) + aoff + m * 2048 + k * 1024); } while (0)
#define PG8_LDB(dst, b, h) do { _Pragma("unroll") for (int n = 0; n < 2; ++n) _Pragma("unroll") for (int k = 0; k < 2; ++k) dst[n][k] = *(const PG8_LAS bf16x8*)(lds + PG8_SB(b, h) + boff + n * 2048 + k * 1024); } while (0)
#define PG8_MMA(ai, bj, At, Bt) do { __builtin_amdgcn_s_setprio(1); _Pragma("unroll") for (int m = 0; m < 4; ++m) _Pragma("unroll") for (int n = 0; n < 2; ++n) _Pragma("unroll") for (int k = 0; k < 2; ++k) \
        acc[ai][bj][m][n] = __builtin_amdgcn_mfma_f32_16x16x32_bf16(Bt[n][k], At[m][k], acc[ai][bj][m][n], 0, 0, 0); __builtin_amdgcn_s_setprio(0); } while (0)
#define PG8_WAIT_V(n) asm volatile("s_waitcnt vmcnt(" #n ")" ::: "memory")
#define PG8_WAIT_L(n) asm volatile("s_waitcnt lgkmcnt(" #n ")" ::: "memory")
#define PG8_BAR __builtin_amdgcn_s_barrier()
#define PG8_SCHED __builtin_amdgcn_sched_barrier(0)
    Unit cur, nxt; int ui = 0;
    if (!S.next(0, cur)) return;
    if constexpr (Sched::GATHER) S.gather(cur, RA, CA, vA0, vA1);
    bool halfu = S.half(cur);
    f32x4 acc[2][2][4][2];
#pragma unroll
    for (int a = 0; a < 2; ++a)
#pragma unroll
        for (int b = 0; b < 2; ++b)
#pragma unroll
            for (int m = 0; m < 4; ++m)
#pragma unroll
                for (int n = 0; n < 2; ++n) acc[a][b][m][n] = (f32x4){0.f, 0.f, 0.f, 0.f};
    bf16x8 At[4][2], B0[2][2], B1[2][2];
    const char* cA = S.a_ptr(cur); const char* cB = S.b_ptr(cur);
    { const size_t k0_ = PG8_KOFF(0), k1_ = PG8_KOFF(1);
    PG8_STAGEB(PG8_SB(0, 0), cB + k0_); PG8_STAGEB(PG8_SB(0, 1), cB + hstepB + k0_); PG8_STAGE2(PG8_SA(0, 0), cA + k0_, vA0[0], vA0[1]); PG8_STAGE2(PG8_SA(0, 1), cA + k0_, vA1[0], vA1[1]);
    if (wr == 1) PG8_BAR;
    PG8_WAIT_V(2); PG8_BAR;
    PG8_STAGEB(PG8_SB(1, 0), cB + k1_); PG8_STAGE2(PG8_SA(1, 0), cA + k1_, vA0[0], vA0[1]); PG8_STAGEB(PG8_SB(1, 1), cB + hstepB + k1_); }
    PG8_WAIT_V(6); PG8_BAR;
    for (;;) {
        const bool has_next = S.next(ui + 1, nxt);
        const char* nA = has_next ? S.a_ptr(nxt) : cA; const char* nB = has_next ? S.b_ptr(nxt) : cB;
        if constexpr (Sched::GATHER) { if (has_next) S.gather(nxt, RA, CA, nvA0, nvA1); else { nvA0[0] = vA0[0]; nvA0[1] = vA0[1]; nvA1[0] = vA1[0]; nvA1[1] = vA1[1]; } }
        for (int t = 0; t < nt; t += 2) {
            const bool last = (t == nt - 2);
            const size_t k1_ = PG8_KOFF(t + 1), k2_ = last ? PG8_KOFF(0) : PG8_KOFF(t + 2), k3_ = last ? PG8_KOFF(1) : PG8_KOFF(t + 3);
            const char* a1 = cA + k1_;
            const char* a2 = (last ? nA : cA) + k2_; const char* b2 = (last ? nB : cB) + k2_;
            const char* a3 = (last ? nA : cA) + k3_; const char* b3 = (last ? nB : cB) + k3_;
            unsigned s00 = vA0[0], s01 = vA0[1], s10 = vA1[0], s11 = vA1[1];
            if constexpr (Sched::GATHER) { if (last) { s00 = nvA0[0]; s01 = nvA0[1]; s10 = nvA1[0]; s11 = nvA1[1]; } }
            PG8_LDB(B0, 0, 0); PG8_LDB(B1, 0, 1); PG8_SCHED; PG8_LDA(At, 0, 0); PG8_STAGE2(PG8_SA(1, 1), a1, vA1[0], vA1[1]);
            PG8_WAIT_V(8); PG8_WAIT_L(0); PG8_BAR; PG8_MMA(0, 0, At, B0); PG8_MMA(0, 1, At, B1); PG8_BAR; PG8_SCHED;
            PG8_LDA(At, 0, 1); PG8_STAGEB(PG8_SB(0, 0), b2); PG8_STAGEB(PG8_SB(0, 1), b2 + hstepB); PG8_STAGE2(PG8_SA(0, 0), a2, s00, s01);
            PG8_WAIT_V(8); PG8_WAIT_L(0); PG8_BAR; if (!halfu) { PG8_MMA(1, 0, At, B0); PG8_MMA(1, 1, At, B1); } PG8_BAR; PG8_SCHED;
            PG8_LDB(B0, 1, 0); PG8_LDB(B1, 1, 1); PG8_SCHED; PG8_LDA(At, 1, 0); PG8_STAGE2(PG8_SA(0, 1), a2, s10, s11);
            PG8_WAIT_V(8); PG8_WAIT_L(0); PG8_BAR; PG8_MMA(0, 0, At, B0); PG8_MMA(0, 1, At, B1); PG8_BAR; PG8_SCHED;
            PG8_LDA(At, 1, 1); PG8_STAGEB(PG8_SB(1, 0), b3); PG8_STAGEB(PG8_SB(1, 1), b3 + hstepB); PG8_STAGE2(PG8_SA(1, 0), a3, s00, s01);
            PG8_WAIT_V(8); PG8_WAIT_L(0); PG8_BAR; if (!halfu) { PG8_MMA(1, 0, At, B0); PG8_MMA(1, 1, At, B1); } PG8_BAR; PG8_SCHED;
        }
        if constexpr (ALIGN_EPI) { if (wr == 0) PG8_BAR; }
        E(acc, cur, wr, wc, fr, fq);
        if (!has_next) break;
#pragma unroll
        for (int a = 0; a < 2; ++a)
#pragma unroll
            for (int b = 0; b < 2; ++b)
#pragma unroll
                for (int m = 0; m < 4; ++m)
#pragma unroll
                    for (int n = 0; n < 2; ++n) acc[a][b][m][n] = (f32x4){0.f, 0.f, 0.f, 0.f};
        cur = nxt; cA = nA; cB = nB; ++ui; halfu = S.half(cur);
        if constexpr (Sched::GATHER) { vA0[0] = nvA0[0]; vA0[1] = nvA0[1]; vA1[0] = nvA1[0]; vA1[1] = nvA1[1]; }
        if constexpr (ALIGN_EPI) { if (wr == 1) PG8_BAR; }
    }
    PG8_WAIT_V(0);
    if constexpr (!ALIGN_EPI) { if (wr == 0) PG8_BAR; }
    PG8_BAR;
#undef PG8_KOFF
#undef PG8_SA
#undef PG8_SB
#undef PG8_STAGE2
#undef PG8_STAGEB
#undef PG8_LDA
#undef PG8_LDB
#undef PG8_MMA
#undef PG8_WAIT_V
#undef PG8_WAIT_L
#undef PG8_BAR
#undef PG8_SCHED
}

typedef f32x4 AccT[2][2][4][2];

struct EpiInProj {
    static constexpr bool PERM = true;
    bf16* q; bf16* kt; bf16* vt; bf16* uperm;
    __device__ __forceinline__ void operator()(const AccT& acc, const Unit& u, int wr, int wc, int fr, int fq) const {
        const int row0 = u.pm * BM + wr * 64 + fr; const int col0 = u.pn * BM + wc * 32 + 8 * fq;
        const float sc = (u.pn < 2) ? QSCALE : 1.0f;
#pragma unroll
        for (int ai = 0; ai < 2; ++ai)
#pragma unroll
            for (int m = 0; m < 4; ++m) { const int row = row0 + ai * HALF + m * 16; const int b = row >> 12, sq = row & 4095, tl = sq >> 6, s = sq & 63;
#pragma unroll
                for (int bj = 0; bj < 2; ++bj) { const f32x4 v0 = acc[ai][bj][m][0] * sc, v1 = acc[ai][bj][m][1] * sc; const int col = col0 + bj * HALF;
                    v4u w; w.x = cvtpk(v0[0], v0[1]); w.y = cvtpk(v0[2], v0[3]); w.z = cvtpk(v1[0], v1[1]); w.w = cvtpk(v1[2], v1[3]);
                    if (u.pn < 2) *(v4u*)(q + (size_t)row * 512 + col) = w;
                    else if (u.pn < 4) { const int ck = col - 512, h = ck >> 7, sub = (ck >> 6) & 1, ch = (ck & 63) >> 3;
                        *(v4u*)(kt + ((size_t)((((b * 4 + h) * 2 + sub) * 64 + tl) * 8 + ch) * 512 + s * 8)) = w; }
                    else if (u.pn < 6) { const int cv = col - 1024, h = cv >> 7, d0 = (cv & 127) >> 5, c16 = (cv & 31) >> 3;
                        *(v4u*)(vt + ((size_t)(((b * 4 + h) * 64 + tl) * 4 + d0) * 2048 + s * 32 + c16 * 8)) = w; }
                    else { const int cu = col - 1536, g = cu >> 4, ci0 = cu & 15;
                        *(v4u*)(uperm + ((size_t)(g * 512 + b * 64 + tl) * UP_PITCH + s * 16 + ci0)) = w; } } }
    }
};
struct EpiState {
    static constexpr bool PERM = false;
    float* sstate;
    __device__ __forceinline__ void operator()(const AccT& acc, const Unit& u, int wr, int wc, int fr, int fq) const {
        const int row0 = u.pm * BM + wr * 64 + fr; const int col0 = wc * 32 + 4 * fq;
#pragma unroll
        for (int ai = 0; ai < 2; ++ai)
#pragma unroll
            for (int m = 0; m < 4; ++m) { const int row = row0 + ai * HALF + m * 16;
#pragma unroll
                for (int bj = 0; bj < 2; ++bj)
#pragma unroll
                    for (int n = 0; n < 2; ++n) *(f32x4*)(sstate + ((size_t)(u.aux * 512 + row) * 256 + bj * HALF + col0 + n * 16)) = acc[ai][bj][m][n]; }
    }
};
struct EpiSsmOut {
    static constexpr bool PERM = true;
    const bf16* uperm; const float* dvec; bf16* z;
    __device__ __forceinline__ void operator()(const AccT& acc, const Unit& u, int wr, int wc, int fr, int fq) const {
        const int g = u.aux; const int row0 = u.pm * BM + wr * 64 + fr; const int col0 = u.pn * BM + wc * 32 + 8 * fq;
        const int co0 = col0 & 15;
        const f32x4 d0 = *(const f32x4*)(dvec + g * 16 + co0), d1 = *(const f32x4*)(dvec + g * 16 + co0 + 4);
#pragma unroll
        for (int ai = 0; ai < 2; ++ai)
#pragma unroll
            for (int m = 0; m < 4; ++m) { const int row = row0 + ai * HALF + m * 16; const int b = row >> 6, ch = row & 63;
#pragma unroll
                for (int bj = 0; bj < 2; ++bj) { const int col = col0 + bj * HALF; const int t = col >> 4;
                    const v4u uw = *(const v4u*)(uperm + ((size_t)(g * 512 + row) * UP_PITCH + col));
                    const f32x4 a0 = acc[ai][bj][m][0], a1 = acc[ai][bj][m][1];
                    float y[8];
                    y[0] = a0[0] + d0[0] * bf_lo(uw.x); y[1] = a0[1] + d0[1] * bf_hi(uw.x); y[2] = a0[2] + d0[2] * bf_lo(uw.y); y[3] = a0[3] + d0[3] * bf_hi(uw.y);
                    y[4] = a1[0] + d1[0] * bf_lo(uw.z); y[5] = a1[1] + d1[1] * bf_hi(uw.z); y[6] = a1[2] + d1[2] * bf_lo(uw.w); y[7] = a1[3] + d1[3] * bf_hi(uw.w);
#pragma unroll
                    for (int j = 0; j < 8; ++j) y[j] = gelu_tanh(y[j]);
                    v4u w; w.x = cvtpk(y[0], y[1]); w.y = cvtpk(y[2], y[3]); w.z = cvtpk(y[4], y[5]); w.w = cvtpk(y[6], y[7]);
                    *(v4u*)(z + ((size_t)(b * SEQ + ch * 64 + t) * SSMW + g * 16 + co0)) = w; } }
    }
};
struct EpiGlu {
    static constexpr bool PERM = true;
    const bf16* z; const float* bias; bf16* cat;
    __device__ __forceinline__ void operator()(const AccT& acc, const Unit& u, int wr, int wc, int fr, int fq) const {
        const int row0 = u.pm * BM + wr * 64 + fr; const int col0 = u.pn * BM + wc * 32 + 8 * fq;
#pragma unroll
        for (int bj = 0; bj < 2; ++bj) { const int col = col0 + bj * HALF; const f32x4 b0 = *(const f32x4*)(bias + col), b1 = *(const f32x4*)(bias + col + 4);
#pragma unroll
            for (int ai = 0; ai < 2; ++ai)
#pragma unroll
                for (int m = 0; m < 4; ++m) { const int row = row0 + ai * HALF + m * 16;
                    const v4u zw = *(const v4u*)(z + (size_t)row * SSMW + col);
                    const f32x4 a0 = acc[ai][bj][m][0] + b0, a1 = acc[ai][bj][m][1] + b1;
                    float s[8];
                    s[0] = bf_lo(zw.x) * sigmoidf_(a0[0]); s[1] = bf_hi(zw.x) * sigmoidf_(a0[1]); s[2] = bf_lo(zw.y) * sigmoidf_(a0[2]); s[3] = bf_hi(zw.y) * sigmoidf_(a0[3]);
                    s[4] = bf_lo(zw.z) * sigmoidf_(a1[0]); s[5] = bf_hi(zw.z) * sigmoidf_(a1[1]); s[6] = bf_lo(zw.w) * sigmoidf_(a1[2]); s[7] = bf_hi(zw.w) * sigmoidf_(a1[3]);
                    v4u w; w.x = cvtpk(s[0], s[1]); w.y = cvtpk(s[2], s[3]); w.z = cvtpk(s[4], s[5]); w.w = cvtpk(s[6], s[7]);
                    *(v4u*)(cat + (size_t)row * DM + 512 + col) = w; } }
    }
};
struct EpiOutProj {
    static constexpr bool PERM = true;
    const bf16* xb; bf16* pre; f32x2* stats;
    __device__ __forceinline__ void operator()(const AccT& acc, const Unit& u, int wr, int wc, int fr, int fq) const {
        const int row0 = u.pm * BM + wr * 64 + fr; const int col0 = u.pn * BM + wc * 32 + 8 * fq;
#pragma unroll
        for (int ai = 0; ai < 2; ++ai)
#pragma unroll
            for (int m = 0; m < 4; ++m) { const int row = row0 + ai * HALF + m * 16; const size_t off = (size_t)row * DM + col0;
                f32x4 v[2][2]; float s = 0.f;
#pragma unroll
                for (int bj = 0; bj < 2; ++bj) { const v4u xw = *(const v4u*)(xb + off + bj * HALF);
                    v[bj][0] = (f32x4){bf_lo(xw.x), bf_hi(xw.x), bf_lo(xw.y), bf_hi(xw.y)} * ALPHA + acc[ai][bj][m][0];
                    v[bj][1] = (f32x4){bf_lo(xw.z), bf_hi(xw.z), bf_lo(xw.w), bf_hi(xw.w)} * ALPHA + acc[ai][bj][m][1];
                    v4u w; w.x = cvtpk(v[bj][0][0], v[bj][0][1]); w.y = cvtpk(v[bj][0][2], v[bj][0][3]); w.z = cvtpk(v[bj][1][0], v[bj][1][1]); w.w = cvtpk(v[bj][1][2], v[bj][1][3]);
                    *(v4u*)(pre + off + bj * HALF) = w;
#pragma unroll
                    for (int n = 0; n < 2; ++n) s += (v[bj][n][0] + v[bj][n][1]) + (v[bj][n][2] + v[bj][n][3]); }
                s += __shfl_xor(s, 16); s += __shfl_xor(s, 32);
                const float mw = s * (1.0f / 64.0f); float q = 0.f;
#pragma unroll
                for (int bj = 0; bj < 2; ++bj)
#pragma unroll
                    for (int n = 0; n < 2; ++n) { const f32x4 d = v[bj][n] - mw; q += (d[0] * d[0] + d[1] * d[1]) + (d[2] * d[2] + d[3] * d[3]); }
                q += __shfl_xor(q, 16); q += __shfl_xor(q, 32);
                if (fq == 0) stats[(size_t)row * 16 + u.pn * 4 + wc] = (f32x2){mw, q}; }
    }
};
template <bool WT  > struct EpiMoe1T {
    static constexpr bool PERM = true;
    bf16* hid;
    __device__ __forceinline__ void operator()(const AccT& acc, const Unit& u, int wr, int wc, int fr, int fq) const {
        const int row0 = u.pm * BM + wr * 64 + fr; const int col0 = u.pn * BM + wc * 32 + 8 * fq;
#pragma unroll
        for (int ai = 0; ai < 2; ++ai)
#pragma unroll
            for (int m = 0; m < 4; ++m) { const int row = row0 + ai * HALF + m * 16;
#pragma unroll
                for (int bj = 0; bj < 2; ++bj) { const f32x4 a0 = acc[ai][bj][m][0], a1 = acc[ai][bj][m][1]; const int col = (col0 + bj * HALF) >> 1;
                    const float h0 = a0[0] * sigmoidf_(a0[0]) * a0[1], h1 = a0[2] * sigmoidf_(a0[2]) * a0[3], h2 = a1[0] * sigmoidf_(a1[0]) * a1[1], h3 = a1[2] * sigmoidf_(a1[2]) * a1[3];
                    v2u w; w.x = cvtpk(h0, h1); w.y = cvtpk(h2, h3);
                    if constexpr (WT) __hip_atomic_store((GAS unsigned long long*)(hid + (size_t)row * DEXP + col), ((unsigned long long)w.y << 32) | w.x, __ATOMIC_RELAXED, __HIP_MEMORY_SCOPE_AGENT);
                    else *(v2u*)(hid + (size_t)row * DEXP + col) = w; } }
    }
};
typedef EpiMoe1T<false> EpiMoe1;
struct EpiMoe2 {
    static constexpr bool PERM = true;
    const int* eslot; const float* ew; const PG8_LAS int* ecnt; bf16* y2;
    __device__ __forceinline__ void operator()(const AccT& acc, const Unit& u, int wr, int wc, int fr, int fq) const {
        const int e = u.aux & 255, cnt = ecnt[e]; const int row0 = (u.aux >> 8) * BM + wr * 64 + fr; const int col0 = u.pn * BM + wc * 32 + 8 * fq;
#pragma unroll
        for (int ai = 0; ai < 2; ++ai)
#pragma unroll
            for (int m = 0; m < 4; ++m) { const int idx = row0 + ai * HALF + m * 16; const bool ok = idx < cnt;
                const int slot = ok ? eslot[e * 65536 + idx] : 65536 + (idx & 255); const float wt = ok ? ew[e * 65536 + idx] : 0.f;
#pragma unroll
                for (int bj = 0; bj < 2; ++bj) { const f32x4 v0 = acc[ai][bj][m][0] * wt, v1 = acc[ai][bj][m][1] * wt;
                    v4u w; w.x = cvtpk(v0[0], v0[1]); w.y = cvtpk(v0[2], v0[3]); w.z = cvtpk(v1[0], v1[1]); w.w = cvtpk(v1[2], v1[3]);
                    *(v4u*)(y2 + (size_t)slot * DM + col0 + bj * HALF) = w; } }
    }
};
}

namespace att {
__device__ __forceinline__ int crow(int r, int hi) { return (r & 3) + 8 * (r >> 2) + 4 * hi; }
#define SBAR() __builtin_amdgcn_sched_barrier(0)
constexpr int STAGE = 32768, K_OFF = 0, V_OFF = 16384, WS_OFF = 131072 + 4096;
constexpr float THR = 8.0f;
__device__ __forceinline__ void glds16(const void* gsrc, unsigned lds_dst) { unsigned keep;
    asm volatile("s_mov_b32 %0, m0\n\ts_mov_b32 m0, %2\n\ts_nop 0\n\tglobal_load_lds_dwordx4 %1, off\n\ts_mov_b32 m0, %0" : "=&s"(keep) : "v"(gsrc), "s"(lds_dst) : "memory"); }
#define ATT_WAIT_BAR(N) asm volatile("s_waitcnt vmcnt(" #N ") lgkmcnt(0)\n\ts_barrier" ::: "memory")
#define ATT_BAR_L() asm volatile("s_waitcnt lgkmcnt(0)\n\ts_barrier" ::: "memory")

__device__ __forceinline__ float max3f(float a, float b, float c) { return __builtin_fmaxf(__builtin_fmaxf(a, b), c); }
__device__ __forceinline__ float max2f(float a, float b) { return __builtin_fmaxf(a, b); }
__device__ __forceinline__ float rowmax32(const f32x16& p0, const f32x16& p1) {
    float a = max3f(p0[0], p0[1], p1[0]), b = max3f(p0[2], p0[3], p1[1]); a = max3f(a, p1[2], p1[3]);
#pragma unroll
    for (int r = 4; r < 16; r += 4) { a = max3f(a, p0[r], p0[r + 1]); b = max3f(b, p0[r + 2], p0[r + 3]); a = max3f(a, p1[r], p1[r + 1]); b = max3f(b, p1[r + 2], p1[r + 3]); }
    const float m = max2f(a, b);
    auto rr = __builtin_amdgcn_permlane32_swap(__float_as_uint(m), __float_as_uint(m), false, false);
    return max2f(__uint_as_float(rr[0]), __uint_as_float(rr[1]));
}

__device__ __forceinline__ void attn_unit(int b, int h, int qb, const bf16* PROJ, bf16* CAT, char* shm, float lam, const float* subln_g) {
    const int tid = threadIdx.x, lane = tid & 63, r32 = lane & 31, hi = lane >> 5; const int wid = __builtin_amdgcn_readfirstlane(tid >> 6);
    const int sub = wid >> 2, wq = wid & 3;
    const long rowbase = (long)b * SEQ; const int q0 = qb * 128;
    const bf16* Qw = PROJ + (rowbase + q0 + wq * 32) * 512 + h * 128 + sub * 64;
    const bf16* Kh = PROJ + (size_t)TOK * 512 + (size_t)((b * 4 + h) * 2) * 64 * 4096;
    const bf16* Vh = PROJ + (size_t)TOK * 1024 + (size_t)(b * 4 + h) * 64 * 8192;
    const unsigned lds0 = (unsigned)(uintptr_t)shm;
    float* wsf = (float*)(shm + WS_OFF) + wid * 64;
    const bf16* ksrc0 = Kh + wid * 512 + lane * 8;
    const bf16* ksrc1 = ksrc0 + 64 * 4096;
    const unsigned kdst0 = lds0 + K_OFF + wid * 1024, kdst1 = lds0 + K_OFF + 8192 + wid * 1024;
    const bf16* vsrc0 = Vh + wid * 512 + lane * 8;
    const bf16* vsrc1 = vsrc0 + 4096;
    const unsigned vdst0 = lds0 + V_OFF + wid * 1024, vdst1 = vdst0 + 8192;
#define ATT_DMA(t, so) do { const long rk_ = (long)(t) * 4096, rv_ = (long)(t) * 8192; const unsigned so_ = (unsigned)(so); \
        glds16(ksrc0 + rk_, (unsigned)__builtin_amdgcn_readfirstlane(kdst0 + so_)); glds16(ksrc1 + rk_, (unsigned)__builtin_amdgcn_readfirstlane(kdst1 + so_)); \
        glds16(vsrc0 + rv_, (unsigned)__builtin_amdgcn_readfirstlane(vdst0 + so_)); glds16(vsrc1 + rv_, (unsigned)__builtin_amdgcn_readfirstlane(vdst1 + so_)); } while (0)
    const int NT = 2 * qb + 2; const int my_last = 2 * qb + (wq >> 1);
    ATT_DMA(0, 0); ATT_DMA(1, STAGE); if (NT > 2) ATT_DMA(2, 2 * STAGE);
    bf16x8 qr[4];
#pragma unroll
    for (int d0 = 0; d0 < 4; ++d0) qr[d0] = *reinterpret_cast<const bf16x8*>(&Qw[(long)r32 * 512 + d0 * 16 + hi * 8]);
    float mrun = 0.f, l_reg = 0.f;
    f32x16 o[4];
#pragma unroll
    for (int d = 0; d < 4; ++d) o[d] = f32x16{};
    const int vb0 = (int)(lds0 + V_OFF) + ((lane >> 4) & 1) * 32 + (lane & 3) * 8 + (4 * hi + ((lane & 15) >> 2)) * 64;
    const char* kbase = shm + K_OFF + sub * 8192 + hi * 1024 + r32 * 16;
    const int kb32 = (int)(lds0 + K_OFF) + sub * 8192 + hi * 1024 + r32 * 16;
    if (NT > 2) ATT_WAIT_BAR(4); else ATT_WAIT_BAR(0);
    asm volatile("" :: "v"(qr[0]), "v"(qr[1]), "v"(qr[2]), "v"(qr[3]));
#define ATT_QK(P0, P1, soff) do { const char* kb_ = kbase + (soff); f32x16 negm; _Pragma("unroll") for (int r = 0; r < 16; ++r) negm[r] = -mrun;     \
        _Pragma("unroll") for (int d0 = 0; d0 < 4; ++d0) { \
            const bf16x8 b0_ = *reinterpret_cast<const bf16x8*>(kb_ + d0 * 2048); const bf16x8 b1_ = *reinterpret_cast<const bf16x8*>(kb_ + d0 * 2048 + 512); \
            if (d0 == 0) { P0 = __builtin_amdgcn_mfma_f32_32x32x16_bf16(b0_, qr[0], negm, 0, 0, 0); P1 = __builtin_amdgcn_mfma_f32_32x32x16_bf16(b1_, qr[0], negm, 0, 0, 0); } \
            else { P0 = __builtin_amdgcn_mfma_f32_32x32x16_bf16(b0_, qr[d0], P0, 0, 0, 0); P1 = __builtin_amdgcn_mfma_f32_32x32x16_bf16(b1_, qr[d0], P1, 0, 0, 0); } } } while (0)
    f32x16 pS0, pS1;
    ATT_QK(pS0, pS1, 0);
    if (sub == 1) ATT_BAR_L();
    int cur = 0;
#define ATT_RDV(L, H, d0) do { _Pragma("unroll") for (int ks = 0; ks < 4; ++ks) { \
                    asm volatile("ds_read_b64_tr_b16 %0,%1 offset:%c2" : "=&v"(L[ks]) : "v"(vb), "i"((d0) * 4096 + ks * 1024) : "memory"); \
                    asm volatile("ds_read_b64_tr_b16 %0,%1 offset:%c2" : "=&v"(H[ks]) : "v"(vb), "i"((d0) * 4096 + ks * 1024 + 512) : "memory"); } } while (0)
#define ATT_PK(L, H, k) (bf16x8){L[k][0], L[k][1], L[k][2], L[k][3], H[k][0], H[k][1], H[k][2], H[k][3]}
#define ATT_PV(L, H, d0) do { \
                    o[d0] = __builtin_amdgcn_mfma_f32_32x32x16_bf16(__builtin_bit_cast(bf16x8, pw[0]), ATT_PK(L, H, 0), o[d0], 0, 0, 0); \
                    o[d0] = __builtin_amdgcn_mfma_f32_32x32x16_bf16(__builtin_bit_cast(bf16x8, pw[1]), ATT_PK(L, H, 1), o[d0], 0, 0, 0); \
                    o[d0] = __builtin_amdgcn_mfma_f32_32x32x16_bf16(__builtin_bit_cast(bf16x8, pw[2]), ATT_PK(L, H, 2), o[d0], 0, 0, 0); \
                    o[d0] = __builtin_amdgcn_mfma_f32_32x32x16_bf16(__builtin_bit_cast(bf16x8, pw[3]), ATT_PK(L, H, 3), o[d0], 0, 0, 0); } while (0)
    for (int t = 0; t < NT; ++t) {
        const int nx1 = (cur == 3 * STAGE) ? 0 : cur + STAGE; const int st3 = (cur == 0) ? 3 * STAGE : cur - STAGE;
        const bool more = (t + 3 < NT);
        if (sub == 1 && more) ATT_DMA(t + 3, st3);
        v4u pw[4];
        if (t <= my_last) {
            const float rm = rowmax32(pS0, pS1); bool resc = false;
            if (t == 0 || __any(rm > THR)) {
                const float dl = (t == 0) ? rm : fmaxf(rm, 0.f); mrun += dl;
#pragma unroll
                for (int r = 0; r < 16; ++r) { pS0[r] -= dl; pS1[r] -= dl; }
                if (t != 0) { const float f = fexp2(-dl); l_reg *= f; if (hi == 0) wsf[r32] = f; resc = true; }
            }
            float sacc = 0.f;
#pragma unroll
            for (int r = 0; r < 16; ++r) { pS0[r] = fexp2(pS0[r]); pS1[r] = fexp2(pS1[r]); sacc += pS0[r] + pS1[r]; }
            l_reg += sacc;
            if (resc) { LDS_WAIT();
#pragma unroll
                for (int r = 0; r < 16; ++r) { const float f = wsf[crow(r, hi)];
#pragma unroll
                    for (int d = 0; d < 4; ++d) o[d][r] *= f; } }
            pw[0] = (v4u){cvtpk(pS0[0], pS0[1]), cvtpk(pS0[2], pS0[3]), cvtpk(pS0[4], pS0[5]), cvtpk(pS0[6], pS0[7])};
            pw[1] = (v4u){cvtpk(pS0[8], pS0[9]), cvtpk(pS0[10], pS0[11]), cvtpk(pS0[12], pS0[13]), cvtpk(pS0[14], pS0[15])};
            pw[2] = (v4u){cvtpk(pS1[0], pS1[1]), cvtpk(pS1[2], pS1[3]), cvtpk(pS1[4], pS1[5]), cvtpk(pS1[6], pS1[7])};
            pw[3] = (v4u){cvtpk(pS1[8], pS1[9]), cvtpk(pS1[10], pS1[11]), cvtpk(pS1[12], pS1[13]), cvtpk(pS1[14], pS1[15])};
        }
        if (sub == 0) ATT_BAR_L(); else { if (more) ATT_WAIT_BAR(4); else ATT_WAIT_BAR(0); }
        if (sub == 0 && more) ATT_DMA(t + 3, st3);
        if (t <= my_last) {
            const int vb = vb0 + cur;
            s16x4 la[4], ha[4], lb[4], hb[4];
            ATT_RDV(la, ha, 0); ATT_RDV(lb, hb, 1);
            asm volatile("s_waitcnt lgkmcnt(8)" ::: "memory"); SBAR();
            ATT_PV(la, ha, 0); SBAR();
            ATT_RDV(la, ha, 2);
            asm volatile("s_waitcnt lgkmcnt(8)" ::: "memory"); SBAR();
            ATT_PV(lb, hb, 1); SBAR();
            ATT_RDV(lb, hb, 3);
            asm volatile("s_waitcnt lgkmcnt(8)" ::: "memory"); SBAR();
            ATT_PV(la, ha, 2); SBAR();
            asm volatile("s_waitcnt lgkmcnt(0)" ::: "memory"); SBAR();
            ATT_PV(lb, hb, 3);
        }
        if (t + 1 <= my_last) {
            bf16x8 kA0, kA1, kB0, kB1; const int ka = kb32 + nx1;
#define ATT_KRD(D0, D1, d0) do { asm volatile("ds_read_b128 %0,%1 offset:%c2" : "=&v"(D0) : "v"(ka), "i"((d0) * 2048) : "memory"); \
                                 asm volatile("ds_read_b128 %0,%1 offset:%c2" : "=&v"(D1) : "v"(ka), "i"((d0) * 2048 + 512) : "memory"); } while (0)
            ATT_KRD(kA0, kA1, 0); ATT_KRD(kB0, kB1, 1);
#pragma unroll
            for (int r = 0; r < 16; ++r) { pS0[r] = -mrun; pS1[r] = -mrun; }
            asm volatile("s_waitcnt lgkmcnt(2)" ::: "memory"); SBAR();
            pS0 = __builtin_amdgcn_mfma_f32_32x32x16_bf16(kA0, qr[0], pS0, 0, 0, 0); pS1 = __builtin_amdgcn_mfma_f32_32x32x16_bf16(kA1, qr[0], pS1, 0, 0, 0); SBAR();
            ATT_KRD(kA0, kA1, 2);
            asm volatile("s_waitcnt lgkmcnt(2)" ::: "memory"); SBAR();
            pS0 = __builtin_amdgcn_mfma_f32_32x32x16_bf16(kB0, qr[1], pS0, 0, 0, 0); pS1 = __builtin_amdgcn_mfma_f32_32x32x16_bf16(kB1, qr[1], pS1, 0, 0, 0); SBAR();
            ATT_KRD(kB0, kB1, 3);
            asm volatile("s_waitcnt lgkmcnt(2)" ::: "memory"); SBAR();
            pS0 = __builtin_amdgcn_mfma_f32_32x32x16_bf16(kA0, qr[2], pS0, 0, 0, 0); pS1 = __builtin_amdgcn_mfma_f32_32x32x16_bf16(kA1, qr[2], pS1, 0, 0, 0); SBAR();
            asm volatile("s_waitcnt lgkmcnt(0)" ::: "memory"); SBAR();
            pS0 = __builtin_amdgcn_mfma_f32_32x32x16_bf16(kB0, qr[3], pS0, 0, 0, 0); pS1 = __builtin_amdgcn_mfma_f32_32x32x16_bf16(kB1, qr[3], pS1, 0, 0, 0);
#undef ATT_KRD
        }
        if (sub == 1) ATT_BAR_L(); else { if (more) ATT_WAIT_BAR(4); else ATT_WAIT_BAR(0); }
        cur = nx1;
    }
#undef ATT_QK
#undef ATT_RDV
#undef ATT_PK
#undef ATT_PV
    if (sub == 0) ATT_BAR_L();
    { auto rr = __builtin_amdgcn_permlane32_swap(__float_as_uint(l_reg), __float_as_uint(l_reg), false, false); l_reg = __uint_as_float(rr[0]) + __uint_as_float(rr[1]); }
    if (hi == 0) wsf[32 + r32] = l_reg;
    LDS_WAIT();
    float rli[16];
#pragma unroll
    for (int r = 0; r < 16; ++r) rli[r] = frcp(wsf[32 + crow(r, hi)]);
    float* stg = (float*)shm + wq * 4096;
    if (sub == 1) {
#pragma unroll
        for (int r = 0; r < 16; ++r) { const int orow = crow(r, hi);
#pragma unroll
            for (int d = 0; d < 4; ++d) stg[orow * 128 + d * 32 + r32] = o[d][r] * rli[r]; }
    }
    ATT_WAIT_BAR(0);
    if (sub == 0) {
#pragma unroll
        for (int r = 0; r < 16; ++r) { const int orow = crow(r, hi);
#pragma unroll
            for (int d = 0; d < 4; ++d) { const float v = o[d][r] * rli[r] - lam * stg[orow * 128 + d * 32 + r32]; stg[orow * 128 + d * 32 + r32] = v; } }
        LDS_WAIT();
        const int c8 = (lane & 15) * 8;
        const f32x4 g0 = *(const f32x4*)(subln_g + c8), g1 = *(const f32x4*)(subln_g + c8 + 4);
        bf16* Ow = CAT + (rowbase + q0 + wq * 32) * DM + h * 128 + c8;
#pragma unroll
        for (int i = 0; i < 8; ++i) { const int row = i * 4 + (lane >> 4);
            const f32x4 a = *(const f32x4*)(stg + row * 128 + c8), c = *(const f32x4*)(stg + row * 128 + c8 + 4);
            float ss = (a[0] * a[0] + a[1] * a[1]) + (a[2] * a[2] + a[3] * a[3]) + (c[0] * c[0] + c[1] * c[1]) + (c[2] * c[2] + c[3] * c[3]);
            ss += __shfl_xor(ss, 1); ss += __shfl_xor(ss, 2); ss += __shfl_xor(ss, 4); ss += __shfl_xor(ss, 8);
            const float sc = (1.0f - LAM_INIT) / sqrtf(ss * (1.0f / 128.0f) + RMS_EPS);
            v4u w; w.x = cvtpk(a[0] * sc * g0[0], a[1] * sc * g0[1]); w.y = cvtpk(a[2] * sc * g0[2], a[3] * sc * g0[3]);
            w.z = cvtpk(c[0] * sc * g1[0], c[1] * sc * g1[1]); w.w = cvtpk(c[2] * sc * g1[2], c[3] * sc * g1[3]);
            *(v4u*)(Ow + (long)row * DM) = w; }
    }
    ATT_WAIT_BAR(0);
#undef ATT_DMA
}
#undef SBAR
}

#define XB_TMO      128
#define XB_XCNT(j)  (256  + 64 * (j))
#define XB_XSUB(j)  (1280 + 64 * (j))
#define XB_XGEN(j)  (2304 + 64 * (j))
#define XB_TOP      3328
#define XB_TOPGEN   3392
#define XCD_BAR_WORDS 3456
#define XB_SPIN_CAP (1u << 18)
__device__ __forceinline__ unsigned xb_ld(unsigned* p)              { return __hip_atomic_load(p, __ATOMIC_RELAXED, __HIP_MEMORY_SCOPE_AGENT); }
__device__ __forceinline__ unsigned xb_add(unsigned* p, unsigned v) { return __hip_atomic_fetch_add(p, v, __ATOMIC_RELAXED, __HIP_MEMORY_SCOPE_AGENT); }
__device__ __forceinline__ unsigned xb_xcc_id() { return (unsigned)__builtin_amdgcn_s_getreg((3 << 11) | 20) & 0xFu; }
#define XB_SPIN(cond, bar) do { unsigned _sp = 0; while (cond) { __builtin_amdgcn_s_sleep(1); \
    if ((++_sp & 255u) == 0u) { if (xb_ld(&(bar)[XB_TMO])) break; if (_sp > XB_SPIN_CAP) { atomicAdd(&(bar)[XB_TMO], 1u); break; } } } } while (0)
struct XcdBarrier { unsigned* bar; unsigned x; volatile LAS unsigned* st; };
__device__ __forceinline__ XcdBarrier xcd_barrier_post(unsigned* bar, volatile LAS unsigned* st) {
    XcdBarrier b; b.bar = bar; b.x = xb_xcc_id(); b.st = st;
    if (threadIdx.x == 0) (void)xb_add(&bar[XB_XCNT(b.x)], 1u);
    return b;
}
__device__ __forceinline__ void xcd_barrier_complete(unsigned* bar, unsigned x, unsigned& nloc, unsigned& nx) {
    const unsigned G = gridDim.x * gridDim.y * gridDim.z;
    unsigned sum, cnt, mine, sp = 0u;
    for (;;) {
        sum = 0u; cnt = 0u; mine = 0u;
#pragma unroll
        for (unsigned j = 0; j < 16; ++j) { const unsigned c = xb_ld(&bar[XB_XCNT(j)]); sum += c; cnt += (c > 0u) ? 1u : 0u; mine = (j == x) ? c : mine; }
        if (sum == G) break;
        __builtin_amdgcn_s_sleep(1);
        if ((++sp & 255u) == 0u) { if (xb_ld(&bar[XB_TMO])) break; if (sp > XB_SPIN_CAP) { atomicAdd(&bar[XB_TMO], 1u); break; } }
    }
    nloc = mine > 0u ? mine : 1u; nx = cnt > 0u ? cnt : 1u;
}
__device__ __forceinline__ void xcd_barrier(const XcdBarrier& b) {
    asm volatile("s_waitcnt vmcnt(0)" ::: "memory");
    __syncthreads();
    if (threadIdx.x == 0) {
        unsigned* bar = b.bar;
        __builtin_amdgcn_s_waitcnt(0);
        unsigned nloc = b.st[0], nx = b.st[1];
        if (nloc == 0u) { xcd_barrier_complete(bar, b.x, nloc, nx); b.st[0] = nloc; b.st[1] = nx; }
        const unsigned old = xb_add(&bar[XB_XSUB(b.x)], 1u);
        const unsigned gen = old / nloc;
        if (old + 1u == (gen + 1u) * nloc) {
            __builtin_amdgcn_fence(__ATOMIC_RELEASE, "agent");
            asm volatile("s_waitcnt vmcnt(0)" ::: "memory");
            const unsigned og = xb_add(&bar[XB_TOP], 1u);
            const unsigned tg = og / nx;
            if (og + 1u == (tg + 1u) * nx) xb_add(&bar[XB_TOPGEN], 1u);
            else XB_SPIN(xb_ld(&bar[XB_TOPGEN]) == tg, bar);
            __builtin_amdgcn_fence(__ATOMIC_ACQUIRE, "agent");
            xb_add(&bar[XB_XGEN(b.x)], 1u);
            asm volatile("s_waitcnt vmcnt(0)" ::: "memory");
        } else {
            XB_SPIN(xb_ld(&bar[XB_XGEN(b.x)]) == gen, bar);
            __builtin_amdgcn_fence(__ATOMIC_ACQUIRE, "agent");
            asm volatile("s_waitcnt vmcnt(0)" ::: "memory");
        }
    }
    __syncthreads();
}

constexpr int NWAVES = 8;
constexpr int NPHASES = 11;
struct Args { const void* in[27]; float* out; unsigned char* ws; int ph_lo, ph_hi, li, pad; };

struct Frame {
    LAS unsigned char* lds; unsigned char* ws; int tid, lane, wave, G, bid;
};

__device__ __forceinline__ void p0_transpose_tile(const float* W, int K, int N, bf16* WT, int row_off, int rmul, LAS float* scr, int tile, int tid) {
    const int nnb = N / 512, kb = tile / nnb, nb = tile % nnb, k0 = 64 * kb, n0 = 512 * nb;
    const int c4 = tid & 127, rr = tid >> 7;
    f32x4 v[16];
#pragma unroll
    for (int i = 0; i < 16; ++i) v[i] = *(const GAS f32x4*)(W + (size_t)(k0 + 4 * i + rr) * N + n0 + 4 * c4);
#pragma unroll
    for (int i = 0; i < 16; ++i) { const int k = 4 * i + rr; *(LAS f32x4*)(scr + k * 512 + ((4 * c4) ^ (4 * ((k >> 3) & 7)))) = v[i]; }
    __syncthreads();
    const int c = tid & 7, dn = tid >> 3;
#pragma unroll
    for (int j = 0; j < 8; ++j) { const int n = 64 * j + dn; const LAS float* sp = scr + (8 * c) * 512 + (n ^ (4 * c));
        v4u o; o.x = cvtpk(sp[0 * 512], sp[1 * 512]); o.y = cvtpk(sp[2 * 512], sp[3 * 512]); o.z = cvtpk(sp[4 * 512], sp[5 * 512]); o.w = cvtpk(sp[6 * 512], sp[7 * 512]);
        *(GAS v4u*)(WT + (size_t)(row_off + rmul * (n0 + n)) * K + k0 + 8 * c) = o; }
    __syncthreads();
}

__device__ __forceinline__ void p0_ssm_job(Frame& F, const Args& a, int job) {
    const int g = job >> 3, i = job & 7, tid = F.tid;
    const float* a_re = (const float*)a.in[7]; const float* a_im = (const float*)a.in[8]; const float* log_dt = (const float*)a.in[9];
    const float* b_re = (const float*)a.in[10]; const float* b_im = (const float*)a.in[11]; const float* c_re = (const float*)a.in[12]; const float* c_im = (const float*)a.in[13];
    LAS float* PW = (LAS float*)(F.lds);
    LAS float* BB = (LAS float*)(F.lds + 33280);
    LAS float* CC = (LAS float*)(F.lds + 41472);
    LAS bf16* KT = (LAS bf16*)(F.lds + 49664);
    if (tid < 64) {
        const int p = tid; const double are = a_re[g * 64 + p], aim = a_im[g * 64 + p]; const double dt = exp((double)log_dt[g]);
        const double mag = exp(are * dt), th = aim * dt; const double lr = mag * cos(th), li = mag * sin(th);
        double pr = 1.0, pi = 0.0;
        for (int j = 0; j <= 32; ++j) { PW[(j * 64 + p) * 2] = (float)pr; PW[(j * 64 + p) * 2 + 1] = (float)pi; const double nr = pr * lr - pi * li, ni = pr * li + pi * lr; pr = nr; pi = ni; }
        const double den = are * are + aim * aim; const double nr_ = lr - 1.0, ni_ = li;
        const double fr_ = (nr_ * are + ni_ * aim) / den, fi_ = (ni_ * are - nr_ * aim) / den;
        for (int ci = 0; ci < 16; ++ci) { const double br = b_re[(g * 64 + p) * 16 + ci], bi = b_im[(g * 64 + p) * 16 + ci];
            BB[(p * 16 + ci) * 2] = (float)(fr_ * br - fi_ * bi); BB[(p * 16 + ci) * 2 + 1] = (float)(fr_ * bi + fi_ * br); }
    }
    for (int e = tid; e < 1024; e += 512) { CC[e * 2] = c_re[g * 1024 + e]; CC[e * 2 + 1] = c_im[g * 1024 + e]; }
    __syncthreads();
    {
        const int ci = tid & 15, c2 = (tid >> 4) & 1, jq = tid >> 5, co = 2 * i + c2;
        float acc[2] = {0.f, 0.f};
        for (int p = 0; p < 64; ++p) { const float cr = CC[(co * 64 + p) * 2], cim = CC[(co * 64 + p) * 2 + 1], br = BB[(p * 16 + ci) * 2], bi = BB[(p * 16 + ci) * 2 + 1];
            const float xr = cr * br - cim * bi, xi = cr * bi + cim * br;
#pragma unroll
            for (int q = 0; q < 2; ++q) { const int j = 2 * jq + q; acc[q] += xr * PW[(j * 64 + p) * 2] - xi * PW[(j * 64 + p) * 2 + 1]; } }
#pragma unroll
        for (int q = 0; q < 2; ++q) { const int j = 2 * jq + q; KT[(j * 2 + c2) * 16 + ci] = (bf16)(cvtpk(acc[q], 0.f) & 0xffffu); }
    }
    __syncthreads();
    bf16* toep = (bf16*)(F.ws + WS_TOEP) + (size_t)g * 1024 * UP_PITCH;
    for (int q = tid; q < 128 * 64; q += 512) { const int rl = q >> 6, chn = q & 63; const int t = rl >> 1, c2 = rl & 1, s = (t & 32) + (chn >> 1), half = chn & 1; const int n = t * 16 + 2 * i + c2;
        v4u w = (v4u){0u, 0u, 0u, 0u};
        if (t >= s) w = *(const LAS v4u*)(KT + ((t - s) * 2 + c2) * 16 + half * 8);
        *(GAS v4u*)(toep + (size_t)n * UP_PITCH + s * 16 + half * 8) = w; }
    for (int q = tid; q < 128 * 64; q += 512) { const int rl = q >> 6, p = q & 63; const int t = rl >> 1, c2 = rl & 1, co = 2 * i + c2; const int n = t * 16 + co; const int j = (t & 31) + 1;
        const float cr = CC[(co * 64 + p) * 2], cim = CC[(co * 64 + p) * 2 + 1], wr_ = PW[(j * 64 + p) * 2], wi_ = PW[(j * 64 + p) * 2 + 1];
        const float re = cr * wr_ - cim * wi_, im = cr * wi_ + cim * wr_;
        bf16* d = toep + (size_t)n * UP_PITCH + 1024 + 128 * (t >> 5) + p;
        d[0] = (bf16)(cvtpk(re, 0.f) & 0xffffu); d[64] = (bf16)(cvtpk(-im, 0.f) & 0xffffu); }
    bf16* wsin = (bf16*)(F.ws + WS_WSIN) + (size_t)g * 256 * 1024;
    for (int q = tid; q < 32 * 1024; q += 512) { const int rl = q >> 10, k = q & 1023; const int pp = 32 * i + rl, p = pp & 63, s = k >> 4, ci = k & 15;
        float v = 0.f;
        if ((s >> 5) == (pp >> 7)) { const int j = 31 - (s & 31); const float wr_ = PW[(j * 64 + p) * 2], wi_ = PW[(j * 64 + p) * 2 + 1], br = BB[(p * 16 + ci) * 2], bi = BB[(p * 16 + ci) * 2 + 1];
            v = ((pp & 64) == 0) ? (wr_ * br - wi_ * bi) : (wr_ * bi + wi_ * br); }
        wsin[(size_t)pp * 1024 + k] = (bf16)(cvtpk(v, 0.f) & 0xffffu); }
    if (i == 0 && tid < 64) { float* lamb = (float*)(F.ws + WS_LAMB) + (g * 64 + tid) * 2; lamb[0] = PW[(32 * 64 + tid) * 2]; lamb[1] = PW[(32 * 64 + tid) * 2 + 1]; }
    __syncthreads();
}

__device__ __forceinline__ void p0_prologue(Frame& F, const Args& a) {
    for (int job = F.bid; job < 256; job += F.G) p0_ssm_job(F, a, job);
    LAS float* scr = (LAS float*)(F.lds);
    const int gw = F.bid * NWAVES + F.wave, NGW = F.G * NWAVES;
    const float* w_in = (const float*)a.in[1]; const float* w_glu = (const float*)a.in[15]; const float* w_out = (const float*)a.in[17];
    const float* wg = (const float*)a.in[22]; const float* wu = (const float*)a.in[23]; const float* wd = (const float*)a.in[24];
    constexpr int I_IN = 16 * 4, I_GLU = 8 * 1, I_OUT = 16 * 2, I_G = 16 * 1, I_D = 8 * 2;
    constexpr int NTILES = I_IN + I_GLU + I_OUT + NEXP * (2 * I_G + I_D);
    for (int it = F.bid; it < NTILES; it += F.G) {
        int r = it;
        if (r < I_IN) { p0_transpose_tile(w_in, 1024, 2048, (bf16*)(F.ws + WS_WIN_T), 0, 1, scr, r, F.tid); continue; } r -= I_IN;
        if (r < I_GLU) { p0_transpose_tile(w_glu, 512, 512, (bf16*)(F.ws + WS_WGLU_T), 0, 1, scr, r, F.tid); continue; } r -= I_GLU;
        if (r < I_OUT) { p0_transpose_tile(w_out, 1024, 1024, (bf16*)(F.ws + WS_WOUT_T), 0, 1, scr, r, F.tid); continue; } r -= I_OUT;
        const int e = r / (2 * I_G + I_D); r -= e * (2 * I_G + I_D);
        if (r < I_G) { p0_transpose_tile(wg + (size_t)e * 1024 * 512, 1024, 512, (bf16*)(F.ws + WS_WG1) + (size_t)e * 1024 * 1024, 0, 2, scr, r, F.tid); continue; } r -= I_G;
        if (r < I_G) { p0_transpose_tile(wu + (size_t)e * 1024 * 512, 1024, 512, (bf16*)(F.ws + WS_WG1) + (size_t)e * 1024 * 1024, 1, 2, scr, r, F.tid); continue; } r -= I_G;
        p0_transpose_tile(wd + (size_t)e * 512 * 1024, 512, 1024, (bf16*)(F.ws + WS_WD) + (size_t)e * 1024 * 512, 0, 1, scr, r, F.tid);
    }
    const float* x = (const float*)a.in[0]; bf16* xb = (bf16*)(F.ws + WS_XB);
    for (int m = gw; m < TOK; m += NGW) {
        const GAS f32x4* xr = (const GAS f32x4*)(x + (size_t)m * DM) + F.lane; GAS v2u* o8 = (GAS v2u*)(xb + (size_t)m * DM) + F.lane;
        f32x4 v[4];
#pragma unroll
        for (int j = 0; j < 4; ++j) v[j] = xr[64 * j];
#pragma unroll
        for (int j = 0; j < 4; ++j) o8[64 * j] = (v2u){cvtpk(v[j][0], v[j][1]), cvtpk(v[j][2], v[j][3])};
    }
}

__device__ __forceinline__ void p3_scan(Frame& F, const float* sstate, int g, int pm) {
    const int tid = F.tid, lane = F.lane, wave = F.wave;
    const unsigned lds0 = (unsigned)(uintptr_t)(F.lds);
    LAS float* SB = (LAS float*)F.lds;
    LAS bf16* HS = (LAS bf16*)(F.lds + 98304);
    const float* ss = sstate + (size_t)(g * 512 + 4 * pm * 64) * 256;
    bf16* up = (bf16*)(F.ws + WS_UPERM) + (size_t)(g * 512 + 4 * pm * 64) * UP_PITCH + 1024;
#define P3_DMA(k, buf) do { _Pragma("unroll") for (int q_ = 0; q_ < 8; ++q_) { const int r_ = 8 * wave + q_; \
        att::glds16(ss + (size_t)((r_ >> 3) * 64 + 8 * (k) + (r_ & 7)) * 256 + lane * 4, (unsigned)__builtin_amdgcn_readfirstlane(lds0 + (buf) * 32768 + r_ * 1024)); } } while (0)
    if (wave < 4) {
        const int bb = tid >> 6, p = tid & 63;
        const float* lamb = (const float*)(F.ws + WS_LAMB) + (g * 64 + p) * 2; const float lr = lamb[0], li = lamb[1];
        asm volatile("s_waitcnt vmcnt(0)" :: "v"(lr), "v"(li) : "memory");
        float hr = 0.f, hi_ = 0.f;
        P3_DMA(0, 0); P3_DMA(1, 1);
        int buf = 0;
        for (int k = 0; k < 8; ++k) {
            if (k < 7) asm volatile("s_waitcnt vmcnt(8) lgkmcnt(0)\n\ts_barrier" ::: "memory"); else asm volatile("s_waitcnt vmcnt(0) lgkmcnt(0)\n\ts_barrier" ::: "memory");
            if (k + 2 < 8) { const int b2 = (buf >= 1) ? buf - 1 : buf + 2; P3_DMA(k + 2, b2); }
            const LAS float* sb = SB + buf * 8192 + bb * 8 * 256 + p; LAS bf16* hs = HS + (k & 1) * 8192 + bb * 8 * 256 + p;
#pragma unroll
            for (int j = 0; j < 8; ++j) { const float s0r = sb[j * 256], s0i = sb[j * 256 + 64], s1r = sb[j * 256 + 128], s1i = sb[j * 256 + 192];
                hs[j * 256] = (bf16)(cvtpk(hr, 0.f) & 0xffffu); hs[j * 256 + 64] = (bf16)(cvtpk(hi_, 0.f) & 0xffffu);
                float nr = lr * hr - li * hi_ + s0r, ni = lr * hi_ + li * hr + s0i; hr = nr; hi_ = ni;
                hs[j * 256 + 128] = (bf16)(cvtpk(hr, 0.f) & 0xffffu); hs[j * 256 + 192] = (bf16)(cvtpk(hi_, 0.f) & 0xffffu);
                nr = lr * hr - li * hi_ + s1r; ni = lr * hi_ + li * hr + s1i; hr = nr; hi_ = ni; }
            asm volatile("s_waitcnt lgkmcnt(0)\n\ts_barrier" ::: "memory");
            buf = (buf == 2) ? 0 : buf + 1;
        }
    } else {
        const int t2 = tid - 256;
        for (int k = 0; k < 8; ++k) {
            asm volatile("s_waitcnt lgkmcnt(0)\n\ts_barrier" ::: "memory");
            asm volatile("s_waitcnt lgkmcnt(0)\n\ts_barrier" ::: "memory");
#pragma unroll
            for (int q = 0; q < 4; ++q) { const int idx = t2 + 256 * q; const int r = idx >> 5, ch = idx & 31;
                const v4u w = *(const LAS v4u*)(HS + (k & 1) * 8192 + r * 256 + ch * 8);
                *(GAS v4u*)(up + (size_t)((r >> 3) * 64 + 8 * k + (r & 7)) * UP_PITCH + ch * 8) = w; }
        }
    }
#undef P3_DMA
    VM_WAIT(); LDS_WAIT(); __syncthreads();
}

__device__ __forceinline__ void p6_job(Frame& F, const Args& a, int job) {
    const int tid = F.tid, lane = F.lane, wave = F.wave;
    LAS _Float16* WR = (LAS _Float16*)F.lds;
    LAS float* LG = (LAS float*)(F.lds + 99072) + wave * 768;
    LAS int* SLE = (LAS int*)(F.lds + 99072 + 24576);
    LAS float* SLW = (LAS float*)(F.lds + 99072 + 24576 + 1024);
    LAS int* LCNT = (LAS int*)(F.lds + 99072 + 24576 + 2048);
    LAS int* LBASE = LCNT + 32; LAS int* LRANK = LCNT + 64;
    const bf16* pre = (const bf16*)(F.ws + WS_PREB); const f32x2* stats = (const f32x2*)(F.ws + WS_STATS);
    const float* g1 = (const float*)a.in[18]; const float* b1 = (const float*)a.in[19];
    bf16* hb = (bf16*)(F.ws + WS_HB);
    if (tid < 32) LCNT[tid] = 0;
    const int r0 = job * 128 + wave * 16; const int row = r0 + (lane & 15), kg = lane >> 4;
    float mean, rstd;
    { const f32x4* sp = (const f32x4*)(stats + (size_t)row * 16); float ms = 0.f; f32x4 q[8];
#pragma unroll
        for (int j = 0; j < 8; ++j) { q[j] = sp[j]; ms += q[j][0] + q[j][2]; }
        mean = ms * (1.0f / 16.0f); float m2 = 0.f;
#pragma unroll
        for (int j = 0; j < 8; ++j) { const float d0 = q[j][0] - mean, d1 = q[j][2] - mean; m2 += q[j][1] + q[j][3] + 64.0f * (d0 * d0 + d1 * d1); }
        rstd = 1.0f / sqrtf(m2 * (1.0f / 1024.0f) + LN_EPS); }
    f32x4 acc[3] = {(f32x4){0.f, 0.f, 0.f, 0.f}, (f32x4){0.f, 0.f, 0.f, 0.f}, (f32x4){0.f, 0.f, 0.f, 0.f}};
    const LAS float* GL = (const LAS float*)(F.lds + LDSCTL_OFF + 4096);
    v4u xq[8];
#pragma unroll
    for (int j = 0; j < 8; ++j) xq[j] = *(const v4u*)(pre + (size_t)row * DM + j * 32 + kg * 8);
#pragma unroll 1
    for (int kb = 0; kb < 4; ++kb) {
#pragma unroll
        for (int j = 0; j < 8; ++j) {
            const int ks = kb * 8 + j; const int col = ks * 32 + kg * 8;
            const v4u xw = xq[j];
            if (kb < 3) xq[j] = *(const v4u*)(pre + (size_t)row * DM + col + 256);
            const f32x4 x0 = (f32x4){bf_lo(xw.x), bf_hi(xw.x), bf_lo(xw.y), bf_hi(xw.y)}, x1 = (f32x4){bf_lo(xw.z), bf_hi(xw.z), bf_lo(xw.w), bf_hi(xw.w)};
            const f32x4 ga = *(const LAS f32x4*)(GL + col), gb = *(const LAS f32x4*)(GL + col + 4), ba = *(const LAS f32x4*)(GL + 1024 + col), bb = *(const LAS f32x4*)(GL + 1024 + col + 4);
            const f32x4 h0 = (x0 - mean) * rstd * ga + ba, h1 = (x1 - mean) * rstd * gb + bb;
            v4u w; w.x = cvtpk(h0[0], h0[1]); w.y = cvtpk(h0[2], h0[3]); w.z = cvtpk(h1[0], h1[1]); w.w = cvtpk(h1[2], h1[3]);
            *(v4u*)(hb + (size_t)row * DM + col) = w;
            f16x8 af; af[0] = (_Float16)h0[0]; af[1] = (_Float16)h0[1]; af[2] = (_Float16)h0[2]; af[3] = (_Float16)h0[3]; af[4] = (_Float16)h1[0]; af[5] = (_Float16)h1[1]; af[6] = (_Float16)h1[2]; af[7] = (_Float16)h1[3];
#pragma unroll
            for (int ntile = 0; ntile < 3; ++ntile) { const f16x8 bf = *(const LAS f16x8*)(WR + (ntile * 16 + (lane & 15)) * 1032 + col);
                acc[ntile] = __builtin_amdgcn_mfma_f32_16x16x32_f16(af, bf, acc[ntile], 0, 0, 0); }
        }
    }
#pragma unroll
    for (int ntile = 0; ntile < 3; ++ntile)
#pragma unroll
        for (int i = 0; i < 4; ++i) LG[(4 * kg + i) * 48 + ntile * 16 + (lane & 15)] = acc[ntile][i];
    LDS_WAIT(); asm volatile("" ::: "memory");
    if (lane < 16) {
        const LAS float* L = LG + lane * 48;
        float gm = L[0]; int gi = 0;
#pragma unroll
        for (int j = 1; j < 4; ++j) { const float v = L[j]; if (v > gm) { gm = v; gi = j; } }
        float gs = 0.f;
#pragma unroll
        for (int j = 0; j < 4; ++j) gs += __expf(L[j] - gm);
        const float gp = 1.0f / gs;
        float ev[8];
#pragma unroll
        for (int j = 0; j < 8; ++j) ev[j] = L[4 + gi * 8 + j];
        float m1 = ev[0]; int i1 = 0;
#pragma unroll
        for (int j = 1; j < 8; ++j) if (ev[j] > m1) { m1 = ev[j]; i1 = j; }
        float m2 = -INFINITY; int i2 = 0;
#pragma unroll
        for (int j = 0; j < 8; ++j) if (j != i1 && ev[j] > m2) { m2 = ev[j]; i2 = j; }
        const float ex = __expf(m2 - m1); const float w1 = 1.0f / (1.0f + ex), w2 = ex * w1;
        const int sl = (wave * 16 + lane) * 2;
        SLE[sl] = gi * 8 + i1; SLE[sl + 1] = gi * 8 + i2; SLW[sl] = gp * w1; SLW[sl + 1] = gp * w2;
    }
    __syncthreads();
    int e = 0;
    if (tid < 256) { e = SLE[tid]; LRANK[tid] = __hip_atomic_fetch_add(LCNT + e, 1, __ATOMIC_RELAXED, __HIP_MEMORY_SCOPE_WORKGROUP); }
    __syncthreads();
    if (tid < 32) LBASE[tid] = (int)__hip_atomic_fetch_add((gu32*)(F.ws + WS_CTL) + CW_GCNT + tid, (unsigned)LCNT[tid], RLX_AGENT);
    __syncthreads();
    if (tid < 256) { const int pos = LBASE[e] + LRANK[tid];
        ((int*)(F.ws + WS_ESLOT))[e * 65536 + pos] = job * 256 + tid; ((float*)(F.ws + WS_EW))[e * 65536 + pos] = SLW[tid]; }
    __syncthreads();
}

__device__ __forceinline__ int moe_layout(Frame& F, LAS int* pstart) {
    LAS int* tile_e = (LAS int*)(F.lds + TILE_E_OFF); LAS int* ecnt = pstart + 40;
    if (F.tid < 64) { const int e = F.tid & 31;
        const int c = (int)__hip_atomic_load((gu32*)(F.ws + WS_CTL) + CW_GCNT + e, RLX_AGENT); const int nf = c >> 8, hp = (c & 255) ? 1 : 0;
        int inf = nf, inp = hp;
#pragma unroll
        for (int o = 1; o < 32; o <<= 1) { const int v = __shfl_up(inf, o, 32), w = __shfl_up(inp, o, 32); if (e >= o) { inf += v; inp += w; } }
        const int totf = __shfl(inf, 31, 32), totp = __shfl(inp, 31, 32);
        if (F.tid < 32) { ecnt[e] = c; if (e == 0) pstart[32] = (totf + totp) << 8;
            const int sf = inf - nf; for (int t = 0; t < nf; ++t) tile_e[sf + t] = e | (t << 8);
            if (hp) tile_e[totf + inp - 1] = e | (nf << 8); } }
    __syncthreads();
    return pstart[NEXP] >> 8;
}

__global__ void __launch_bounds__(NWAVES * 64, 2) trunk_fwd(Args args) {
    extern __shared__ __attribute__((aligned(16))) unsigned char lds[];
    Frame F; F.lds = (LAS unsigned char*)lds; F.ws = args.ws; F.tid = threadIdx.x; F.lane = F.tid & 63; F.wave = __builtin_amdgcn_readfirstlane(F.tid >> 6); F.G = gridDim.x; F.bid = blockIdx.x;
    volatile LAS unsigned* MISC = (volatile LAS unsigned*)(F.lds + MISC_OFF);
    LAS int* PSTART = (LAS int*)(F.lds + LDSCTL_OFF);
    for (int u = F.tid; u < (LDS_BYTES - LDSCTL_OFF) / 4; u += NWAVES * 64) ((LAS unsigned*)(F.lds + LDSCTL_OFF))[u] = 0u;
    __syncthreads();
    gu32* ctl = (gu32*)(args.ws + WS_CTL);
    const int lo = args.ph_lo, hi = args.ph_hi;
    const bool multi = (hi - lo) > 1;
    XcdBarrier bar; bar.bar = (unsigned*)ctl + CW_BAR + args.li * XCD_BAR_WORDS; bar.x = 0; bar.st = nullptr;
    if (multi) bar = xcd_barrier_post((unsigned*)ctl + CW_BAR + args.li * XCD_BAR_WORDS, MISC + 8);
#define IN(k) (lo <= (k) && (k) < hi)
#define SEAM(k) do { if (IN(k) && IN((k) + 1)) xcd_barrier(bar); } while (0)
    bf16* const XB = (bf16*)(args.ws + WS_XB); bf16* const PROJ = (bf16*)(args.ws + WS_PROJ); bf16* const UPERM = (bf16*)(args.ws + WS_UPERM);
    bf16* const ZB = (bf16*)(args.ws + WS_Z); bf16* const CAT = (bf16*)(args.ws + WS_CAT); bf16* const HB = (bf16*)(args.ws + WS_HB);
    bf16* const HID = (bf16*)(args.ws + WS_HID); bf16* const Y2 = (bf16*)(args.ws + WS_Y2); bf16* const PREB = (bf16*)(args.ws + WS_PREB);

    if (IN(0)) { p0_prologue(F, args); }
    SEAM(0);
    if (IN(1)) {
        pg8::DenseOrder S; S.init(XB, args.ws + WS_WIN_T, 1024, 1024, TOK, NPROJ, F.G, F.bid);
        pg8::EpiInProj E{PROJ, PROJ + (size_t)TOK * 512, PROJ + (size_t)TOK * 1024, UPERM};
        pg8::gemm_phase<pg8::EpiInProj, pg8::DenseOrder, true>(F.lds, 1024, 1024, 1024, S, E);
    }
    SEAM(1);
    if (IN(2)) {
        for (int u = F.bid; u < 64; u += F.G) {
            const int g = u >> 1, pm = u & 1;
            pg8::OneUnit S; S.A = (const char*)(UPERM + (size_t)(g * 512 + pm * 256) * UP_PITCH); S.Bt = (const char*)((bf16*)(args.ws + WS_WSIN) + (size_t)g * 256 * 1024); S.u0 = pg8::Unit{pm, 0, g};
            pg8::EpiState E{args.out};
            pg8::gemm_phase<pg8::EpiState, pg8::OneUnit, true>(F.lds, 1024, UP_PITCH, 1024, S, E);
        }
        const float* lq1 = (const float*)args.in[2]; const float* lk1 = (const float*)args.in[3]; const float* lq2 = (const float*)args.in[4]; const float* lk2 = (const float*)args.in[5];
        const float s1 = wave_sum(lq1[F.lane] * lk1[F.lane]), s2 = wave_sum(lq2[F.lane] * lk2[F.lane]);
        const float lam = expf(s1) - expf(s2) + LAM_INIT;
        const int vcu = (F.G % 8 == 0) ? (F.bid % 8) * (F.G / 8) + F.bid / 8 : F.bid;
        for (int v = vcu; v < 256; v += F.G) {
            const int xg = v >> 5, j = v & 31;
#pragma unroll 1
            for (int i = 0; i < 4; ++i) { const int bh = xg * 4 + i; const int qb = (i & 1) ? 31 - j : j;
                att::attn_unit(bh >> 2, bh & 3, qb, PROJ, CAT, (char*)lds, lam, (const float*)args.in[6]); }
        }
    }
    SEAM(2);
    if (IN(3)) {
        for (int u = F.bid; u < 256; u += F.G) {
            const int g = u >> 3, pm = (u >> 2) & 1, pn = u & 3;
            p3_scan(F, args.out, g, pm);
            pg8::SsmUnit S; S.A = (const char*)(UPERM + (size_t)(g * 512 + pm * 256) * UP_PITCH); S.Bt = (const char*)((bf16*)(args.ws + WS_TOEP) + (size_t)(g * 1024 + pn * 256) * UP_PITCH); S.u0 = pg8::Unit{pm, pn, g}; S.first = 8 * (pn >> 1); S.cnt = 4 * (pn & 1) + 4; S.st = 16 + 2 * (pn >> 1);
            pg8::EpiSsmOut E{UPERM, (const float*)args.in[14], ZB};
            pg8::gemm_phase<pg8::EpiSsmOut, pg8::SsmUnit, true>(F.lds, UP_PITCH, UP_PITCH, UP_PITCH, S, E);
        }
    }
    SEAM(3);
    if (IN(4)) {
        pg8::DenseOrder S; S.init(ZB, args.ws + WS_WGLU_T, 512, 512, TOK, SSMW, F.G, F.bid);
        pg8::EpiGlu E{ZB, (const float*)args.in[16], CAT};
        pg8::gemm_phase<pg8::EpiGlu, pg8::DenseOrder, true>(F.lds, 512, 512, 512, S, E);
    }
    SEAM(4);
    if (IN(5)) {
        pg8::DenseOrder S; S.init(CAT, args.ws + WS_WOUT_T, 1024, 1024, TOK, DM, F.G, F.bid);
        pg8::EpiOutProj E{XB, PREB, (f32x2*)(args.ws + WS_STATS)};
        pg8::gemm_phase<pg8::EpiOutProj, pg8::DenseOrder, true>(F.lds, 1024, 1024, 1024, S, E);
    }
    SEAM(5);
    if (IN(6)) {
        {
            LAS _Float16* WR = (LAS _Float16*)F.lds; const float* wrg = (const float*)args.in[20]; const float* wre = (const float*)args.in[21];
            for (int q = F.tid; q < 1024 * 4; q += 512) { const int k = q >> 2, n = q & 3; WR[n * 1032 + k] = (_Float16)wrg[q]; }
            for (int q = F.tid; q < 1024 * 32; q += 512) { const int k = q >> 5, n = q & 31; WR[(4 + n) * 1032 + k] = (_Float16)wre[q]; }
            for (int q = F.tid; q < 12 * 1032; q += 512) WR[36 * 1032 + q] = (_Float16)0.f;
            LAS float* GL = (LAS float*)(F.lds + LDSCTL_OFF + 4096); const float* g1_ = (const float*)args.in[18]; const float* b1_ = (const float*)args.in[19];
            for (int q = F.tid; q < 1024; q += 512) { GL[q] = g1_[q]; GL[1024 + q] = b1_[q]; }
        }
        __syncthreads();
        for (int job = F.bid; job < 256; job += F.G) p6_job(F, args, job);
    }
    SEAM(6);
    if (IN(8)) {
        const int ntiles = moe_layout(F, PSTART);
        pg8::MoeOrder<true> S; S.A = (const char*)HB; S.W = (const char*)(args.ws + WS_WG1); S.eslot = (const int*)(args.ws + WS_ESLOT); S.tile_e = (const LAS int*)(F.lds + TILE_E_OFF); S.ecnt = PSTART + 40; S.ntiles = ntiles; S.G = F.G; S.c = F.bid; S.lda = 1024; S.ldb = 1024;
        { const int per = F.G >> 5, chunk = (ntiles + 7) >> 3; S.lt_lim = (chunk / per) * per; }
        pg8::EpiMoe1 E{HID};
        pg8::gemm_phase<pg8::EpiMoe1, pg8::MoeOrder<true>, true>(F.lds, 1024, 1024, 1024, S, E);
    }
    SEAM(8);
    if (IN(9)) {
        const int ntiles = moe_layout(F, PSTART);
        const int x = F.bid & 7, j = F.bid >> 3, per = F.G >> 5, chunk = (ntiles + 7) >> 3, lt_main = (chunk / per) * per;
        int tiles_x = ntiles - x * chunk; tiles_x = tiles_x < 0 ? 0 : (tiles_x > chunk ? chunk : tiles_x);
        const int tail0 = lt_main < tiles_x ? lt_main : tiles_x; const int P = 4 * (tiles_x - tail0), U = 4 * tiles_x;
        const LAS int* tile_e = (const LAS int*)(F.lds + TILE_E_OFF);
        if (j < P) {
            pg8::MoeUnits<true> S; S.A = (const char*)HB; S.W = (const char*)(args.ws + WS_WG1); S.eslot = (const int*)(args.ws + WS_ESLOT); S.tile_e = tile_e; S.ecnt = PSTART + 40;
            S.tile0 = x * chunk; S.u_lo = 4 * tail0 + j; S.u_hi = S.u_lo + 1; S.lda = 1024; S.ldb = 1024;
            pg8::EpiMoe1T<true> E{HID};
            pg8::gemm_phase<pg8::EpiMoe1T<true>, pg8::MoeUnits<true>, true>(F.lds, 1024, 1024, 1024, S, E);
            if (F.tid == 0) __hip_atomic_fetch_add(ctl + CW_TAILCNT + x * chunk + tail0 + (j >> 2), 1u, RLX_AGENT);
        }
        const int tot = U + P, E_ = tot >> 5, rem = tot & 31, A_ = 32 - rem;
        const int sA = P < A_ ? P : A_, sB = P < A_ ? A_ : P;
        const int quota = E_ - 1 + (j >= sA ? 1 : 0) + (j >= sB ? 1 : 0);
        pg8::MoeRounds S; S.A = (const char*)HID; S.W = (const char*)(args.ws + WS_WD); S.tile_e = tile_e; S.ecnt = PSTART + 40; S.tile0 = x * chunk; S.j = j; S.E = E_; S.sA = sA; S.sB = sB; S.lda = 512; S.ldb = 512;
        int r_split = quota; for (int r = quota - 1; r >= 0; --r) if (S.lt_of(r) >= tail0) r_split = r;
        pg8::EpiMoe2 E{(const int*)(args.ws + WS_ESLOT), (const float*)(args.ws + WS_EW), PSTART + 40, Y2};
        S.r_lo = 0; S.r_hi = r_split;
        pg8::gemm_phase<pg8::EpiMoe2, pg8::MoeRounds, true>(F.lds, 512, 512, 512, S, E);
        if (quota > r_split) {
            if (F.tid == 0) {
                for (int r = r_split; r < quota; ++r) { gu32* cw = ctl + CW_TAILCNT + x * chunk + S.lt_of(r); unsigned sp = 0;
                    while (__hip_atomic_load(cw, RLX_AGENT) < 4u) { __builtin_amdgcn_s_sleep(2); if (++sp > (1u << 22)) break; } }
                __builtin_amdgcn_fence(__ATOMIC_ACQUIRE, "agent"); asm volatile("s_waitcnt vmcnt(0)" ::: "memory");
            }
            __syncthreads();
            S.r_lo = r_split; S.r_hi = quota;
            pg8::gemm_phase<pg8::EpiMoe2, pg8::MoeRounds, true>(F.lds, 512, 512, 512, S, E);
        }
    }
    SEAM(9);
    if (IN(10)) {
        const int gw = F.bid * NWAVES + F.wave, NGW = F.G * NWAVES;
        const float* g2 = (const float*)args.in[25]; const float* b2 = (const float*)args.in[26];
        for (int m = gw; m < TOK; m += NGW) {
            const GAS v2u* hr = (const GAS v2u*)(HB + (size_t)m * DM) + F.lane; const GAS v2u* y0 = (const GAS v2u*)(Y2 + (size_t)(2 * m) * DM) + F.lane; const GAS v2u* y1 = (const GAS v2u*)(Y2 + (size_t)(2 * m + 1) * DM) + F.lane;
            f32x4 v[4]; float s = 0.f;
#pragma unroll
            for (int j = 0; j < 4; ++j) { const v2u a = hr[64 * j], b = y0[64 * j], c = y1[64 * j];
                v[j][0] = ALPHA * bf_lo(a.x) + bf_lo(b.x) + bf_lo(c.x); v[j][1] = ALPHA * bf_hi(a.x) + bf_hi(b.x) + bf_hi(c.x);
                v[j][2] = ALPHA * bf_lo(a.y) + bf_lo(b.y) + bf_lo(c.y); v[j][3] = ALPHA * bf_hi(a.y) + bf_hi(b.y) + bf_hi(c.y);
                s += (v[j][0] + v[j][1]) + (v[j][2] + v[j][3]); }
            const float mean = wave_sum(s) * (1.f / DM); float s2 = 0.f;
#pragma unroll
            for (int j = 0; j < 4; ++j) { v[j] = v[j] - mean; s2 += (v[j][0] * v[j][0] + v[j][1] * v[j][1]) + (v[j][2] * v[j][2] + v[j][3] * v[j][3]); }
            const float rstd = 1.f / sqrtf(wave_sum(s2) * (1.f / DM) + LN_EPS);
            GAS f32x4* o = (GAS f32x4*)(args.out + (size_t)m * DM) + F.lane;
#pragma unroll
            for (int j = 0; j < 4; ++j) { const f32x4 gg = *((const GAS f32x4*)g2 + F.lane + 64 * j), bb = *((const GAS f32x4*)b2 + F.lane + 64 * j); o[64 * j] = v[j] * rstd * gg + bb; }
        }
    }
#undef IN
#undef SEAM
}

extern "C" void kernel_launch(void* const* d_in, const int* in_sizes, int n_in, void* d_out, int out_size, void* d_ws, size_t ws_size, hipStream_t stream) {
    static int grid = 0;
    if (grid == 0) {
        if (n_in != 27 || in_sizes[0] != TOK * DM || out_size != TOK * DM || ws_size < WS_END) { fprintf(stderr, "kernel_launch: unexpected shapes (n_in %d, in0 %d, out %d, ws %zu); nothing launched\n", n_in, n_in > 0 ? in_sizes[0] : -1, out_size, ws_size); grid = -1; return; }
        int dev = 0, cus = 0, per_cu = 0;
        if (hipGetDevice(&dev) != hipSuccess || hipDeviceGetAttribute(&cus, hipDeviceAttributeMultiprocessorCount, dev) != hipSuccess) { fprintf(stderr, "kernel_launch: device query failed\n"); grid = -1; return; }
        if (hipFuncSetAttribute((const void*)trunk_fwd, hipFuncAttributeMaxDynamicSharedMemorySize, LDS_BYTES) != hipSuccess) { fprintf(stderr, "kernel_launch: hipFuncSetAttribute failed\n"); grid = -1; return; }
        if (hipOccupancyMaxActiveBlocksPerMultiprocessor(&per_cu, (const void*)trunk_fwd, NWAVES * 64, LDS_BYTES) != hipSuccess || per_cu < 1) { fprintf(stderr, "kernel_launch: occupancy query reports %d blocks per CU\n", per_cu); per_cu = 1; }
        (void)hipGetLastError();
        grid = cus;
        if (grid != 256) fprintf(stderr, "kernel_launch: note: %d CUs (kernel tuned for 256)\n", grid);
    }
    if (grid < 0) return;
    (void)hipMemsetAsync((char*)d_ws + WS_CTL, 0, CTL_ZERO_BYTES, stream);
    Args a{};
    for (int i = 0; i < 27; ++i) a.in[i] = d_in[i];
    a.out = (float*)d_out; a.ws = (unsigned char*)d_ws;
    if (PROBE_DUP >= 0) { a.ph_lo = 0; a.ph_hi = PROBE_DUP + 1; a.li = 0; hipLaunchKernelGGL(trunk_fwd, dim3(grid), dim3(NWAVES * 64), LDS_BYTES, stream, a);
        a.ph_lo = PROBE_DUP; a.ph_hi = NPHASES; a.li = 1; hipLaunchKernelGGL(trunk_fwd, dim3(grid), dim3(NWAVES * 64), LDS_BYTES, stream, a); }
    else if (MK_N_LAUNCHES == 1) { a.ph_lo = 0; a.ph_hi = NPHASES; hipLaunchKernelGGL(trunk_fwd, dim3(grid), dim3(NWAVES * 64), LDS_BYTES, stream, a); }
    else { for (int p = 0; p < NPHASES; ++p) { a.ph_lo = p; a.ph_hi = p + 1; hipLaunchKernelGGL(trunk_fwd, dim3(grid), dim3(NWAVES * 64), LDS_BYTES, stream, a); } }
}
```

```cpp
#include <hip/hip_runtime.h>
#include <cstdio>
#include <cstdint>
#include <cmath>

#ifndef MK_N_LAUNCHES
#define MK_N_LAUNCHES 1
#endif
#ifndef PROBE_DUP
#define PROBE_DUP (-1)
#endif

constexpr int BATCH = 8, SEQ = 4096, DM = 1024, TOK = BATCH * SEQ;
constexpr int NPROJ = 2048, QKV_PITCH = 1536;
constexpr int NGRP = 32, GCH = 16, NSTATE = 64, SSMW = 512;
constexpr int NEXP = 32, DEXP = 512;
constexpr int UP_PITCH = 1280;
constexpr float LN_EPS = 1e-5f, RMS_EPS = 1e-5f;
constexpr float ALPHA = 1.189207115002721f;
constexpr float QSCALE = 0.125f * 1.4426950408889634f;
constexpr float LAM_INIT = 0.2f;
constexpr int MOE_MAXTILES = 288;
constexpr int MOE_MAXROWS = MOE_MAXTILES * 256;

constexpr size_t MiB = 1u << 20;
constexpr size_t WS_CTL = 0, CTL_ZERO_BYTES = 64 * 1024;
constexpr size_t WS_STATS = 1 * MiB;
constexpr size_t WS_LAMB = 7 * MiB + 512 * 1024;
constexpr size_t WS_WIN_T = 8 * MiB;
constexpr size_t WS_WOUT_T = 12 * MiB;
constexpr size_t WS_WGLU_T = 14 * MiB;
constexpr size_t WS_WG1 = 24 * MiB;
constexpr size_t WS_WD = 88 * MiB;
constexpr size_t WS_TOEP = 120 * MiB;
constexpr size_t WS_HB = 120 * MiB;
constexpr size_t WS_WSIN = 200 * MiB;
constexpr size_t WS_ESLOT = 200 * MiB;
constexpr size_t WS_EW = 208 * MiB;
constexpr size_t WS_XB = 216 * MiB;
constexpr size_t WS_PROJ = 280 * MiB;
constexpr size_t WS_UPERM = 376 * MiB;
constexpr size_t WS_PREB = 280 * MiB;
constexpr size_t WS_Y2 = 280 * MiB;
constexpr size_t WS_Z = 416 * MiB;
constexpr size_t WS_CAT = 448 * MiB;
constexpr size_t WS_HID = 416 * MiB;
constexpr size_t WS_END = 512 * MiB;
static_assert(WS_Y2 + (size_t)(65536 + 256) * 1024 * 2 <= WS_Z && WS_TOEP + (size_t)32 * 1024 * UP_PITCH * 2 <= WS_WSIN && WS_XB + (size_t)TOK * DM * 2 <= WS_PROJ && WS_PROJ + (size_t)TOK * 1536 * 2 <= WS_UPERM, "ws map");
static_assert(WS_HID + (size_t)MOE_MAXROWS * 512 * 2 <= WS_END, "HID overlay");
static_assert(WS_UPERM + (size_t)32 * 512 * UP_PITCH * 2 <= WS_Z, "UPERM");
constexpr int CW_TMO = 0, CW_CODE = 1;
constexpr int CW_GCNT = 64;
constexpr int CW_TAILCNT = 128;
constexpr int CW_BAR = 4096;

constexpr int RING_BYTES = 131072;
constexpr int LDSCTL_OFF = RING_BYTES, MISC_OFF = LDSCTL_OFF + 320, TILE_E_OFF = LDSCTL_OFF + 512;
constexpr int LDS_BYTES = 147456;

#define GAS __attribute__((address_space(1)))
#define LAS __attribute__((address_space(3)))
typedef unsigned short bf16;
typedef unsigned v4u __attribute__((ext_vector_type(4)));
typedef unsigned v2u __attribute__((ext_vector_type(2)));
typedef float f32x4 __attribute__((ext_vector_type(4)));
typedef float f32x2 __attribute__((ext_vector_type(2)));
typedef float f32x16 __attribute__((ext_vector_type(16)));
typedef short bf16x8 __attribute__((ext_vector_type(8)));
typedef short s16x4 __attribute__((ext_vector_type(4)));
typedef _Float16 f16x8 __attribute__((ext_vector_type(8)));
typedef __bf16 bf16x2_t __attribute__((ext_vector_type(2)));
typedef GAS unsigned gu32;
#define RLX_AGENT __ATOMIC_RELAXED, __HIP_MEMORY_SCOPE_AGENT
#define LDS_WAIT() asm volatile("s_waitcnt lgkmcnt(0)" ::: "memory")
#define VM_WAIT() asm volatile("s_waitcnt vmcnt(0)" ::: "memory")

__device__ __forceinline__ unsigned cvtpk(float lo, float hi) { f32x2 v = {lo, hi}; bf16x2_t b = __builtin_convertvector(v, bf16x2_t); return __builtin_bit_cast(unsigned, b); }
__device__ __forceinline__ float bf_lo(unsigned w) { return __uint_as_float(w << 16); }
__device__ __forceinline__ float bf_hi(unsigned w) { return __uint_as_float(w & 0xffff0000u); }
__device__ __forceinline__ float fexp2(float x) { return __builtin_amdgcn_exp2f(x); }
__device__ __forceinline__ float frcp(float x) { return __builtin_amdgcn_rcpf(x); }
__device__ __forceinline__ float sigmoidf_(float x) { return frcp(1.0f + fexp2(-1.4426950408889634f * x)); }
__device__ __forceinline__ float gelu_tanh(float y) { const float t = y * (1.0f + 0.044715f * y * y) * (-2.302208198f); return y * frcp(1.0f + fexp2(t)); }
__device__ __forceinline__ float wave_sum(float v) {
#pragma unroll
    for (int o = 1; o < 64; o <<= 1) v += __shfl_xor(v, o);
    return v;
}

namespace pg8 {
#define PG8_LAS __attribute__((address_space(3)))
constexpr int BM = 256, BK = 64, HALF = 128, HTB = HALF * BK * 2, STAGE_BYTES = 8 * HTB, NXCD = 8, WGM = 8;
__host__ __device__ __forceinline__ int lds_byte(int r, int c) { const int st = (r >> 4) * 2 + (c >> 5), rr = r & 15, cc = c & 31, ob = rr * 64 + cc * 2; return st * 1024 + (ob ^ (((ob >> 9) & 1) << 5)); }
__host__ __device__ __forceinline__ void stage_rc(int b, int& R, int& C) { const int st = b / 1024, sb = b % 1024, swz = sb ^ (((sb >> 9) & 1) << 5); R = (st >> 1) * 16 + swz / 64; C = (st & 1) * 32 + (swz % 64) / 2; }
__host__ __device__ __forceinline__ int perm32(int rho) { const int n = rho >> 4, i = rho & 15; return 8 * (i >> 2) + 4 * n + (i & 3); }

struct Unit { int pm, pn, aux; };

struct DenseOrder {
    static constexpr bool GATHER = false, KMAP = false;
    __device__ __forceinline__ int nt() const { return 0; }
    __device__ __forceinline__ size_t koff(int t) const { return (size_t)t * 128; }
    __device__ __forceinline__ bool half(const Unit&) const { return false; }
    const char* A; const char* Bt; int lda, ldb; int nM, nN, nwg, G, c;
    __device__ void init(const void* A_, const void* Bt_, int lda_, int ldb_, int M, int N, int G_, int c_) { A = (const char*)A_; Bt = (const char*)Bt_; lda = lda_; ldb = ldb_; nM = M / BM; nN = N / BM; nwg = nM * nN; G = G_; c = c_; }
    __device__ bool next(int i, Unit& u) const {
        const long L = (long)i * G + c; if (L >= nwg) return false;
        int wgid = (int)L; { const int q = nwg / NXCD, r = nwg % NXCD, xcd = wgid % NXCD, off = wgid / NXCD; wgid = (xcd < r ? xcd * (q + 1) : r * (q + 1) + (xcd - r) * q) + off; }
        const int nig = WGM * nN, gid = wgid / nig, fm = gid * WGM, gsz = (nM - fm) < WGM ? (nM - fm) : WGM;
        u.pm = fm + ((wgid % nig) % gsz); u.pn = (wgid % nig) / gsz; u.aux = 0; return true;
    }
    __device__ __forceinline__ const char* a_ptr(const Unit& u) const { return A + (size_t)u.pm * BM * lda * 2; }
    __device__ __forceinline__ const char* b_ptr(const Unit& u) const { return Bt + (size_t)u.pn * BM * ldb * 2; }
    __device__ __forceinline__ void gather(const Unit&, const int*, const int*, unsigned*, unsigned*) const {}
};
struct OneUnit {
    static constexpr bool GATHER = false, KMAP = false;
    __device__ __forceinline__ int nt() const { return 0; }
    __device__ __forceinline__ size_t koff(int t) const { return (size_t)t * 128; }
    __device__ __forceinline__ bool half(const Unit&) const { return false; }
    const char* A; const char* Bt; Unit u0;
    __device__ bool next(int i, Unit& u) const { if (i > 0) return false; u = u0; return true; }
    __device__ __forceinline__ const char* a_ptr(const Unit&) const { return A; }
    __device__ __forceinline__ const char* b_ptr(const Unit&) const { return Bt; }
    __device__ __forceinline__ void gather(const Unit&, const int*, const int*, unsigned*, unsigned*) const {}
};
struct SsmUnit {
    static constexpr bool GATHER = false, KMAP = true;
    const char* A; const char* Bt; Unit u0; int first, cnt, st;
    __device__ bool next(int i, Unit& u) const { if (i > 0) return false; u = u0; return true; }
    __device__ __forceinline__ const char* a_ptr(const Unit&) const { return A; }
    __device__ __forceinline__ const char* b_ptr(const Unit&) const { return Bt; }
    __device__ __forceinline__ void gather(const Unit&, const int*, const int*, unsigned*, unsigned*) const {}
    __device__ __forceinline__ int nt() const { return cnt + 2; }
    __device__ __forceinline__ bool half(const Unit&) const { return false; }
    __device__ __forceinline__ size_t koff(int t) const { return (size_t)((t < cnt) ? first + t : st + (t - cnt)) * 128; }
};
template <bool GATHER_> struct MoeOrder {
    static constexpr bool GATHER = GATHER_, KMAP = false;
    __device__ __forceinline__ int nt() const { return 0; }
    __device__ __forceinline__ size_t koff(int t) const { return (size_t)t * 128; }
    const char* A; const char* W; const int* eslot; const PG8_LAS int* tile_e; const PG8_LAS int* ecnt; int ntiles, G, c, lda, ldb, lt_lim;
    __device__ bool next(int i, Unit& u) const { const int x = c & 7, j = c >> 3, per = G >> 5;
        const int chunk = (ntiles + 7) >> 3; const int lt = i * per + (j >> 2); const int rt = x * chunk + lt;
        if ((j >> 2) >= per || lt >= chunk || lt >= lt_lim || rt >= ntiles) return false; u.pm = rt; u.pn = j & 3; u.aux = tile_e[rt]; return true; }
    __device__ __forceinline__ bool half(const Unit& u) const { return ecnt[u.aux & 255] - (u.aux >> 8) * BM <= HALF; }
    __device__ __forceinline__ const char* a_ptr(const Unit& u) const { return GATHER_ ? A : A + (size_t)u.pm * BM * lda * 2; }
    __device__ __forceinline__ const char* b_ptr(const Unit& u) const { return W + ((size_t)(u.aux & 255) * 1024 + (size_t)u.pn * BM) * ldb * 2; }
    __device__ __forceinline__ void gather(const Unit& u, const int* RA, const int* CA, unsigned* v0, unsigned* v1) const {
        const int e = u.aux & 255, r0 = (u.aux >> 8) * BM, cnt = ecnt[e];
#pragma unroll
        for (int i = 0; i < 2; ++i) { const int i0 = r0 + RA[i], i1 = i0 + HALF;
            const int t0 = (i0 < cnt) ? (eslot[e * 65536 + i0] >> 1) : 0, t1 = (i1 < cnt) ? (eslot[e * 65536 + i1] >> 1) : 0;
            v0[i] = (unsigned)(t0 * lda + CA[i]) * 2u; v1[i] = (unsigned)(t1 * lda + CA[i]) * 2u; }
    }
};

template <bool GATHER_> struct MoeUnits {
    static constexpr bool GATHER = GATHER_, KMAP = false;
    __device__ __forceinline__ int nt() const { return 0; }
    __device__ __forceinline__ size_t koff(int t) const { return (size_t)t * 128; }
    const char* A; const char* W; const int* eslot; const PG8_LAS int* tile_e; const PG8_LAS int* ecnt; int tile0, u_lo, u_hi, lda, ldb;
    __device__ bool next(int i, Unit& u) const { const int q = u_lo + i; if (q >= u_hi) return false; u.pm = tile0 + (q >> 2); u.pn = q & 3; u.aux = tile_e[u.pm]; return true; }
    __device__ __forceinline__ bool half(const Unit& u) const { return ecnt[u.aux & 255] - (u.aux >> 8) * BM <= HALF; }
    __device__ __forceinline__ const char* a_ptr(const Unit& u) const { return GATHER_ ? A : A + (size_t)u.pm * BM * lda * 2; }
    __device__ __forceinline__ const char* b_ptr(const Unit& u) const { return W + ((size_t)(u.aux & 255) * 1024 + (size_t)u.pn * BM) * ldb * 2; }
    __device__ __forceinline__ void gather(const Unit& u, const int* RA, const int* CA, unsigned* v0, unsigned* v1) const {
        const int e = u.aux & 255, r0 = (u.aux >> 8) * BM, cnt = ecnt[e];
#pragma unroll
        for (int i = 0; i < 2; ++i) { const int i0 = r0 + RA[i], i1 = i0 + HALF;
            const int t0 = (i0 < cnt) ? (eslot[e * 65536 + i0] >> 1) : 0, t1 = (i1 < cnt) ? (eslot[e * 65536 + i1] >> 1) : 0;
            v0[i] = (unsigned)(t0 * lda + CA[i]) * 2u; v1[i] = (unsigned)(t1 * lda + CA[i]) * 2u; }
    }
};

struct MoeRounds {
    static constexpr bool GATHER = false, KMAP = false;
    __device__ __forceinline__ int nt() const { return 0; }
    __device__ __forceinline__ size_t koff(int t) const { return (size_t)t * 128; }
    const char* A; const char* W; const PG8_LAS int* tile_e; const PG8_LAS int* ecnt; int tile0, j, E, sA, sB, r_lo, r_hi, lda, ldb;
    __device__ __forceinline__ int lt_of(int r) const { const int s = r < E - 1 ? 0 : (r == E - 1 ? sA : sB); const int base = r < E ? 8 * r : 8 * (E - 1) + ((32 - sA) >> 2); return base + ((j - s) >> 2); }
    __device__ bool next(int i, Unit& u) const { const int r = r_lo + i; if (r >= r_hi) return false; const int s = r < E - 1 ? 0 : (r == E - 1 ? sA : sB);
        u.pm = tile0 + lt_of(r); u.pn = (j - s) & 3; u.aux = tile_e[u.pm]; return true; }
    __device__ __forceinline__ bool half(const Unit& u) const { return ecnt[u.aux & 255] - (u.aux >> 8) * BM <= HALF; }
    __device__ __forceinline__ const char* a_ptr(const Unit& u) const { return A + (size_t)u.pm * BM * lda * 2; }
    __device__ __forceinline__ const char* b_ptr(const Unit& u) const { return W + ((size_t)(u.aux & 255) * 1024 + (size_t)u.pn * BM) * ldb * 2; }
    __device__ __forceinline__ void gather(const Unit&, const int*, const int*, unsigned*, unsigned*) const {}
};

template <class Epi, class Sched, bool ALIGN_EPI>
__device__ __forceinline__ void gemm_phase(PG8_LAS unsigned char* lds, const int K, const int lda, const int ldb, const Sched& S, const Epi& E) {
    int tid = threadIdx.x; asm volatile("" : "+v"(tid));
    const int wid = __builtin_amdgcn_readfirstlane(tid >> 6), lane = tid & 63, wr = wid >> 2, wc = wid & 3, fr = lane & 15, fq = lane >> 4;
    int nt = K / BK; if constexpr (Sched::KMAP) nt = S.nt();
#define PG8_KOFF(t) (Sched::KMAP ? S.koff(t) : (size_t)(t) * kstep)
    unsigned vA0[2], vA1[2], nvA0[2], nvA1[2], voffB[2]; int RA[2], CA[2];
#pragma unroll
    for (int i = 0; i < 2; ++i) { int R, C; stage_rc(tid * 16 + i * 8192, R, C); const int Rb = Epi::PERM ? ((R & ~31) + perm32(R & 31)) : R;
        RA[i] = R; CA[i] = C; vA0[i] = (unsigned)(R * lda + C) * 2u; vA1[i] = (unsigned)((R + HALF) * lda + C) * 2u; voffB[i] = (unsigned)(Rb * ldb + C) * 2u; nvA0[i] = vA0[i]; nvA1[i] = vA1[i]; }
    const size_t kstep = (size_t)(BK * 2);
    const size_t hstepB = (size_t)HALF * ldb * 2;
    const unsigned ldsw = (unsigned)wid * 1024u;
    const int aoff = lds_byte(wr * 64 + fr, fq * 8), boff = lds_byte(wc * 32 + fr, fq * 8);
#define PG8_SA(b, h) (((b) * 2 + (h)) * HTB)
#define PG8_SB(b, h) ((4 + (b) * 2 + (h)) * HTB)
#define PG8_STAGE2(bufoff, gbase, o0, o1) do { \
        __builtin_amdgcn_global_load_lds((const unsigned*)((const char*)(gbase) + (o0)), (PG8_LAS unsigned*)(lds + (bufoff) + ldsw), 16, 0, 0); \
        __builtin_amdgcn_global_load_lds((const unsigned*)((const char*)(gbase) + (o1)), (PG8_LAS unsigned*)(lds + (bufoff) + ldsw + 8192), 16, 0, 0); } while (0)
#define PG8_STAGEB(bufoff, gbase) PG8_STAGE2(bufoff, gbase, voffB[0], voffB[1])
#define PG8_LDA(dst, b, h) do { _Pragma("unroll") for (int m = 0; m < 4; ++m) _Pragma("unroll") for (int k = 0; k < 2; ++k) dst[m][k] = *(const PG8_LAS bf16x8*)(lds + PG8_SA(b, h) + aoff + m * 2048 + k * 1024); } while (0)
#define PG8_LDB(dst, b, h) do { _Pragma("unroll") for (int n = 0; n < 2; ++n) _Pragma("unroll") for (int k = 0; k < 2; ++k) dst[n][k] = *(const PG8_LAS bf16x8*)(lds + PG8_SB(b, h) + boff + n * 2048 + k * 1024); } while (0)
#define PG8_MMA(ai, bj, At, Bt) do { __builtin_amdgcn_s_setprio(1); _Pragma("unroll") for (int m = 0; m < 4; ++m) _Pragma("unroll") for (int n = 0; n < 2; ++n) _Pragma("unroll") for (int k = 0; k < 2; ++k) \
        acc[ai][bj][m][n] = __builtin_amdgcn_mfma_f32_16x16x32_bf16(Bt[n][k], At[m][k], acc[ai][bj][m][n], 0, 0, 0); __builtin_amdgcn_s_setprio(0); } while (0)
#define PG8_WAIT_V(n) asm volatile("s_waitcnt vmcnt(" #n ")" ::: "memory")
#define PG8_WAIT_L(n) asm volatile("s_waitcnt lgkmcnt(" #n ")" ::: "memory")
#define PG8_BAR __builtin_amdgcn_s_barrier()
#define PG8_SCHED __builtin_amdgcn_sched_barrier(0)
    Unit cur, nxt; int ui = 0;
    if (!S.next(0, cur)) return;
    if constexpr (Sched::GATHER) S.gather(cur, RA, CA, vA0, vA1);
    bool halfu = S.half(cur);
    f32x4 acc[2][2][4][2];
#pragma unroll
    for (int a = 0; a < 2; ++a)
#pragma unroll
        for (int b = 0; b < 2; ++b)
#pragma unroll
            for (int m = 0; m < 4; ++m)
#pragma unroll
                for (int n = 0; n < 2; ++n) acc[a][b][m][n] = (f32x4){0.f, 0.f, 0.f, 0.f};
    bf16x8 At[4][2], B0[2][2], B1[2][2];
    const char* cA = S.a_ptr(cur); const char* cB = S.b_ptr(cur);
    { const size_t k0_ = PG8_KOFF(0), k1_ = PG8_KOFF(1);
    PG8_STAGEB(PG8_SB(0, 0), cB + k0_); PG8_STAGEB(PG8_SB(0, 1), cB + hstepB + k0_); PG8_STAGE2(PG8_SA(0, 0), cA + k0_, vA0[0], vA0[1]); PG8_STAGE2(PG8_SA(0, 1), cA + k0_, vA1[0], vA1[1]);
    if (wr == 1) PG8_BAR;
    PG8_WAIT_V(2); PG8_BAR;
    PG8_STAGEB(PG8_SB(1, 0), cB + k1_); PG8_STAGE2(PG8_SA(1, 0), cA + k1_, vA0[0], vA0[1]); PG8_STAGEB(PG8_SB(1, 1), cB + hstepB + k1_); }
    PG8_WAIT_V(6); PG8_BAR;
    for (;;) {
        const bool has_next = S.next(ui + 1, nxt);
        const char* nA = has_next ? S.a_ptr(nxt) : cA; const char* nB = has_next ? S.b_ptr(nxt) : cB;
        if constexpr (Sched::GATHER) { if (has_next) S.gather(nxt, RA, CA, nvA0, nvA1); else { nvA0[0] = vA0[0]; nvA0[1] = vA0[1]; nvA1[0] = vA1[0]; nvA1[1] = vA1[1]; } }
        for (int t = 0; t < nt; t += 2) {
            const bool last = (t == nt - 2);
            const size_t k1_ = PG8_KOFF(t + 1), k2_ = last ? PG8_KOFF(0) : PG8_KOFF(t + 2), k3_ = last ? PG8_KOFF(1) : PG8_KOFF(t + 3);
            const char* a1 = cA + k1_;
            const char* a2 = (last ? nA : cA) + k2_; const char* b2 = (last ? nB : cB) + k2_;
            const char* a3 = (last ? nA : cA) + k3_; const char* b3 = (last ? nB : cB) + k3_;
            unsigned s00 = vA0[0], s01 = vA0[1], s10 = vA1[0], s11 = vA1[1];
            if constexpr (Sched::GATHER) { if (last) { s00 = nvA0[0]; s01 = nvA0[1]; s10 = nvA1[0]; s11 = nvA1[1]; } }
            PG8_LDB(B0, 0, 0); PG8_LDB(B1, 0, 1); PG8_SCHED; PG8_LDA(At, 0, 0); PG8_STAGE2(PG8_SA(1, 1), a1, vA1[0], vA1[1]);
            PG8_WAIT_V(8); PG8_WAIT_L(0); PG8_BAR; PG8_MMA(0, 0, At, B0); PG8_MMA(0, 1, At, B1); PG8_BAR; PG8_SCHED;
            PG8_LDA(At, 0, 1); PG8_STAGEB(PG8_SB(0, 0), b2); PG8_STAGEB(PG8_SB(0, 1), b2 + hstepB); PG8_STAGE2(PG8_SA(0, 0), a2, s00, s01);
            PG8_WAIT_V(8); PG8_WAIT_L(0); PG8_BAR; if (!halfu) { PG8_MMA(1, 0, At, B0); PG8_MMA(1, 1, At, B1); } PG8_BAR; PG8_SCHED;
            PG8_LDB(B0, 1, 0); PG8_LDB(B1, 1, 1); PG8_SCHED; PG8_LDA(At, 1, 0); PG8_STAGE2(PG8_SA(0, 1), a2, s10, s11);
            PG8_WAIT_V(8); PG8_WAIT_L(0); PG8_BAR; PG8_MMA(0, 0, At, B0); PG8_MMA(0, 1, At, B1); PG8_BAR; PG8_SCHED;
            PG8_LDA(At, 1, 1); PG8_STAGEB(PG8_SB(1, 0), b3); PG8_STAGEB(PG8_SB(1, 1), b3 + hstepB); PG8_STAGE2(PG8_SA(1, 0), a3, s00, s01);
            PG8_WAIT_V(8); PG8_WAIT_L(0); PG8_BAR; if (!halfu) { PG8_MMA(1, 0, At, B0); PG8_MMA(1, 1, At, B1); } PG8_BAR; PG8_SCHED;
        }
        if constexpr (ALIGN_EPI) { if (wr == 0) PG8_BAR; }
        E(acc, cur, wr, wc, fr, fq);
        if (!has_next) break;
#pragma unroll
        for (int a = 0; a < 2; ++a)
#pragma unroll
            for (int b = 0; b < 2; ++b)
#pragma unroll
                for (int m = 0; m < 4; ++m)
#pragma unroll
                    for (int n = 0; n < 2; ++n) acc[a][b][m][n] = (f32x4){0.f, 0.f, 0.f, 0.f};
        cur = nxt; cA = nA; cB = nB; ++ui; halfu = S.half(cur);
        if constexpr (Sched::GATHER) { vA0[0] = nvA0[0]; vA0[1] = nvA0[1]; vA1[0] = nvA1[0]; vA1[1] = nvA1[1]; }
        if constexpr (ALIGN_EPI) { if (wr == 1) PG8_BAR; }
    }
    PG8_WAIT_V(0);
    if constexpr (!ALIGN_EPI) { if (wr == 0) PG8_BAR; }
    PG8_BAR;
#undef PG8_KOFF
#undef PG8_SA
#undef PG8_SB
#undef PG8_STAGE2
#undef PG8_STAGEB
#undef PG8_LDA
#undef PG8_LDB
#undef PG8_MMA
#undef PG8_WAIT_V
#undef PG8_WAIT_L
#undef PG8_BAR
#undef PG8_SCHED
}

typedef f32x4 AccT[2][2][4][2];

struct EpiInProj {
    static constexpr bool PERM = true;
    bf16* q; bf16* kt; bf16* vt; bf16* uperm;
    __device__ __forceinline__ void operator()(const AccT& acc, const Unit& u, int wr, int wc, int fr, int fq) const {
        const int row0 = u.pm * BM + wr * 64 + fr; const int col0 = u.pn * BM + wc * 32 + 8 * fq;
        const float sc = (u.pn < 2) ? QSCALE : 1.0f;
#pragma unroll
        for (int ai = 0; ai < 2; ++ai)
#pragma unroll
            for (int m = 0; m < 4; ++m) { const int row = row0 + ai * HALF + m * 16; const int b = row >> 12, sq = row & 4095, tl = sq >> 6, s = sq & 63;
#pragma unroll
                for (int bj = 0; bj < 2; ++bj) { const f32x4 v0 = acc[ai][bj][m][0] * sc, v1 = acc[ai][bj][m][1] * sc; const int col = col0 + bj * HALF;
                    v4u w; w.x = cvtpk(v0[0], v0[1]); w.y = cvtpk(v0[2], v0[3]); w.z = cvtpk(v1[0], v1[1]); w.w = cvtpk(v1[2], v1[3]);
                    if (u.pn < 2) *(v4u*)(q + (size_t)row * 512 + col) = w;
                    else if (u.pn < 4) { const int ck = col - 512, h = ck >> 7, sub = (ck >> 6) & 1, ch = (ck & 63) >> 3;
                        *(v4u*)(kt + ((size_t)((((b * 4 + h) * 2 + sub) * 64 + tl) * 8 + ch) * 512 + s * 8)) = w; }
                    else if (u.pn < 6) { const int cv = col - 1024, h = cv >> 7, d0 = (cv & 127) >> 5, c16 = (cv & 31) >> 3;
                        *(v4u*)(vt + ((size_t)(((b * 4 + h) * 64 + tl) * 4 + d0) * 2048 + s * 32 + c16 * 8)) = w; }
                    else { const int cu = col - 1536, g = cu >> 4, ci0 = cu & 15;
                        *(v4u*)(uperm + ((size_t)(g * 512 + b * 64 + tl) * UP_PITCH + s * 16 + ci0)) = w; } } }
    }
};
struct EpiState {
    static constexpr bool PERM = false;
    float* sstate;
    __device__ __forceinline__ void operator()(const AccT& acc, const Unit& u, int wr, int wc, int fr, int fq) const {
        const int row0 = u.pm * BM + wr * 64 + fr; const int col0 = wc * 32 + 4 * fq;
#pragma unroll
        for (int ai = 0; ai < 2; ++ai)
#pragma unroll
            for (int m = 0; m < 4; ++m) { const int row = row0 + ai * HALF + m * 16;
#pragma unroll
                for (int bj = 0; bj < 2; ++bj)
#pragma unroll
                    for (int n = 0; n < 2; ++n) *(f32x4*)(sstate + ((size_t)(u.aux * 512 + row) * 256 + bj * HALF + col0 + n * 16)) = acc[ai][bj][m][n]; }
    }
};
struct EpiSsmOut {
    static constexpr bool PERM = true;
    const bf16* uperm; const float* dvec; bf16* z;
    __device__ __forceinline__ void operator()(const AccT& acc, const Unit& u, int wr, int wc, int fr, int fq) const {
        const int g = u.aux; const int row0 = u.pm * BM + wr * 64 + fr; const int col0 = u.pn * BM + wc * 32 + 8 * fq;
        const int co0 = col0 & 15;
        const f32x4 d0 = *(const f32x4*)(dvec + g * 16 + co0), d1 = *(const f32x4*)(dvec + g * 16 + co0 + 4);
#pragma unroll
        for (int ai = 0; ai < 2; ++ai)
#pragma unroll
            for (int m = 0; m < 4; ++m) { const int row = row0 + ai * HALF + m * 16; const int b = row >> 6, ch = row & 63;
#pragma unroll
                for (int bj = 0; bj < 2; ++bj) { const int col = col0 + bj * HALF; const int t = col >> 4;
                    const v4u uw = *(const v4u*)(uperm + ((size_t)(g * 512 + row) * UP_PITCH + col));
                    const f32x4 a0 = acc[ai][bj][m][0], a1 = acc[ai][bj][m][1];
                    float y[8];
                    y[0] = a0[0] + d0[0] * bf_lo(uw.x); y[1] = a0[1] + d0[1] * bf_hi(uw.x); y[2] = a0[2] + d0[2] * bf_lo(uw.y); y[3] = a0[3] + d0[3] * bf_hi(uw.y);
                    y[4] = a1[0] + d1[0] * bf_lo(uw.z); y[5] = a1[1] + d1[1] * bf_hi(uw.z); y[6] = a1[2] + d1[2] * bf_lo(uw.w); y[7] = a1[3] + d1[3] * bf_hi(uw.w);
#pragma unroll
                    for (int j = 0; j < 8; ++j) y[j] = gelu_tanh(y[j]);
                    v4u w; w.x = cvtpk(y[0], y[1]); w.y = cvtpk(y[2], y[3]); w.z = cvtpk(y[4], y[5]); w.w = cvtpk(y[6], y[7]);
                    *(v4u*)(z + ((size_t)(b * SEQ + ch * 64 + t) * SSMW + g * 16 + co0)) = w; } }
    }
};
struct EpiGlu {
    static constexpr bool PERM = true;
    const bf16* z; const float* bias; bf16* cat;
    __device__ __forceinline__ void operator()(const AccT& acc, const Unit& u, int wr, int wc, int fr, int fq) const {
        const int row0 = u.pm * BM + wr * 64 + fr; const int col0 = u.pn * BM + wc * 32 + 8 * fq;
#pragma unroll
        for (int bj = 0; bj < 2; ++bj) { const int col = col0 + bj * HALF; const f32x4 b0 = *(const f32x4*)(bias + col), b1 = *(const f32x4*)(bias + col + 4);
#pragma unroll
            for (int ai = 0; ai < 2; ++ai)
#pragma unroll
                for (int m = 0; m < 4; ++m) { const int row = row0 + ai * HALF + m * 16;
                    const v4u zw = *(const v4u*)(z + (size_t)row * SSMW + col);
                    const f32x4 a0 = acc[ai][bj][m][0] + b0, a1 = acc[ai][bj][m][1] + b1;
                    float s[8];
                    s[0] = bf_lo(zw.x) * sigmoidf_(a0[0]); s[1] = bf_hi(zw.x) * sigmoidf_(a0[1]); s[2] = bf_lo(zw.y) * sigmoidf_(a0[2]); s[3] = bf_hi(zw.y) * sigmoidf_(a0[3]);
                    s[4] = bf_lo(zw.z) * sigmoidf_(a1[0]); s[5] = bf_hi(zw.z) * sigmoidf_(a1[1]); s[6] = bf_lo(zw.w) * sigmoidf_(a1[2]); s[7] = bf_hi(zw.w) * sigmoidf_(a1[3]);
                    v4u w; w.x = cvtpk(s[0], s[1]); w.y = cvtpk(s[2], s[3]); w.z = cvtpk(s[4], s[5]); w.w = cvtpk(s[6], s[7]);
                    *(v4u*)(cat + (size_t)row * DM + 512 + col) = w; } }
    }
};
struct EpiOutProj {
    static constexpr bool PERM = true;
    const bf16* xb; bf16* pre; f32x2* stats;
    __device__ __forceinline__ void operator()(const AccT& acc, const Unit& u, int wr, int wc, int fr, int fq) const {
        const int row0 = u.pm * BM + wr * 64 + fr; const int col0 = u.pn * BM + wc * 32 + 8 * fq;
#pragma unroll
        for (int ai = 0; ai < 2; ++ai)
#pragma unroll
            for (int m = 0; m < 4; ++m) { const int row = row0 + ai * HALF + m * 16; const size_t off = (size_t)row * DM + col0;
                f32x4 v[2][2]; float s = 0.f;
#pragma unroll
                for (int bj = 0; bj < 2; ++bj) { const v4u xw = *(const v4u*)(xb + off + bj * HALF);
                    v[bj][0] = (f32x4){bf_lo(xw.x), bf_hi(xw.x), bf_lo(xw.y), bf_hi(xw.y)} * ALPHA + acc[ai][bj][m][0];
                    v[bj][1] = (f32x4){bf_lo(xw.z), bf_hi(xw.z), bf_lo(xw.w), bf_hi(xw.w)} * ALPHA + acc[ai][bj][m][1];
                    v4u w; w.x = cvtpk(v[bj][0][0], v[bj][0][1]); w.y = cvtpk(v[bj][0][2], v[bj][0][3]); w.z = cvtpk(v[bj][1][0], v[bj][1][1]); w.w = cvtpk(v[bj][1][2], v[bj][1][3]);
                    *(v4u*)(pre + off + bj * HALF) = w;
#pragma unroll
                    for (int n = 0; n < 2; ++n) s += (v[bj][n][0] + v[bj][n][1]) + (v[bj][n][2] + v[bj][n][3]); }
                s += __shfl_xor(s, 16); s += __shfl_xor(s, 32);
                const float mw = s * (1.0f / 64.0f); float q = 0.f;
#pragma unroll
                for (int bj = 0; bj < 2; ++bj)
#pragma unroll
                    for (int n = 0; n < 2; ++n) { const f32x4 d = v[bj][n] - mw; q += (d[0] * d[0] + d[1] * d[1]) + (d[2] * d[2] + d[3] * d[3]); }
                q += __shfl_xor(q, 16); q += __shfl_xor(q, 32);
                if (fq == 0) stats[(size_t)row * 16 + u.pn * 4 + wc] = (f32x2){mw, q}; }
    }
};
template <bool WT  > struct EpiMoe1T {
    static constexpr bool PERM = true;
    bf16* hid;
    __device__ __forceinline__ void operator()(const AccT& acc, const Unit& u, int wr, int wc, int fr, int fq) const {
        const int row0 = u.pm * BM + wr * 64 + fr; const int col0 = u.pn * BM + wc * 32 + 8 * fq;
#pragma unroll
        for (int ai = 0; ai < 2; ++ai)
#pragma unroll
            for (int m = 0; m < 4; ++m) { const int row = row0 + ai * HALF + m * 16;
#pragma unroll
                for (int bj = 0; bj < 2; ++bj) { const f32x4 a0 = acc[ai][bj][m][0], a1 = acc[ai][bj][m][1]; const int col = (col0 + bj * HALF) >> 1;
                    const float h0 = a0[0] * sigmoidf_(a0[0]) * a0[1], h1 = a0[2] * sigmoidf_(a0[2]) * a0[3], h2 = a1[0] * sigmoidf_(a1[0]) * a1[1], h3 = a1[2] * sigmoidf_(a1[2]) * a1[3];
                    v2u w; w.x = cvtpk(h0, h1); w.y = cvtpk(h2, h3);
                    if constexpr (WT) __hip_atomic_store((GAS unsigned long long*)(hid + (size_t)row * DEXP + col), ((unsigned long long)w.y << 32) | w.x, __ATOMIC_RELAXED, __HIP_MEMORY_SCOPE_AGENT);
                    else *(v2u*)(hid + (size_t)row * DEXP + col) = w; } }
    }
};
typedef EpiMoe1T<false> EpiMoe1;
struct EpiMoe2 {
    static constexpr bool PERM = true;
    const int* eslot; const float* ew; const PG8_LAS int* ecnt; bf16* y2;
    __device__ __forceinline__ void operator()(const AccT& acc, const Unit& u, int wr, int wc, int fr, int fq) const {
        const int e = u.aux & 255, cnt = ecnt[e]; const int row0 = (u.aux >> 8) * BM + wr * 64 + fr; const int col0 = u.pn * BM + wc * 32 + 8 * fq;
#pragma unroll
        for (int ai = 0; ai < 2; ++ai)
#pragma unroll
            for (int m = 0; m < 4; ++m) { const int idx = row0 + ai * HALF + m * 16; const bool ok = idx < cnt;
                const int slot = ok ? eslot[e * 65536 + idx] : 65536 + (idx & 255); const float wt = ok ? ew[e * 65536 + idx] : 0.f;
#pragma unroll
                for (int bj = 0; bj < 2; ++bj) { const f32x4 v0 = acc[ai][bj][m][0] * wt, v1 = acc[ai][bj][m][1] * wt;
                    v4u w; w.x = cvtpk(v0[0], v0[1]); w.y = cvtpk(v0[2], v0[3]); w.z = cvtpk(v1[0], v1[1]); w.w = cvtpk(v1[2], v1[3]);
                    *(v4u*)(y2 + (size_t)slot * DM + col0 + bj * HALF) = w; } }
    }
};
}

namespace att {
__device__ __forceinline__ int crow(int r, int hi) { return (r & 3) + 8 * (r >> 2) + 4 * hi; }
#define SBAR() __builtin_amdgcn_sched_barrier(0)
constexpr int STAGE = 32768, K_OFF = 0, V_OFF = 16384, WS_OFF = 131072 + 4096;
constexpr float THR = 8.0f;
__device__ __forceinline__ void glds16(const void* gsrc, unsigned lds_dst) { unsigned keep;
    asm volatile("s_mov_b32 %0, m0\n\ts_mov_b32 m0, %2\n\ts_nop 0\n\tglobal_load_lds_dwordx4 %1, off\n\ts_mov_b32 m0, %0" : "=&s"(keep) : "v"(gsrc), "s"(lds_dst) : "memory"); }
#define ATT_WAIT_BAR(N) asm volatile("s_waitcnt vmcnt(" #N ") lgkmcnt(0)\n\ts_barrier" ::: "memory")
#define ATT_BAR_L() asm volatile("s_waitcnt lgkmcnt(0)\n\ts_barrier" ::: "memory")

__device__ __forceinline__ float max3f(float a, float b, float c) { return __builtin_fmaxf(__builtin_fmaxf(a, b), c); }
__device__ __forceinline__ float max2f(float a, float b) { return __builtin_fmaxf(a, b); }
__device__ __forceinline__ float rowmax32(const f32x16& p0, const f32x16& p1) {
    float a = max3f(p0[0], p0[1], p1[0]), b = max3f(p0[2], p0[3], p1[1]); a = max3f(a, p1[2], p1[3]);
#pragma unroll
    for (int r = 4; r < 16; r += 4) { a = max3f(a, p0[r], p0[r + 1]); b = max3f(b, p0[r + 2], p0[r + 3]); a = max3f(a, p1[r], p1[r + 1]); b = max3f(b, p1[r + 2], p1[r + 3]); }
    const float m = max2f(a, b);
    auto rr = __builtin_amdgcn_permlane32_swap(__float_as_uint(m), __float_as_uint(m), false, false);
    return max2f(__uint_as_float(rr[0]), __uint_as_float(rr[1]));
}

__device__ __forceinline__ void attn_unit(int b, int h, int qb, const bf16* PROJ, bf16* CAT, char* shm, float lam, const float* subln_g) {
    const int tid = threadIdx.x, lane = tid & 63, r32 = lane & 31, hi = lane >> 5; const int wid = __builtin_amdgcn_readfirstlane(tid >> 6);
    const int sub = wid >> 2, wq = wid & 3;
    const long rowbase = (long)b * SEQ; const int q0 = qb * 128;
    const bf16* Qw = PROJ + (rowbase + q0 + wq * 32) * 512 + h * 128 + sub * 64;
    const bf16* Kh = PROJ + (size_t)TOK * 512 + (size_t)((b * 4 + h) * 2) * 64 * 4096;
    const bf16* Vh = PROJ + (size_t)TOK * 1024 + (size_t)(b * 4 + h) * 64 * 8192;
    const unsigned lds0 = (unsigned)(uintptr_t)shm;
    float* wsf = (float*)(shm + WS_OFF) + wid * 64;
    const bf16* ksrc0 = Kh + wid * 512 + lane * 8;
    const bf16* ksrc1 = ksrc0 + 64 * 4096;
    const unsigned kdst0 = lds0 + K_OFF + wid * 1024, kdst1 = lds0 + K_OFF + 8192 + wid * 1024;
    const bf16* vsrc0 = Vh + wid * 512 + lane * 8;
    const bf16* vsrc1 = vsrc0 + 4096;
    const unsigned vdst0 = lds0 + V_OFF + wid * 1024, vdst1 = vdst0 + 8192;
#define ATT_DMA(t, so) do { const long rk_ = (long)(t) * 4096, rv_ = (long)(t) * 8192; const unsigned so_ = (unsigned)(so); \
        glds16(ksrc0 + rk_, (unsigned)__builtin_amdgcn_readfirstlane(kdst0 + so_)); glds16(ksrc1 + rk_, (unsigned)__builtin_amdgcn_readfirstlane(kdst1 + so_)); \
        glds16(vsrc0 + rv_, (unsigned)__builtin_amdgcn_readfirstlane(vdst0 + so_)); glds16(vsrc1 + rv_, (unsigned)__builtin_amdgcn_readfirstlane(vdst1 + so_)); } while (0)
    const int NT = 2 * qb + 2; const int my_last = 2 * qb + (wq >> 1);
    ATT_DMA(0, 0); ATT_DMA(1, STAGE); if (NT > 2) ATT_DMA(2, 2 * STAGE);
    bf16x8 qr[4];
#pragma unroll
    for (int d0 = 0; d0 < 4; ++d0) qr[d0] = *reinterpret_cast<const bf16x8*>(&Qw[(long)r32 * 512 + d0 * 16 + hi * 8]);
    float mrun = 0.f, l_reg = 0.f;
    f32x16 o[4];
#pragma unroll
    for (int d = 0; d < 4; ++d) o[d] = f32x16{};
    const int vb0 = (int)(lds0 + V_OFF) + ((lane >> 4) & 1) * 32 + (lane & 3) * 8 + (4 * hi + ((lane & 15) >> 2)) * 64;
    const char* kbase = shm + K_OFF + sub * 8192 + hi * 1024 + r32 * 16;
    const int kb32 = (int)(lds0 + K_OFF) + sub * 8192 + hi * 1024 + r32 * 16;
    if (NT > 2) ATT_WAIT_BAR(4); else ATT_WAIT_BAR(0);
    asm volatile("" :: "v"(qr[0]), "v"(qr[1]), "v"(qr[2]), "v"(qr[3]));
#define ATT_QK(P0, P1, soff) do { const char* kb_ = kbase + (soff); f32x16 negm; _Pragma("unroll") for (int r = 0; r < 16; ++r) negm[r] = -mrun;     \
        _Pragma("unroll") for (int d0 = 0; d0 < 4; ++d0) { \
            const bf16x8 b0_ = *reinterpret_cast<const bf16x8*>(kb_ + d0 * 2048); const bf16x8 b1_ = *reinterpret_cast<const bf16x8*>(kb_ + d0 * 2048 + 512); \
            if (d0 == 0) { P0 = __builtin_amdgcn_mfma_f32_32x32x16_bf16(b0_, qr[0], negm, 0, 0, 0); P1 = __builtin_amdgcn_mfma_f32_32x32x16_bf16(b1_, qr[0], negm, 0, 0, 0); } \
            else { P0 = __builtin_amdgcn_mfma_f32_32x32x16_bf16(b0_, qr[d0], P0, 0, 0, 0); P1 = __builtin_amdgcn_mfma_f32_32x32x16_bf16(b1_, qr[d0], P1, 0, 0, 0); } } } while (0)
    f32x16 pS0, pS1;
    ATT_QK(pS0, pS1, 0);
    if (sub == 1) ATT_BAR_L();
    int cur = 0;
#define ATT_RDV(L, H, d0) do { _Pragma("unroll") for (int ks = 0; ks < 4; ++ks) { \
                    asm volatile("ds_read_b64_tr_b16 %0,%1 offset:%c2" : "=&v"(L[ks]) : "v"(vb), "i"((d0) * 4096 + ks * 1024) : "memory"); \
                    asm volatile("ds_read_b64_tr_b16 %0,%1 offset:%c2" : "=&v"(H[ks]) : "v"(vb), "i"((d0) * 4096 + ks * 1024 + 512) : "memory"); } } while (0)
#define ATT_PK(L, H, k) (bf16x8){L[k][0], L[k][1], L[k][2], L[k][3], H[k][0], H[k][1], H[k][2], H[k][3]}
#define ATT_PV(L, H, d0) do { \
                    o[d0] = __builtin_amdgcn_mfma_f32_32x32x16_bf16(__builtin_bit_cast(bf16x8, pw[0]), ATT_PK(L, H, 0), o[d0], 0, 0, 0); \
                    o[d0] = __builtin_amdgcn_mfma_f32_32x32x16_bf16(__builtin_bit_cast(bf16x8, pw[1]), ATT_PK(L, H, 1), o[d0], 0, 0, 0); \
                    o[d0] = __builtin_amdgcn_mfma_f32_32x32x16_bf16(__builtin_bit_cast(bf16x8, pw[2]), ATT_PK(L, H, 2), o[d0], 0, 0, 0); \
                    o[d0] = __builtin_amdgcn_mfma_f32_32x32x16_bf16(__builtin_bit_cast(bf16x8, pw[3]), ATT_PK(L, H, 3), o[d0], 0, 0, 0); } while (0)
    for (int t = 0; t < NT; ++t) {
        const int nx1 = (cur == 3 * STAGE) ? 0 : cur + STAGE; const int st3 = (cur == 0) ? 3 * STAGE : cur - STAGE;
        const bool more = (t + 3 < NT);
        if (sub == 1 && more) ATT_DMA(t + 3, st3);
        v4u pw[4];
        if (t <= my_last) {
            const float rm = rowmax32(pS0, pS1); bool resc = false;
            if (t == 0 || __any(rm > THR)) {
                const float dl = (t == 0) ? rm : fmaxf(rm, 0.f); mrun += dl;
#pragma unroll
                for (int r = 0; r < 16; ++r) { pS0[r] -= dl; pS1[r] -= dl; }
                if (t != 0) { const float f = fexp2(-dl); l_reg *= f; if (hi == 0) wsf[r32] = f; resc = true; }
            }
            float sacc = 0.f;
#pragma unroll
            for (int r = 0; r < 16; ++r) { pS0[r] = fexp2(pS0[r]); pS1[r] = fexp2(pS1[r]); sacc += pS0[r] + pS1[r]; }
            l_reg += sacc;
            if (resc) { LDS_WAIT();
#pragma unroll
                for (int r = 0; r < 16; ++r) { const float f = wsf[crow(r, hi)];
#pragma unroll
                    for (int d = 0; d < 4; ++d) o[d][r] *= f; } }
            pw[0] = (v4u){cvtpk(pS0[0], pS0[1]), cvtpk(pS0[2], pS0[3]), cvtpk(pS0[4], pS0[5]), cvtpk(pS0[6], pS0[7])};
            pw[1] = (v4u){cvtpk(pS0[8], pS0[9]), cvtpk(pS0[10], pS0[11]), cvtpk(pS0[12], pS0[13]), cvtpk(pS0[14], pS0[15])};
            pw[2] = (v4u){cvtpk(pS1[0], pS1[1]), cvtpk(pS1[2], pS1[3]), cvtpk(pS1[4], pS1[5]), cvtpk(pS1[6], pS1[7])};
            pw[3] = (v4u){cvtpk(pS1[8], pS1[9]), cvtpk(pS1[10], pS1[11]), cvtpk(pS1[12], pS1[13]), cvtpk(pS1[14], pS1[15])};
        }
        if (sub == 0) ATT_BAR_L(); else { if (more) ATT_WAIT_BAR(4); else ATT_WAIT_BAR(0); }
        if (sub == 0 && more) ATT_DMA(t + 3, st3);
        if (t <= my_last) {
            const int vb = vb0 + cur;
            s16x4 la[4], ha[4], lb[4], hb[4];
            ATT_RDV(la, ha, 0); ATT_RDV(lb, hb, 1);
            asm volatile("s_waitcnt lgkmcnt(8)" ::: "memory"); SBAR();
            ATT_PV(la, ha, 0); SBAR();
            ATT_RDV(la, ha, 2);
            asm volatile("s_waitcnt lgkmcnt(8)" ::: "memory"); SBAR();
            ATT_PV(lb, hb, 1); SBAR();
            ATT_RDV(lb, hb, 3);
            asm volatile("s_waitcnt lgkmcnt(8)" ::: "memory"); SBAR();
            ATT_PV(la, ha, 2); SBAR();
            asm volatile("s_waitcnt lgkmcnt(0)" ::: "memory"); SBAR();
            ATT_PV(lb, hb, 3);
        }
        if (t + 1 <= my_last) {
            bf16x8 kA0, kA1, kB0, kB1; const int ka = kb32 + nx1;
#define ATT_KRD(D0, D1, d0) do { asm volatile("ds_read_b128 %0,%1 offset:%c2" : "=&v"(D0) : "v"(ka), "i"((d0) * 2048) : "memory"); \
                                 asm volatile("ds_read_b128 %0,%1 offset:%c2" : "=&v"(D1) : "v"(ka), "i"((d0) * 2048 + 512) : "memory"); } while (0)
            ATT_KRD(kA0, kA1, 0); ATT_KRD(kB0, kB1, 1);
#pragma unroll
            for (int r = 0; r < 16; ++r) { pS0[r] = -mrun; pS1[r] = -mrun; }
            asm volatile("s_waitcnt lgkmcnt(2)" ::: "memory"); SBAR();
            pS0 = __builtin_amdgcn_mfma_f32_32x32x16_bf16(kA0, qr[0], pS0, 0, 0, 0); pS1 = __builtin_amdgcn_mfma_f32_32x32x16_bf16(kA1, qr[0], pS1, 0, 0, 0); SBAR();
            ATT_KRD(kA0, kA1, 2);
            asm volatile("s_waitcnt lgkmcnt(2)" ::: "memory"); SBAR();
            pS0 = __builtin_amdgcn_mfma_f32_32x32x16_bf16(kB0, qr[1], pS0, 0, 0, 0); pS1 = __builtin_amdgcn_mfma_f32_32x32x16_bf16(kB1, qr[1], pS1, 0, 0, 0); SBAR();
            ATT_KRD(kB0, kB1, 3);
            asm volatile("s_waitcnt lgkmcnt(2)" ::: "memory"); SBAR();
            pS0 = __builtin_amdgcn_mfma_f32_32x32x16_bf16(kA0, qr[2], pS0, 0, 0, 0); pS1 = __builtin_amdgcn_mfma_f32_32x32x16_bf16(kA1, qr[2], pS1, 0, 0, 0); SBAR();
            asm volatile("s_waitcnt lgkmcnt(0)" ::: "memory"); SBAR();
            pS0 = __builtin_amdgcn_mfma_f32_32x32x16_bf16(kB0, qr[3], pS0, 0, 0, 0); pS1 = __builtin_amdgcn_mfma_f32_32x32x16_bf16(kB1, qr[3], pS1, 0, 0, 0);
#undef ATT_KRD
        }
        if (sub == 1) ATT_BAR_L(); else { if (more) ATT_WAIT_BAR(4); else ATT_WAIT_BAR(0); }
        cur = nx1;
    }
#undef ATT_QK
#undef ATT_RDV
#undef ATT_PK
#undef ATT_PV
    if (sub == 0) ATT_BAR_L();
    { auto rr = __builtin_amdgcn_permlane32_swap(__float_as_uint(l_reg), __float_as_uint(l_reg), false, false); l_reg = __uint_as_float(rr[0]) + __uint_as_float(rr[1]); }
    if (hi == 0) wsf[32 + r32] = l_reg;
    LDS_WAIT();
    float rli[16];
#pragma unroll
    for (int r = 0; r < 16; ++r) rli[r] = frcp(wsf[32 + crow(r, hi)]);
    float* stg = (float*)shm + wq * 4096;
    if (sub == 1) {
#pragma unroll
        for (int r = 0; r < 16; ++r) { const int orow = crow(r, hi);
#pragma unroll
            for (int d = 0; d < 4; ++d) stg[orow * 128 + d * 32 + r32] = o[d][r] * rli[r]; }
    }
    ATT_WAIT_BAR(0);
    if (sub == 0) {
#pragma unroll
        for (int r = 0; r < 16; ++r) { const int orow = crow(r, hi);
#pragma unroll
            for (int d = 0; d < 4; ++d) { const float v = o[d][r] * rli[r] - lam * stg[orow * 128 + d * 32 + r32]; stg[orow * 128 + d * 32 + r32] = v; } }
        LDS_WAIT();
        const int c8 = (lane & 15) * 8;
        const f32x4 g0 = *(const f32x4*)(subln_g + c8), g1 = *(const f32x4*)(subln_g + c8 + 4);
        bf16* Ow = CAT + (rowbase + q0 + wq * 32) * DM + h * 128 + c8;
#pragma unroll
        for (int i = 0; i < 8; ++i) { const int row = i * 4 + (lane >> 4);
            const f32x4 a = *(const f32x4*)(stg + row * 128 + c8), c = *(const f32x4*)(stg + row * 128 + c8 + 4);
            float ss = (a[0] * a[0] + a[1] * a[1]) + (a[2] * a[2] + a[3] * a[3]) + (c[0] * c[0] + c[1] * c[1]) + (c[2] * c[2] + c[3] * c[3]);
            ss += __shfl_xor(ss, 1); ss += __shfl_xor(ss, 2); ss += __shfl_xor(ss, 4); ss += __shfl_xor(ss, 8);
            const float sc = (1.0f - LAM_INIT) / sqrtf(ss * (1.0f / 128.0f) + RMS_EPS);
            v4u w; w.x = cvtpk(a[0] * sc * g0[0], a[1] * sc * g0[1]); w.y = cvtpk(a[2] * sc * g0[2], a[3] * sc * g0[3]);
            w.z = cvtpk(c[0] * sc * g1[0], c[1] * sc * g1[1]); w.w = cvtpk(c[2] * sc * g1[2], c[3] * sc * g1[3]);
            *(v4u*)(Ow + (long)row * DM) = w; }
    }
    ATT_WAIT_BAR(0);
#undef ATT_DMA
}
#undef SBAR
}

#define XB_TMO      128
#define XB_XCNT(j)  (256  + 64 * (j))
#define XB_XSUB(j)  (1280 + 64 * (j))
#define XB_XGEN(j)  (2304 + 64 * (j))
#define XB_TOP      3328
#define XB_TOPGEN   3392
#define XCD_BAR_WORDS 3456
#define XB_SPIN_CAP (1u << 18)
__device__ __forceinline__ unsigned xb_ld(unsigned* p)              { return __hip_atomic_load(p, __ATOMIC_RELAXED, __HIP_MEMORY_SCOPE_AGENT); }
__device__ __forceinline__ unsigned xb_add(unsigned* p, unsigned v) { return __hip_atomic_fetch_add(p, v, __ATOMIC_RELAXED, __HIP_MEMORY_SCOPE_AGENT); }
__device__ __forceinline__ unsigned xb_xcc_id() { return (unsigned)__builtin_amdgcn_s_getreg((3 << 11) | 20) & 0xFu; }
#define XB_SPIN(cond, bar) do { unsigned _sp = 0; while (cond) { __builtin_amdgcn_s_sleep(1); \
    if ((++_sp & 255u) == 0u) { if (xb_ld(&(bar)[XB_TMO])) break; if (_sp > XB_SPIN_CAP) { atomicAdd(&(bar)[XB_TMO], 1u); break; } } } } while (0)
struct XcdBarrier { unsigned* bar; unsigned x; volatile LAS unsigned* st; };
__device__ __forceinline__ XcdBarrier xcd_barrier_post(unsigned* bar, volatile LAS unsigned* st) {
    XcdBarrier b; b.bar = bar; b.x = xb_xcc_id(); b.st = st;
    if (threadIdx.x == 0) (void)xb_add(&bar[XB_XCNT(b.x)], 1u);
    return b;
}
__device__ __forceinline__ void xcd_barrier_complete(unsigned* bar, unsigned x, unsigned& nloc, unsigned& nx) {
    const unsigned G = gridDim.x * gridDim.y * gridDim.z;
    unsigned sum, cnt, mine, sp = 0u;
    for (;;) {
        sum = 0u; cnt = 0u; mine = 0u;
#pragma unroll
        for (unsigned j = 0; j < 16; ++j) { const unsigned c = xb_ld(&bar[XB_XCNT(j)]); sum += c; cnt += (c > 0u) ? 1u : 0u; mine = (j == x) ? c : mine; }
        if (sum == G) break;
        __builtin_amdgcn_s_sleep(1);
        if ((++sp & 255u) == 0u) { if (xb_ld(&bar[XB_TMO])) break; if (sp > XB_SPIN_CAP) { atomicAdd(&bar[XB_TMO], 1u); break; } }
    }
    nloc = mine > 0u ? mine : 1u; nx = cnt > 0u ? cnt : 1u;
}
__device__ __forceinline__ void xcd_barrier(const XcdBarrier& b) {
    asm volatile("s_waitcnt vmcnt(0)" ::: "memory");
    __syncthreads();
    if (threadIdx.x == 0) {
        unsigned* bar = b.bar;
        __builtin_amdgcn_s_waitcnt(0);
        unsigned nloc = b.st[0], nx = b.st[1];
        if (nloc == 0u) { xcd_barrier_complete(bar, b.x, nloc, nx); b.st[0] = nloc; b.st[1] = nx; }
        const unsigned old = xb_add(&bar[XB_XSUB(b.x)], 1u);
        const unsigned gen = old / nloc;
        if (old + 1u == (gen + 1u) * nloc) {
            __builtin_amdgcn_fence(__ATOMIC_RELEASE, "agent");
            asm volatile("s_waitcnt vmcnt(0)" ::: "memory");
            const unsigned og = xb_add(&bar[XB_TOP], 1u);
            const unsigned tg = og / nx;
            if (og + 1u == (tg + 1u) * nx) xb_add(&bar[XB_TOPGEN], 1u);
            else XB_SPIN(xb_ld(&bar[XB_TOPGEN]) == tg, bar);
            __builtin_amdgcn_fence(__ATOMIC_ACQUIRE, "agent");
            xb_add(&bar[XB_XGEN(b.x)], 1u);
            asm volatile("s_waitcnt vmcnt(0)" ::: "memory");
        } else {
            XB_SPIN(xb_ld(&bar[XB_XGEN(b.x)]) == gen, bar);
            __builtin_amdgcn_fence(__ATOMIC_ACQUIRE, "agent");
            asm volatile("s_waitcnt vmcnt(0)" ::: "memory");
        }
    }
    __syncthreads();
}

constexpr int NWAVES = 8;
constexpr int NPHASES = 11;
struct Args { const void* in[27]; float* out; unsigned char* ws; int ph_lo, ph_hi, li, pad; };

struct Frame {
    LAS unsigned char* lds; unsigned char* ws; int tid, lane, wave, G, bid;
};

__device__ __forceinline__ void p0_transpose_tile(const float* W, int K, int N, bf16* WT, int row_off, int rmul, LAS float* scr, int tile, int tid) {
    const int nnb = N / 512, kb = tile / nnb, nb = tile % nnb, k0 = 64 * kb, n0 = 512 * nb;
    const int c4 = tid & 127, rr = tid >> 7;
    f32x4 v[16];
#pragma unroll
    for (int i = 0; i < 16; ++i) v[i] = *(const GAS f32x4*)(W + (size_t)(k0 + 4 * i + rr) * N + n0 + 4 * c4);
#pragma unroll
    for (int i = 0; i < 16; ++i) { const int k = 4 * i + rr; *(LAS f32x4*)(scr + k * 512 + ((4 * c4) ^ (4 * ((k >> 3) & 7)))) = v[i]; }
    __syncthreads();
    const int c = tid & 7, dn = tid >> 3;
#pragma unroll
    for (int j = 0; j < 8; ++j) { const int n = 64 * j + dn; const LAS float* sp = scr + (8 * c) * 512 + (n ^ (4 * c));
        v4u o; o.x = cvtpk(sp[0 * 512], sp[1 * 512]); o.y = cvtpk(sp[2 * 512], sp[3 * 512]); o.z = cvtpk(sp[4 * 512], sp[5 * 512]); o.w = cvtpk(sp[6 * 512], sp[7 * 512]);
        *(GAS v4u*)(WT + (size_t)(row_off + rmul * (n0 + n)) * K + k0 + 8 * c) = o; }
    __syncthreads();
}

__device__ __forceinline__ void p0_ssm_job(Frame& F, const Args& a, int job) {
    const int g = job >> 3, i = job & 7, tid = F.tid;
    const float* a_re = (const float*)a.in[7]; const float* a_im = (const float*)a.in[8]; const float* log_dt = (const float*)a.in[9];
    const float* b_re = (const float*)a.in[10]; const float* b_im = (const float*)a.in[11]; const float* c_re = (const float*)a.in[12]; const float* c_im = (const float*)a.in[13];
    LAS float* PW = (LAS float*)(F.lds);
    LAS float* BB = (LAS float*)(F.lds + 33280);
    LAS float* CC = (LAS float*)(F.lds + 41472);
    LAS bf16* KT = (LAS bf16*)(F.lds + 49664);
    if (tid < 64) {
        const int p = tid; const double are = a_re[g * 64 + p], aim = a_im[g * 64 + p]; const double dt = exp((double)log_dt[g]);
        const double mag = exp(are * dt), th = aim * dt; const double lr = mag * cos(th), li = mag * sin(th);
        double pr = 1.0, pi = 0.0;
        for (int j = 0; j <= 32; ++j) { PW[(j * 64 + p) * 2] = (float)pr; PW[(j * 64 + p) * 2 + 1] = (float)pi; const double nr = pr * lr - pi * li, ni = pr * li + pi * lr; pr = nr; pi = ni; }
        const double den = are * are + aim * aim; const double nr_ = lr - 1.0, ni_ = li;
        const double fr_ = (nr_ * are + ni_ * aim) / den, fi_ = (ni_ * are - nr_ * aim) / den;
        for (int ci = 0; ci < 16; ++ci) { const double br = b_re[(g * 64 + p) * 16 + ci], bi = b_im[(g * 64 + p) * 16 + ci];
            BB[(p * 16 + ci) * 2] = (float)(fr_ * br - fi_ * bi); BB[(p * 16 + ci) * 2 + 1] = (float)(fr_ * bi + fi_ * br); }
    }
    for (int e = tid; e < 1024; e += 512) { CC[e * 2] = c_re[g * 1024 + e]; CC[e * 2 + 1] = c_im[g * 1024 + e]; }
    __syncthreads();
    {
        const int ci = tid & 15, c2 = (tid >> 4) & 1, jq = tid >> 5, co = 2 * i + c2;
        float acc[2] = {0.f, 0.f};
        for (int p = 0; p < 64; ++p) { const float cr = CC[(co * 64 + p) * 2], cim = CC[(co * 64 + p) * 2 + 1], br = BB[(p * 16 + ci) * 2], bi = BB[(p * 16 + ci) * 2 + 1];
            const float xr = cr * br - cim * bi, xi = cr * bi + cim * br;
#pragma unroll
            for (int q = 0; q < 2; ++q) { const int j = 2 * jq + q; acc[q] += xr * PW[(j * 64 + p) * 2] - xi * PW[(j * 64 + p) * 2 + 1]; } }
#pragma unroll
        for (int q = 0; q < 2; ++q) { const int j = 2 * jq + q; KT[(j * 2 + c2) * 16 + ci] = (bf16)(cvtpk(acc[q], 0.f) & 0xffffu); }
    }
    __syncthreads();
    bf16* toep = (bf16*)(F.ws + WS_TOEP) + (size_t)g * 1024 * UP_PITCH;
    for (int q = tid; q < 128 * 64; q += 512) { const int rl = q >> 6, chn = q & 63; const int t = rl >> 1, c2 = rl & 1, s = (t & 32) + (chn >> 1), half = chn & 1; const int n = t * 16 + 2 * i + c2;
        v4u w = (v4u){0u, 0u, 0u, 0u};
        if (t >= s) w = *(const LAS v4u*)(KT + ((t - s) * 2 + c2) * 16 + half * 8);
        *(GAS v4u*)(toep + (size_t)n * UP_PITCH + s * 16 + half * 8) = w; }
    for (int q = tid; q < 128 * 64; q += 512) { const int rl = q >> 6, p = q & 63; const int t = rl >> 1, c2 = rl & 1, co = 2 * i + c2; const int n = t * 16 + co; const int j = (t & 31) + 1;
        const float cr = CC[(co * 64 + p) * 2], cim = CC[(co * 64 + p) * 2 + 1], wr_ = PW[(j * 64 + p) * 2], wi_ = PW[(j * 64 + p) * 2 + 1];
        const float re = cr * wr_ - cim * wi_, im = cr * wi_ + cim * wr_;
        bf16* d = toep + (size_t)n * UP_PITCH + 1024 + 128 * (t >> 5) + p;
        d[0] = (bf16)(cvtpk(re, 0.f) & 0xffffu); d[64] = (bf16)(cvtpk(-im, 0.f) & 0xffffu); }
    bf16* wsin = (bf16*)(F.ws + WS_WSIN) + (size_t)g * 256 * 1024;
    for (int q = tid; q < 32 * 1024; q += 512) { const int rl = q >> 10, k = q & 1023; const int pp = 32 * i + rl, p = pp & 63, s = k >> 4, ci = k & 15;
        float v = 0.f;
        if ((s >> 5) == (pp >> 7)) { const int j = 31 - (s & 31); const float wr_ = PW[(j * 64 + p) * 2], wi_ = PW[(j * 64 + p) * 2 + 1], br = BB[(p * 16 + ci) * 2], bi = BB[(p * 16 + ci) * 2 + 1];
            v = ((pp & 64) == 0) ? (wr_ * br - wi_ * bi) : (wr_ * bi + wi_ * br); }
        wsin[(size_t)pp * 1024 + k] = (bf16)(cvtpk(v, 0.f) & 0xffffu); }
    if (i == 0 && tid < 64) { float* lamb = (float*)(F.ws + WS_LAMB) + (g * 64 + tid) * 2; lamb[0] = PW[(32 * 64 + tid) * 2]; lamb[1] = PW[(32 * 64 + tid) * 2 + 1]; }
    __syncthreads();
}

__device__ __forceinline__ void p0_prologue(Frame& F, const Args& a) {
    for (int job = F.bid; job < 256; job += F.G) p0_ssm_job(F, a, job);
    LAS float* scr = (LAS float*)(F.lds);
    const int gw = F.bid * NWAVES + F.wave, NGW = F.G * NWAVES;
    const float* w_in = (const float*)a.in[1]; const float* w_glu = (const float*)a.in[15]; const float* w_out = (const float*)a.in[17];
    const float* wg = (const float*)a.in[22]; const float* wu = (const float*)a.in[23]; const float* wd = (const float*)a.in[24];
    constexpr int I_IN = 16 * 4, I_GLU = 8 * 1, I_OUT = 16 * 2, I_G = 16 * 1, I_D = 8 * 2;
    constexpr int NTILES = I_IN + I_GLU + I_OUT + NEXP * (2 * I_G);
    for (int it = F.bid; it < NTILES; it += F.G) {
        int r = it;
        if (r < I_IN) { p0_transpose_tile(w_in, 1024, 2048, (bf16*)(F.ws + WS_WIN_T), 0, 1, scr, r, F.tid); continue; } r -= I_IN;
        if (r < I_GLU) { p0_transpose_tile(w_glu, 512, 512, (bf16*)(F.ws + WS_WGLU_T), 0, 1, scr, r, F.tid); continue; } r -= I_GLU;
        if (r < I_OUT) { p0_transpose_tile(w_out, 1024, 1024, (bf16*)(F.ws + WS_WOUT_T), 0, 1, scr, r, F.tid); continue; } r -= I_OUT;
        const int e = r / (2 * I_G); r -= e * (2 * I_G);
        if (r < I_G) { p0_transpose_tile(wg + (size_t)e * 1024 * 512, 1024, 512, (bf16*)(F.ws + WS_WG1) + (size_t)e * 1024 * 1024, 0, 2, scr, r, F.tid); continue; } r -= I_G;
        p0_transpose_tile(wu + (size_t)e * 1024 * 512, 1024, 512, (bf16*)(F.ws + WS_WG1) + (size_t)e * 1024 * 1024, 1, 2, scr, r, F.tid);
    }
    (void)wd; (void)I_D;
    const float* x = (const float*)a.in[0]; bf16* xb = (bf16*)(F.ws + WS_XB);
    for (int m = gw; m < TOK; m += NGW) {
        const GAS f32x4* xr = (const GAS f32x4*)(x + (size_t)m * DM) + F.lane; GAS v2u* o8 = (GAS v2u*)(xb + (size_t)m * DM) + F.lane;
        f32x4 v[4];
#pragma unroll
        for (int j = 0; j < 4; ++j) v[j] = xr[64 * j];
#pragma unroll
        for (int j = 0; j < 4; ++j) o8[64 * j] = (v2u){cvtpk(v[j][0], v[j][1]), cvtpk(v[j][2], v[j][3])};
    }
}

__device__ __forceinline__ void p2_tail_transposes(Frame& F, const Args& a, int first_wg) {
    const float* wd = (const float*)a.in[24]; LAS float* scr = (LAS float*)(F.lds);
    const int nw = F.G - first_wg;
    if (nw > 0 && F.bid < first_wg) return;
    const int me = nw > 0 ? F.bid - first_wg : F.bid, step = nw > 0 ? nw : F.G;
    for (int it = me; it < NEXP * 16; it += step) { const int e = it >> 4, r = it & 15;
        p0_transpose_tile(wd + (size_t)e * 512 * 1024, 512, 1024, (bf16*)(F.ws + WS_WD) + (size_t)e * 1024 * 512, 0, 1, scr, r, F.tid); }
}

__device__ __forceinline__ void p3_scan(Frame& F, const float* sstate, int g, int pm) {
    const int tid = F.tid, lane = F.lane, wave = F.wave;
    const unsigned lds0 = (unsigned)(uintptr_t)(F.lds);
    LAS float* SB = (LAS float*)F.lds;
    LAS bf16* HS = (LAS bf16*)(F.lds + 98304);
    const float* ss = sstate + (size_t)(g * 512 + 4 * pm * 64) * 256;
    bf16* up = (bf16*)(F.ws + WS_UPERM) + (size_t)(g * 512 + 4 * pm * 64) * UP_PITCH + 1024;
#define P3_DMA(k, buf) do { _Pragma("unroll") for (int q_ = 0; q_ < 8; ++q_) { const int r_ = 8 * wave + q_; \
        att::glds16(ss + (size_t)((r_ >> 3) * 64 + 8 * (k) + (r_ & 7)) * 256 + lane * 4, (unsigned)__builtin_amdgcn_readfirstlane(lds0 + (buf) * 32768 + r_ * 1024)); } } while (0)
    if (wave < 4) {
        const int bb = tid >> 6, p = tid & 63;
        const float* lamb = (const float*)(F.ws + WS_LAMB) + (g * 64 + p) * 2; const float lr = lamb[0], li = lamb[1];
        asm volatile("s_waitcnt vmcnt(0)" :: "v"(lr), "v"(li) : "memory");
        float hr = 0.f, hi_ = 0.f;
        P3_DMA(0, 0); P3_DMA(1, 1);
        int buf = 0;
        for (int k = 0; k < 8; ++k) {
            if (k < 7) asm volatile("s_waitcnt vmcnt(8) lgkmcnt(0)\n\ts_barrier" ::: "memory"); else asm volatile("s_waitcnt vmcnt(0) lgkmcnt(0)\n\ts_barrier" ::: "memory");
            if (k + 2 < 8) { const int b2 = (buf >= 1) ? buf - 1 : buf + 2; P3_DMA(k + 2, b2); }
            const LAS float* sb = SB + buf * 8192 + bb * 8 * 256 + p; LAS bf16* hs = HS + (k & 1) * 8192 + bb * 8 * 256 + p;
#pragma unroll
            for (int j = 0; j < 8; ++j) { const float s0r = sb[j * 256], s0i = sb[j * 256 + 64], s1r = sb[j * 256 + 128], s1i = sb[j * 256 + 192];
                hs[j * 256] = (bf16)(cvtpk(hr, 0.f) & 0xffffu); hs[j * 256 + 64] = (bf16)(cvtpk(hi_, 0.f) & 0xffffu);
                float nr = lr * hr - li * hi_ + s0r, ni = lr * hi_ + li * hr + s0i; hr = nr; hi_ = ni;
                hs[j * 256 + 128] = (bf16)(cvtpk(hr, 0.f) & 0xffffu); hs[j * 256 + 192] = (bf16)(cvtpk(hi_, 0.f) & 0xffffu);
                nr = lr * hr - li * hi_ + s1r; ni = lr * hi_ + li * hr + s1i; hr = nr; hi_ = ni; }
            asm volatile("s_waitcnt lgkmcnt(0)\n\ts_barrier" ::: "memory");
            buf = (buf == 2) ? 0 : buf + 1;
        }
    } else {
        const int t2 = tid - 256;
        for (int k = 0; k < 8; ++k) {
            asm volatile("s_waitcnt lgkmcnt(0)\n\ts_barrier" ::: "memory");
            asm volatile("s_waitcnt lgkmcnt(0)\n\ts_barrier" ::: "memory");
#pragma unroll
            for (int q = 0; q < 4; ++q) { const int idx = t2 + 256 * q; const int r = idx >> 5, ch = idx & 31;
                const v4u w = *(const LAS v4u*)(HS + (k & 1) * 8192 + r * 256 + ch * 8);
                *(GAS v4u*)(up + (size_t)((r >> 3) * 64 + 8 * k + (r & 7)) * UP_PITCH + ch * 8) = w; }
        }
    }
#undef P3_DMA
    VM_WAIT(); LDS_WAIT(); __syncthreads();
}

__device__ __forceinline__ void p6_job(Frame& F, const Args& a, int job) {
    const int tid = F.tid, lane = F.lane, wave = F.wave;
    LAS _Float16* WR = (LAS _Float16*)F.lds;
    LAS float* LG = (LAS float*)(F.lds + 99072) + wave * 768;
    LAS int* SLE = (LAS int*)(F.lds + 99072 + 24576);
    LAS float* SLW = (LAS float*)(F.lds + 99072 + 24576 + 1024);
    LAS int* LCNT = (LAS int*)(F.lds + 99072 + 24576 + 2048);
    LAS int* LBASE = LCNT + 32; LAS int* LRANK = LCNT + 64;
    const bf16* pre = (const bf16*)(F.ws + WS_PREB); const f32x2* stats = (const f32x2*)(F.ws + WS_STATS);
    const float* g1 = (const float*)a.in[18]; const float* b1 = (const float*)a.in[19];
    bf16* hb = (bf16*)(F.ws + WS_HB);
    if (tid < 32) LCNT[tid] = 0;
    const int r0 = job * 128 + wave * 16; const int row = r0 + (lane & 15), kg = lane >> 4;
    float mean, rstd;
    { const f32x4* sp = (const f32x4*)(stats + (size_t)row * 16); float ms = 0.f; f32x4 q[8];
#pragma unroll
        for (int j = 0; j < 8; ++j) { q[j] = sp[j]; ms += q[j][0] + q[j][2]; }
        mean = ms * (1.0f / 16.0f); float m2 = 0.f;
#pragma unroll
        for (int j = 0; j < 8; ++j) { const float d0 = q[j][0] - mean, d1 = q[j][2] - mean; m2 += q[j][1] + q[j][3] + 64.0f * (d0 * d0 + d1 * d1); }
        rstd = 1.0f / sqrtf(m2 * (1.0f / 1024.0f) + LN_EPS); }
    f32x4 acc[3] = {(f32x4){0.f, 0.f, 0.f, 0.f}, (f32x4){0.f, 0.f, 0.f, 0.f}, (f32x4){0.f, 0.f, 0.f, 0.f}};
    const LAS float* GL = (const LAS float*)(F.lds + LDSCTL_OFF + 4096);
    v4u xq[8];
#pragma unroll
    for (int j = 0; j < 8; ++j) xq[j] = *(const v4u*)(pre + (size_t)row * DM + j * 32 + kg * 8);
#pragma unroll 1
    for (int kb = 0; kb < 4; ++kb) {
#pragma unroll
        for (int j = 0; j < 8; ++j) {
            const int ks = kb * 8 + j; const int col = ks * 32 + kg * 8;
            const v4u xw = xq[j];
            if (kb < 3) xq[j] = *(const v4u*)(pre + (size_t)row * DM + col + 256);
            const f32x4 x0 = (f32x4){bf_lo(xw.x), bf_hi(xw.x), bf_lo(xw.y), bf_hi(xw.y)}, x1 = (f32x4){bf_lo(xw.z), bf_hi(xw.z), bf_lo(xw.w), bf_hi(xw.w)};
            const f32x4 ga = *(const LAS f32x4*)(GL + col), gb = *(const LAS f32x4*)(GL + col + 4), ba = *(const LAS f32x4*)(GL + 1024 + col), bb = *(const LAS f32x4*)(GL + 1024 + col + 4);
            const f32x4 h0 = (x0 - mean) * rstd * ga + ba, h1 = (x1 - mean) * rstd * gb + bb;
            v4u w; w.x = cvtpk(h0[0], h0[1]); w.y = cvtpk(h0[2], h0[3]); w.z = cvtpk(h1[0], h1[1]); w.w = cvtpk(h1[2], h1[3]);
            *(v4u*)(hb + (size_t)row * DM + col) = w;
            f16x8 af; af[0] = (_Float16)h0[0]; af[1] = (_Float16)h0[1]; af[2] = (_Float16)h0[2]; af[3] = (_Float16)h0[3]; af[4] = (_Float16)h1[0]; af[5] = (_Float16)h1[1]; af[6] = (_Float16)h1[2]; af[7] = (_Float16)h1[3];
#pragma unroll
            for (int ntile = 0; ntile < 3; ++ntile) { const f16x8 bf = *(const LAS f16x8*)(WR + (ntile * 16 + (lane & 15)) * 1032 + col);
                acc[ntile] = __builtin_amdgcn_mfma_f32_16x16x32_f16(af, bf, acc[ntile], 0, 0, 0); }
        }
    }
#pragma unroll
    for (int ntile = 0; ntile < 3; ++ntile)
#pragma unroll
        for (int i = 0; i < 4; ++i) LG[(4 * kg + i) * 48 + ntile * 16 + (lane & 15)] = acc[ntile][i];
    LDS_WAIT(); asm volatile("" ::: "memory");
    if (lane < 16) {
        const LAS float* L = LG + lane * 48;
        float gm = L[0]; int gi = 0;
#pragma unroll
        for (int j = 1; j < 4; ++j) { const float v = L[j]; if (v > gm) { gm = v; gi = j; } }
        float gs = 0.f;
#pragma unroll
        for (int j = 0; j < 4; ++j) gs += __expf(L[j] - gm);
        const float gp = 1.0f / gs;
        float ev[8];
#pragma unroll
        for (int j = 0; j < 8; ++j) ev[j] = L[4 + gi * 8 + j];
        float m1 = ev[0]; int i1 = 0;
#pragma unroll
        for (int j = 1; j < 8; ++j) if (ev[j] > m1) { m1 = ev[j]; i1 = j; }
        float m2 = -INFINITY; int i2 = 0;
#pragma unroll
        for (int j = 0; j < 8; ++j) if (j != i1 && ev[j] > m2) { m2 = ev[j]; i2 = j; }
        const float ex = __expf(m2 - m1); const float w1 = 1.0f / (1.0f + ex), w2 = ex * w1;
        const int sl = (wave * 16 + lane) * 2;
        SLE[sl] = gi * 8 + i1; SLE[sl + 1] = gi * 8 + i2; SLW[sl] = gp * w1; SLW[sl + 1] = gp * w2;
    }
    __syncthreads();
    int e = 0;
    if (tid < 256) { e = SLE[tid]; LRANK[tid] = __hip_atomic_fetch_add(LCNT + e, 1, __ATOMIC_RELAXED, __HIP_MEMORY_SCOPE_WORKGROUP); }
    __syncthreads();
    if (tid < 32) LBASE[tid] = (int)__hip_atomic_fetch_add((gu32*)(F.ws + WS_CTL) + CW_GCNT + tid, (unsigned)LCNT[tid], RLX_AGENT);
    __syncthreads();
    if (tid < 256) { const int pos = LBASE[e] + LRANK[tid];
        ((int*)(F.ws + WS_ESLOT))[e * 65536 + pos] = job * 256 + tid; ((float*)(F.ws + WS_EW))[e * 65536 + pos] = SLW[tid]; }
    __syncthreads();
}

__device__ __forceinline__ int moe_layout(Frame& F, LAS int* pstart) {
    LAS int* tile_e = (LAS int*)(F.lds + TILE_E_OFF); LAS int* ecnt = pstart + 40;
    if (F.tid < 64) { const int e = F.tid & 31;
        const int c = (int)__hip_atomic_load((gu32*)(F.ws + WS_CTL) + CW_GCNT + e, RLX_AGENT); const int nf = c >> 8, hp = (c & 255) ? 1 : 0;
        int inf = nf, inp = hp;
#pragma unroll
        for (int o = 1; o < 32; o <<= 1) { const int v = __shfl_up(inf, o, 32), w = __shfl_up(inp, o, 32); if (e >= o) { inf += v; inp += w; } }
        const int totf = __shfl(inf, 31, 32), totp = __shfl(inp, 31, 32);
        if (F.tid < 32) { ecnt[e] = c; if (e == 0) pstart[32] = (totf + totp) << 8;
            const int sf = inf - nf; for (int t = 0; t < nf; ++t) tile_e[sf + t] = e | (t << 8);
            if (hp) tile_e[totf + inp - 1] = e | (nf << 8); } }
    __syncthreads();
    return pstart[NEXP] >> 8;
}

__global__ void __launch_bounds__(NWAVES * 64, 2) trunk_fwd(Args args) {
    extern __shared__ __attribute__((aligned(16))) unsigned char lds[];
    Frame F; F.lds = (LAS unsigned char*)lds; F.ws = args.ws; F.tid = threadIdx.x; F.lane = F.tid & 63; F.wave = __builtin_amdgcn_readfirstlane(F.tid >> 6); F.G = gridDim.x; F.bid = blockIdx.x;
    volatile LAS unsigned* MISC = (volatile LAS unsigned*)(F.lds + MISC_OFF);
    LAS int* PSTART = (LAS int*)(F.lds + LDSCTL_OFF);
    for (int u = F.tid; u < (LDS_BYTES - LDSCTL_OFF) / 4; u += NWAVES * 64) ((LAS unsigned*)(F.lds + LDSCTL_OFF))[u] = 0u;
    __syncthreads();
    gu32* ctl = (gu32*)(args.ws + WS_CTL);
    const int lo = args.ph_lo, hi = args.ph_hi;
    const bool multi = (hi - lo) > 1;
    XcdBarrier bar; bar.bar = (unsigned*)ctl + CW_BAR + args.li * XCD_BAR_WORDS; bar.x = 0; bar.st = nullptr;
    if (multi) bar = xcd_barrier_post((unsigned*)ctl + CW_BAR + args.li * XCD_BAR_WORDS, MISC + 8);
#define IN(k) (lo <= (k) && (k) < hi)
#define SEAM(k) do { if (IN(k) && IN((k) + 1)) xcd_barrier(bar); } while (0)
    bf16* const XB = (bf16*)(args.ws + WS_XB); bf16* const PROJ = (bf16*)(args.ws + WS_PROJ); bf16* const UPERM = (bf16*)(args.ws + WS_UPERM);
    bf16* const ZB = (bf16*)(args.ws + WS_Z); bf16* const CAT = (bf16*)(args.ws + WS_CAT); bf16* const HB = (bf16*)(args.ws + WS_HB);
    bf16* const HID = (bf16*)(args.ws + WS_HID); bf16* const Y2 = (bf16*)(args.ws + WS_Y2); bf16* const PREB = (bf16*)(args.ws + WS_PREB);

    if (IN(0)) { p0_prologue(F, args); }
    SEAM(0);
    if (IN(1)) {
        pg8::DenseOrder S; S.init(XB, args.ws + WS_WIN_T, 1024, 1024, TOK, NPROJ, F.G, F.bid);
        pg8::EpiInProj E{PROJ, PROJ + (size_t)TOK * 512, PROJ + (size_t)TOK * 1024, UPERM};
        pg8::gemm_phase<pg8::EpiInProj, pg8::DenseOrder, true>(F.lds, 1024, 1024, 1024, S, E);
    }
    SEAM(1);
    if (IN(2)) {
        for (int u = F.bid; u < 64; u += F.G) {
            const int g = u >> 1, pm = u & 1;
            pg8::OneUnit S; S.A = (const char*)(UPERM + (size_t)(g * 512 + pm * 256) * UP_PITCH); S.Bt = (const char*)((bf16*)(args.ws + WS_WSIN) + (size_t)g * 256 * 1024); S.u0 = pg8::Unit{pm, 0, g};
            pg8::EpiState E{args.out};
            pg8::gemm_phase<pg8::EpiState, pg8::OneUnit, true>(F.lds, 1024, UP_PITCH, 1024, S, E);
        }
        const float* lq1 = (const float*)args.in[2]; const float* lk1 = (const float*)args.in[3]; const float* lq2 = (const float*)args.in[4]; const float* lk2 = (const float*)args.in[5];
        const float s1 = wave_sum(lq1[F.lane] * lk1[F.lane]), s2 = wave_sum(lq2[F.lane] * lk2[F.lane]);
        const float lam = expf(s1) - expf(s2) + LAM_INIT;
        const int vcu = (F.G % 8 == 0) ? (F.bid % 8) * (F.G / 8) + F.bid / 8 : F.bid;
        for (int v = vcu; v < 256; v += F.G) {
            const int xg = v >> 5, j = v & 31;
#pragma unroll 1
            for (int i = 0; i < 4; ++i) { const int bh = xg * 4 + i; const int qb = (i & 1) ? 31 - j : j;
                att::attn_unit(bh >> 2, bh & 3, qb, PROJ, CAT, (char*)lds, lam, (const float*)args.in[6]); }
        }
        p2_tail_transposes(F, args, 64);
    }
    SEAM(2);
    if (IN(3)) {
        for (int u = F.bid; u < 256; u += F.G) {
            const int g = u >> 3, pm = (u >> 2) & 1, pn = u & 3;
            p3_scan(F, args.out, g, pm);
            pg8::SsmUnit S; S.A = (const char*)(UPERM + (size_t)(g * 512 + pm * 256) * UP_PITCH); S.Bt = (const char*)((bf16*)(args.ws + WS_TOEP) + (size_t)(g * 1024 + pn * 256) * UP_PITCH); S.u0 = pg8::Unit{pm, pn, g}; S.first = 8 * (pn >> 1); S.cnt = 4 * (pn & 1) + 4; S.st = 16 + 2 * (pn >> 1);
            pg8::EpiSsmOut E{UPERM, (const float*)args.in[14], ZB};
            pg8::gemm_phase<pg8::EpiSsmOut, pg8::SsmUnit, true>(F.lds, UP_PITCH, UP_PITCH, UP_PITCH, S, E);
        }
    }
    SEAM(3);
    if (IN(4)) {
        pg8::DenseOrder S; S.init(ZB, args.ws + WS_WGLU_T, 512, 512, TOK, SSMW, F.G, F.bid);
        pg8::EpiGlu E{ZB, (const float*)args.in[16], CAT};
        pg8::gemm_phase<pg8::EpiGlu, pg8::DenseOrder, true>(F.lds, 512, 512, 512, S, E);
    }
    SEAM(4);
    if (IN(5)) {
        pg8::DenseOrder S; S.init(CAT, args.ws + WS_WOUT_T, 1024, 1024, TOK, DM, F.G, F.bid);
        pg8::EpiOutProj E{XB, PREB, (f32x2*)(args.ws + WS_STATS)};
        pg8::gemm_phase<pg8::EpiOutProj, pg8::DenseOrder, true>(F.lds, 1024, 1024, 1024, S, E);
    }
    SEAM(5);
    if (IN(6)) {
        {
            LAS _Float16* WR = (LAS _Float16*)F.lds; const float* wrg = (const float*)args.in[20]; const float* wre = (const float*)args.in[21];
            for (int q = F.tid; q < 1024 * 4; q += 512) { const int k = q >> 2, n = q & 3; WR[n * 1032 + k] = (_Float16)wrg[q]; }
            for (int q = F.tid; q < 1024 * 32; q += 512) { const int k = q >> 5, n = q & 31; WR[(4 + n) * 1032 + k] = (_Float16)wre[q]; }
            for (int q = F.tid; q < 12 * 1032; q += 512) WR[36 * 1032 + q] = (_Float16)0.f;
            LAS float* GL = (LAS float*)(F.lds + LDSCTL_OFF + 4096); const float* g1_ = (const float*)args.in[18]; const float* b1_ = (const float*)args.in[19];
            for (int q = F.tid; q < 1024; q += 512) { GL[q] = g1_[q]; GL[1024 + q] = b1_[q]; }
        }
        __syncthreads();
        for (int job = F.bid; job < 256; job += F.G) p6_job(F, args, job);
    }
    SEAM(6);
    if (IN(8)) {
        const int ntiles = moe_layout(F, PSTART);
        pg8::MoeOrder<true> S; S.A = (const char*)HB; S.W = (const char*)(args.ws + WS_WG1); S.eslot = (const int*)(args.ws + WS_ESLOT); S.tile_e = (const LAS int*)(F.lds + TILE_E_OFF); S.ecnt = PSTART + 40; S.ntiles = ntiles; S.G = F.G; S.c = F.bid; S.lda = 1024; S.ldb = 1024;
        { const int per = F.G >> 5, chunk = (ntiles + 7) >> 3; S.lt_lim = (chunk / per) * per; }
        pg8::EpiMoe1 E{HID};
        pg8::gemm_phase<pg8::EpiMoe1, pg8::MoeOrder<true>, true>(F.lds, 1024, 1024, 1024, S, E);
    }
    SEAM(8);
    if (IN(9)) {
        const int ntiles = moe_layout(F, PSTART);
        const int x = F.bid & 7, j = F.bid >> 3, per = F.G >> 5, chunk = (ntiles + 7) >> 3, lt_main = (chunk / per) * per;
        int tiles_x = ntiles - x * chunk; tiles_x = tiles_x < 0 ? 0 : (tiles_x > chunk ? chunk : tiles_x);
        const int tail0 = lt_main < tiles_x ? lt_main : tiles_x; const int P = 4 * (tiles_x - tail0), U = 4 * tiles_x;
        const LAS int* tile_e = (const LAS int*)(F.lds + TILE_E_OFF);
        if (j < P) {
            pg8::MoeUnits<true> S; S.A = (const char*)HB; S.W = (const char*)(args.ws + WS_WG1); S.eslot = (const int*)(args.ws + WS_ESLOT); S.tile_e = tile_e; S.ecnt = PSTART + 40;
            S.tile0 = x * chunk; S.u_lo = 4 * tail0 + j; S.u_hi = S.u_lo + 1; S.lda = 1024; S.ldb = 1024;
            pg8::EpiMoe1T<true> E{HID};
            pg8::gemm_phase<pg8::EpiMoe1T<true>, pg8::MoeUnits<true>, true>(F.lds, 1024, 1024, 1024, S, E);
            if (F.tid == 0) __hip_atomic_fetch_add(ctl + CW_TAILCNT + x * chunk + tail0 + (j >> 2), 1u, RLX_AGENT);
        }
        const int tot = U + P, E_ = tot >> 5, rem = tot & 31, A_ = 32 - rem;
        const int sA = P < A_ ? P : A_, sB = P < A_ ? A_ : P;
        const int quota = E_ - 1 + (j >= sA ? 1 : 0) + (j >= sB ? 1 : 0);
        pg8::MoeRounds S; S.A = (const char*)HID; S.W = (const char*)(args.ws + WS_WD); S.tile_e = tile_e; S.ecnt = PSTART + 40; S.tile0 = x * chunk; S.j = j; S.E = E_; S.sA = sA; S.sB = sB; S.lda = 512; S.ldb = 512;
        int r_split = quota; for (int r = quota - 1; r >= 0; --r) if (S.lt_of(r) >= tail0) r_split = r;
        pg8::EpiMoe2 E{(const int*)(args.ws + WS_ESLOT), (const float*)(args.ws + WS_EW), PSTART + 40, Y2};
        S.r_lo = 0; S.r_hi = r_split;
        pg8::gemm_phase<pg8::EpiMoe2, pg8::MoeRounds, true>(F.lds, 512, 512, 512, S, E);
        if (quota > r_split) {
            if (F.tid == 0) {
                for (int r = r_split; r < quota; ++r) { gu32* cw = ctl + CW_TAILCNT + x * chunk + S.lt_of(r); unsigned sp = 0;
                    while (__hip_atomic_load(cw, RLX_AGENT) < 4u) { __builtin_amdgcn_s_sleep(2); if (++sp > (1u << 22)) break; } }
                __builtin_amdgcn_fence(__ATOMIC_ACQUIRE, "agent"); asm volatile("s_waitcnt vmcnt(0)" ::: "memory");
            }
            __syncthreads();
            S.r_lo = r_split; S.r_hi = quota;
            pg8::gemm_phase<pg8::EpiMoe2, pg8::MoeRounds, true>(F.lds, 512, 512, 512, S, E);
        }
    }
    SEAM(9);
    if (IN(10)) {
        const int gw = F.bid * NWAVES + F.wave, NGW = F.G * NWAVES;
        const float* g2 = (const float*)args.in[25]; const float* b2 = (const float*)args.in[26];
        for (int m = gw; m < TOK; m += NGW) {
            const GAS v2u* hr = (const GAS v2u*)(HB + (size_t)m * DM) + F.lane; const GAS v2u* y0 = (const GAS v2u*)(Y2 + (size_t)(2 * m) * DM) + F.lane; const GAS v2u* y1 = (const GAS v2u*)(Y2 + (size_t)(2 * m + 1) * DM) + F.lane;
            f32x4 v[4]; float s = 0.f;
#pragma unroll
            for (int j = 0; j < 4; ++j) { const v2u a = hr[64 * j], b = y0[64 * j], c = y1[64 * j];
                v[j][0] = ALPHA * bf_lo(a.x) + bf_lo(b.x) + bf_lo(c.x); v[j][1] = ALPHA * bf_hi(a.x) + bf_hi(b.x) + bf_hi(c.x);
                v[j][2] = ALPHA * bf_lo(a.y) + bf_lo(b.y) + bf_lo(c.y); v[j][3] = ALPHA * bf_hi(a.y) + bf_hi(b.y) + bf_hi(c.y);
                s += (v[j][0] + v[j][1]) + (v[j][2] + v[j][3]); }
            const float mean = wave_sum(s) * (1.f / DM); float s2 = 0.f;
#pragma unroll
            for (int j = 0; j < 4; ++j) { v[j] = v[j] - mean; s2 += (v[j][0] * v[j][0] + v[j][1] * v[j][1]) + (v[j][2] * v[j][2] + v[j][3] * v[j][3]); }
            const float rstd = 1.f / sqrtf(wave_sum(s2) * (1.f / DM) + LN_EPS);
            GAS f32x4* o = (GAS f32x4*)(args.out + (size_t)m * DM) + F.lane;
#pragma unroll
            for (int j = 0; j < 4; ++j) { const f32x4 gg = *((const GAS f32x4*)g2 + F.lane + 64 * j), bb = *((const GAS f32x4*)b2 + F.lane + 64 * j); o[64 * j] = v[j] * rstd * gg + bb; }
        }
    }
#undef IN
#undef SEAM
}

extern "C" void kernel_launch(void* const* d_in, const int* in_sizes, int n_in, void* d_out, int out_size, void* d_ws, size_t ws_size, hipStream_t stream) {
    static int grid = 0;
    if (grid == 0) {
        if (n_in != 27 || in_sizes[0] != TOK * DM || out_size != TOK * DM || ws_size < WS_END) { fprintf(stderr, "kernel_launch: unexpected shapes (n_in %d, in0 %d, out %d, ws %zu); nothing launched\n", n_in, n_in > 0 ? in_sizes[0] : -1, out_size, ws_size); grid = -1; return; }
        int dev = 0, cus = 0, per_cu = 0;
        if (hipGetDevice(&dev) != hipSuccess || hipDeviceGetAttribute(&cus, hipDeviceAttributeMultiprocessorCount, dev) != hipSuccess) { fprintf(stderr, "kernel_launch: device query failed\n"); grid = -1; return; }
        if (hipFuncSetAttribute((const void*)trunk_fwd, hipFuncAttributeMaxDynamicSharedMemorySize, LDS_BYTES) != hipSuccess) { fprintf(stderr, "kernel_launch: hipFuncSetAttribute failed\n"); grid = -1; return; }
        if (hipOccupancyMaxActiveBlocksPerMultiprocessor(&per_cu, (const void*)trunk_fwd, NWAVES * 64, LDS_BYTES) != hipSuccess || per_cu < 1) { fprintf(stderr, "kernel_launch: occupancy query reports %d blocks per CU\n", per_cu); per_cu = 1; }
        (void)hipGetLastError();
        grid = cus;
        if (grid != 256) fprintf(stderr, "kernel_launch: note: %d CUs (kernel tuned for 256)\n", grid);
    }
    if (grid < 0) return;
    (void)hipMemsetAsync((char*)d_ws + WS_CTL, 0, CTL_ZERO_BYTES, stream);
    Args a{};
    for (int i = 0; i < 27; ++i) a.in[i] = d_in[i];
    a.out = (float*)d_out; a.ws = (unsigned char*)d_ws;
    if (PROBE_DUP >= 0) { a.ph_lo = 0; a.ph_hi = PROBE_DUP + 1; a.li = 0; hipLaunchKernelGGL(trunk_fwd, dim3(grid), dim3(NWAVES * 64), LDS_BYTES, stream, a);
        a.ph_lo = PROBE_DUP; a.ph_hi = NPHASES; a.li = 1; hipLaunchKernelGGL(trunk_fwd, dim3(grid), dim3(NWAVES * 64), LDS_BYTES, stream, a); }
    else if (MK_N_LAUNCHES == 1) { a.ph_lo = 0; a.ph_hi = NPHASES; hipLaunchKernelGGL(trunk_fwd, dim3(grid), dim3(NWAVES * 64), LDS_BYTES, stream, a); }
    else { for (int p = 0; p < NPHASES; ++p) { a.ph_lo = p; a.ph_hi = p + 1; hipLaunchKernelGGL(trunk_fwd, dim3(grid), dim3(NWAVES * 64), LDS_BYTES, stream, a); } }
}
```

```cpp
#include <hip/hip_runtime.h>
#include <cstdio>
#include <cstdint>
#include <cmath>

#ifndef MK_N_LAUNCHES
#define MK_N_LAUNCHES 1
#endif
#ifndef PROBE_DUP
#define PROBE_DUP (-1)
#endif

constexpr int BATCH = 8, SEQ = 4096, DM = 1024, TOK = BATCH * SEQ;
constexpr int NPROJ = 2048, QKV_PITCH = 1536;
constexpr int NGRP = 32, GCH = 16, NSTATE = 64, SSMW = 512;
constexpr int NEXP = 32, DEXP = 512;
constexpr int UP_PITCH = 1280;
constexpr float LN_EPS = 1e-5f, RMS_EPS = 1e-5f;
constexpr float ALPHA = 1.189207115002721f;
constexpr float QSCALE = 0.125f * 1.4426950408889634f;
constexpr float LAM_INIT = 0.2f;
constexpr int MOE_MAXTILES = 288;
constexpr int MOE_MAXROWS = MOE_MAXTILES * 256;

constexpr size_t MiB = 1u << 20;
constexpr size_t WS_CTL = 0, CTL_ZERO_BYTES = 64 * 1024;
constexpr size_t WS_STATS = 1 * MiB;
constexpr size_t WS_LAMB = 7 * MiB + 512 * 1024;
constexpr size_t WS_WIN_T = 8 * MiB;
constexpr size_t WS_WOUT_T = 12 * MiB;
constexpr size_t WS_WGLU_T = 14 * MiB;
constexpr size_t WS_WG1 = 24 * MiB;
constexpr size_t WS_WD = 88 * MiB;
constexpr size_t WS_TOEP = 120 * MiB;
constexpr size_t WS_HB = 120 * MiB;
constexpr size_t WS_WSIN = 200 * MiB;
constexpr size_t WS_ESLOT = 200 * MiB;
constexpr size_t WS_EW = 208 * MiB;
constexpr size_t WS_XB = 216 * MiB;
constexpr size_t WS_PROJ = 280 * MiB;
constexpr size_t WS_UPERM = 376 * MiB;
constexpr size_t WS_PREB = 280 * MiB;
constexpr size_t WS_Y2 = 280 * MiB;
constexpr size_t WS_Z = 416 * MiB;
constexpr size_t WS_CAT = 448 * MiB;
constexpr size_t WS_HID = 416 * MiB;
constexpr size_t WS_END = 512 * MiB;
static_assert(WS_Y2 + (size_t)(65536 + 256) * 1024 * 2 <= WS_Z && WS_TOEP + (size_t)32 * 1024 * UP_PITCH * 2 <= WS_WSIN && WS_XB + (size_t)TOK * DM * 2 <= WS_PROJ && WS_PROJ + (size_t)TOK * 1536 * 2 <= WS_UPERM, "ws map");
static_assert(WS_HID + (size_t)MOE_MAXROWS * 512 * 2 <= WS_END, "HID overlay");
static_assert(WS_UPERM + (size_t)32 * 512 * UP_PITCH * 2 <= WS_Z, "UPERM");
constexpr int CW_TMO = 0, CW_CODE = 1;
constexpr int CW_GCNT = 64;
constexpr int CW_TAILCNT = 128;
constexpr int CW_BAR = 4096;

constexpr int RING_BYTES = 131072;
constexpr int LDSCTL_OFF = RING_BYTES, MISC_OFF = LDSCTL_OFF + 320, TILE_E_OFF = LDSCTL_OFF + 512;
constexpr int LDS_BYTES = 147456;

#define GAS __attribute__((address_space(1)))
#define LAS __attribute__((address_space(3)))
typedef unsigned short bf16;
typedef unsigned v4u __attribute__((ext_vector_type(4)));
typedef unsigned v2u __attribute__((ext_vector_type(2)));
typedef float f32x4 __attribute__((ext_vector_type(4)));
typedef float f32x2 __attribute__((ext_vector_type(2)));
typedef float f32x16 __attribute__((ext_vector_type(16)));
typedef short bf16x8 __attribute__((ext_vector_type(8)));
typedef short s16x4 __attribute__((ext_vector_type(4)));
typedef _Float16 f16x8 __attribute__((ext_vector_type(8)));
typedef __bf16 bf16x2_t __attribute__((ext_vector_type(2)));
typedef GAS unsigned gu32;
#define RLX_AGENT __ATOMIC_RELAXED, __HIP_MEMORY_SCOPE_AGENT
#define LDS_WAIT() asm volatile("s_waitcnt lgkmcnt(0)" ::: "memory")
#define VM_WAIT() asm volatile("s_waitcnt vmcnt(0)" ::: "memory")

__device__ __forceinline__ unsigned cvtpk(float lo, float hi) { f32x2 v = {lo, hi}; bf16x2_t b = __builtin_convertvector(v, bf16x2_t); return __builtin_bit_cast(unsigned, b); }
__device__ __forceinline__ float bf_lo(unsigned w) { return __uint_as_float(w << 16); }
__device__ __forceinline__ float bf_hi(unsigned w) { return __uint_as_float(w & 0xffff0000u); }
__device__ __forceinline__ float fexp2(float x) { return __builtin_amdgcn_exp2f(x); }
__device__ __forceinline__ float frcp(float x) { return __builtin_amdgcn_rcpf(x); }
__device__ __forceinline__ float sigmoidf_(float x) { return frcp(1.0f + fexp2(-1.4426950408889634f * x)); }
__device__ __forceinline__ float gelu_tanh(float y) { const float t = y * (1.0f + 0.044715f * y * y) * (-2.302208198f); return y * frcp(1.0f + fexp2(t)); }
__device__ __forceinline__ float wave_sum(float v) {
#pragma unroll
    for (int o = 1; o < 64; o <<= 1) v += __shfl_xor(v, o);
    return v;
}

namespace pg8 {
#define PG8_LAS __attribute__((address_space(3)))
constexpr int BM = 256, BK = 64, HALF = 128, HTB = HALF * BK * 2, STAGE_BYTES = 8 * HTB, NXCD = 8, WGM = 8;
__host__ __device__ __forceinline__ int lds_byte(int r, int c) { const int st = (r >> 4) * 2 + (c >> 5), rr = r & 15, cc = c & 31, ob = rr * 64 + cc * 2; return st * 1024 + (ob ^ (((ob >> 9) & 1) << 5)); }
__host__ __device__ __forceinline__ void stage_rc(int b, int& R, int& C) { const int st = b / 1024, sb = b % 1024, swz = sb ^ (((sb >> 9) & 1) << 5); R = (st >> 1) * 16 + swz / 64; C = (st & 1) * 32 + (swz % 64) / 2; }
__host__ __device__ __forceinline__ int perm32(int rho) { const int n = rho >> 4, i = rho & 15; return 8 * (i >> 2) + 4 * n + (i & 3); }

struct Unit { int pm, pn, aux; };

struct DenseOrder {
    static constexpr bool GATHER = false, KMAP = false;
    __device__ __forceinline__ int nt() const { return 0; }
    __device__ __forceinline__ size_t koff(int t) const { return (size_t)t * 128; }
    __device__ __forceinline__ bool half(const Unit&) const { return false; }
    const char* A; const char* Bt; int lda, ldb; int nM, nN, nwg, G, c;
    __device__ void init(const void* A_, const void* Bt_, int lda_, int ldb_, int M, int N, int G_, int c_) { A = (const char*)A_; Bt = (const char*)Bt_; lda = lda_; ldb = ldb_; nM = M / BM; nN = N / BM; nwg = nM * nN; G = G_; c = c_; }
    __device__ bool next(int i, Unit& u) const {
        const long L = (long)i * G + c; if (L >= nwg) return false;
        int wgid = (int)L; { const int q = nwg / NXCD, r = nwg % NXCD, xcd = wgid % NXCD, off = wgid / NXCD; wgid = (xcd < r ? xcd * (q + 1) : r * (q + 1) + (xcd - r) * q) + off; }
        const int nig = WGM * nN, gid = wgid / nig, fm = gid * WGM, gsz = (nM - fm) < WGM ? (nM - fm) : WGM;
        u.pm = fm + ((wgid % nig) % gsz); u.pn = (wgid % nig) / gsz; u.aux = 0; return true;
    }
    __device__ __forceinline__ const char* a_ptr(const Unit& u) const { return A + (size_t)u.pm * BM * lda * 2; }
    __device__ __forceinline__ const char* b_ptr(const Unit& u) const { return Bt + (size_t)u.pn * BM * ldb * 2; }
    __device__ __forceinline__ void gather(const Unit&, const int*, const int*, unsigned*, unsigned*) const {}
};
struct OneUnit {
    static constexpr bool GATHER = false, KMAP = false;
    __device__ __forceinline__ int nt() const { return 0; }
    __device__ __forceinline__ size_t koff(int t) const { return (size_t)t * 128; }
    __device__ __forceinline__ bool half(const Unit&) const { return false; }
    const char* A; const char* Bt; Unit u0;
    __device__ bool next(int i, Unit& u) const { if (i > 0) return false; u = u0; return true; }
    __device__ __forceinline__ const char* a_ptr(const Unit&) const { return A; }
    __device__ __forceinline__ const char* b_ptr(const Unit&) const { return Bt; }
    __device__ __forceinline__ void gather(const Unit&, const int*, const int*, unsigned*, unsigned*) const {}
};
struct SsmUnit {
    static constexpr bool GATHER = false, KMAP = true;
    const char* A; const char* Bt; Unit u0; int first, cnt, st;
    __device__ bool next(int i, Unit& u) const { if (i > 0) return false; u = u0; return true; }
    __device__ __forceinline__ const char* a_ptr(const Unit&) const { return A; }
    __device__ __forceinline__ const char* b_ptr(const Unit&) const { return Bt; }
    __device__ __forceinline__ void gather(const Unit&, const int*, const int*, unsigned*, unsigned*) const {}
    __device__ __forceinline__ int nt() const { return cnt + 2; }
    __device__ __forceinline__ bool half(const Unit&) const { return false; }
    __device__ __forceinline__ size_t koff(int t) const { return (size_t)((t < cnt) ? first + t : st + (t - cnt)) * 128; }
};
template <bool GATHER_> struct MoeOrder {
    static constexpr bool GATHER = GATHER_, KMAP = false;
    __device__ __forceinline__ int nt() const { return 0; }
    __device__ __forceinline__ size_t koff(int t) const { return (size_t)t * 128; }
    const char* A; const char* W; const int* eslot; const PG8_LAS int* tile_e; const PG8_LAS int* ecnt; int ntiles, G, c, lda, ldb, lt_lim;
    __device__ bool next(int i, Unit& u) const { const int x = c & 7, j = c >> 3, per = G >> 5;
        const int chunk = (ntiles + 7) >> 3; const int lt = i * per + (j >> 2); const int rt = x * chunk + lt;
        if ((j >> 2) >= per || lt >= chunk || lt >= lt_lim || rt >= ntiles) return false; u.pm = rt; u.pn = j & 3; u.aux = tile_e[rt]; return true; }
    __device__ __forceinline__ bool half(const Unit& u) const { return ecnt[u.aux & 255] - (u.aux >> 8) * BM <= HALF; }
    __device__ __forceinline__ const char* a_ptr(const Unit& u) const { return GATHER_ ? A : A + (size_t)u.pm * BM * lda * 2; }
    __device__ __forceinline__ const char* b_ptr(const Unit& u) const { return W + ((size_t)(u.aux & 255) * 1024 + (size_t)u.pn * BM) * ldb * 2; }
    __device__ __forceinline__ void gather(const Unit& u, const int* RA, const int* CA, unsigned* v0, unsigned* v1) const {
        const int e = u.aux & 255, r0 = (u.aux >> 8) * BM, cnt = ecnt[e];
#pragma unroll
        for (int i = 0; i < 2; ++i) { const int i0 = r0 + RA[i], i1 = i0 + HALF;
            const int t0 = (i0 < cnt) ? (eslot[e * 65536 + i0] >> 1) : 0, t1 = (i1 < cnt) ? (eslot[e * 65536 + i1] >> 1) : 0;
            v0[i] = (unsigned)(t0 * lda + CA[i]) * 2u; v1[i] = (unsigned)(t1 * lda + CA[i]) * 2u; }
    }
};

template <bool GATHER_> struct MoeUnits {
    static constexpr bool GATHER = GATHER_, KMAP = false;
    __device__ __forceinline__ int nt() const { return 0; }
    __device__ __forceinline__ size_t koff(int t) const { return (size_t)t * 128; }
    const char* A; const char* W; const int* eslot; const PG8_LAS int* tile_e; const PG8_LAS int* ecnt; int tile0, u_lo, u_hi, lda, ldb;
    __device__ bool next(int i, Unit& u) const { const int q = u_lo + i; if (q >= u_hi) return false; u.pm = tile0 + (q >> 2); u.pn = q & 3; u.aux = tile_e[u.pm]; return true; }
    __device__ __forceinline__ bool half(const Unit& u) const { return ecnt[u.aux & 255] - (u.aux >> 8) * BM <= HALF; }
    __device__ __forceinline__ const char* a_ptr(const Unit& u) const { return GATHER_ ? A : A + (size_t)u.pm * BM * lda * 2; }
    __device__ __forceinline__ const char* b_ptr(const Unit& u) const { return W + ((size_t)(u.aux & 255) * 1024 + (size_t)u.pn * BM) * ldb * 2; }
    __device__ __forceinline__ void gather(const Unit& u, const int* RA, const int* CA, unsigned* v0, unsigned* v1) const {
        const int e = u.aux & 255, r0 = (u.aux >> 8) * BM, cnt = ecnt[e];
#pragma unroll
        for (int i = 0; i < 2; ++i) { const int i0 = r0 + RA[i], i1 = i0 + HALF;
            const int t0 = (i0 < cnt) ? (eslot[e * 65536 + i0] >> 1) : 0, t1 = (i1 < cnt) ? (eslot[e * 65536 + i1] >> 1) : 0;
            v0[i] = (unsigned)(t0 * lda + CA[i]) * 2u; v1[i] = (unsigned)(t1 * lda + CA[i]) * 2u; }
    }
};

struct MoeRounds {
    static constexpr bool GATHER = false, KMAP = false;
    __device__ __forceinline__ int nt() const { return 0; }
    __device__ __forceinline__ size_t koff(int t) const { return (size_t)t * 128; }
    const char* A; const char* W; const PG8_LAS int* tile_e; const PG8_LAS int* ecnt; int tile0, j, E, sA, sB, r_lo, r_hi, lda, ldb;
    __device__ __forceinline__ int lt_of(int r) const { const int s = r < E - 1 ? 0 : (r == E - 1 ? sA : sB); const int base = r < E ? 8 * r : 8 * (E - 1) + ((32 - sA) >> 2); return base + ((j - s) >> 2); }
    __device__ bool next(int i, Unit& u) const { const int r = r_lo + i; if (r >= r_hi) return false; const int s = r < E - 1 ? 0 : (r == E - 1 ? sA : sB);
        u.pm = tile0 + lt_of(r); u.pn = (j - s) & 3; u.aux = tile_e[u.pm]; return true; }
    __device__ __forceinline__ bool half(const Unit& u) const { return ecnt[u.aux & 255] - (u.aux >> 8) * BM <= HALF; }
    __device__ __forceinline__ const char* a_ptr(const Unit& u) const { return A + (size_t)u.pm * BM * lda * 2; }
    __device__ __forceinline__ const char* b_ptr(const Unit& u) const { return W + ((size_t)(u.aux & 255) * 1024 + (size_t)u.pn * BM) * ldb * 2; }
    __device__ __forceinline__ void gather(const Unit&, const int*, const int*, unsigned*, unsigned*) const {}
};

template <class Epi, class Sched, bool ALIGN_EPI>
__device__ __forceinline__ void gemm_phase(PG8_LAS unsigned char* lds, const int K, const int lda, const int ldb, const Sched& S, const Epi& E) {
    int tid = threadIdx.x; asm volatile("" : "+v"(tid));
    const int wid = __builtin_amdgcn_readfirstlane(tid >> 6), lane = tid & 63, wr = wid >> 2, wc = wid & 3, fr = lane & 15, fq = lane >> 4;
    int nt = K / BK; if constexpr (Sched::KMAP) nt = S.nt();
#define PG8_KOFF(t) (Sched::KMAP ? S.koff(t) : (size_t)(t) * kstep)
    unsigned vA0[2], vA1[2], nvA0[2], nvA1[2], voffB[2]; int RA[2], CA[2];
#pragma unroll
    for (int i = 0; i < 2; ++i) { int R, C; stage_rc(tid * 16 + i * 8192, R, C); const int Rb = Epi::PERM ? ((R & ~31) + perm32(R & 31)) : R;
        RA[i] = R; CA[i] = C; vA0[i] = (unsigned)(R * lda + C) * 2u; vA1[i] = (unsigned)((R + HALF) * lda + C) * 2u; voffB[i] = (unsigned)(Rb * ldb + C) * 2u; nvA0[i] = vA0[i]; nvA1[i] = vA1[i]; }
    const size_t kstep = (size_t)(BK * 2);
    const size_t hstepB = (size_t)HALF * ldb * 2;
    const unsigned ldsw = (unsigned)wid * 1024u;
    const int aoff = lds_byte(wr * 64 + fr, fq * 8), boff = lds_byte(wc * 32 + fr, fq * 8);
#define PG8_SA(b, h) (((b) * 2 + (h)) * HTB)
#define PG8_SB(b, h) ((4 + (b) * 2 + (h)) * HTB)
#define PG8_STAGE2(bufoff, gbase, o0, o1) do { \
        __builtin_amdgcn_global_load_lds((const unsigned*)((const char*)(gbase) + (o0)), (PG8_LAS unsigned*)(lds + (bufoff) + ldsw), 16, 0, 0); \
        __builtin_amdgcn_global_load_lds((const unsigned*)((const char*)(gbase) + (o1)), (PG8_LAS unsigned*)(lds + (bufoff) + ldsw + 8192), 16, 0, 0); } while (0)
#define PG8_STAGEB(bufoff, gbase) PG8_STAGE2(bufoff, gbase, voffB[0], voffB[1])
#define PG8_LDA(dst, b, h) do { _Pragma("unroll") for (int m = 0; m < 4; ++m) _Pragma("unroll") for (int k = 0; k < 2; ++k) dst[m][k] = *(const PG8_LAS bf16x8*)(lds + PG8_SA(b, h) + aoff + m * 2048 + k * 1024); } while (0)
#define PG8_LDB(dst, b, h) do { _Pragma("unroll") for (int n = 0; n < 2; ++n) _Pragma("unroll") for (int k = 0; k < 2; ++k) dst[n][k] = *(const PG8_LAS bf16x8*)(lds + PG8_SB(b, h) + boff + n * 2048 + k * 1024); } while (0)
#define PG8_MMA(ai, bj, At, Bt) do { __builtin_amdgcn_s_setprio(1); _Pragma("unroll") for (int m = 0; m < 4; ++m) _Pragma("unroll") for (int n = 0; n < 2; ++n) _Pragma("unroll") for (int k = 0; k < 2; ++k) \
        acc[ai][bj][m][n] = __builtin_amdgcn_mfma_f32_16x16x32_bf16(Bt[n][k], At[m][k], acc[ai][bj][m][n], 0, 0, 0); __builtin_amdgcn_s_setprio(0); } while (0)
#define PG8_WAIT_V(n) asm volatile("s_waitcnt vmcnt(" #n ")" ::: "memory")
#define PG8_WAIT_L(n) asm volatile("s_waitcnt lgkmcnt(" #n ")" ::: "memory")
#define PG8_BAR __builtin_amdgcn_s_barrier()
#define PG8_SCHED __builtin_amdgcn_sched_barrier(0)
    Unit cur, nxt; int ui = 0;
    if (!S.next(0, cur)) return;
    if constexpr (Sched::GATHER) S.gather(cur, RA, CA, vA0, vA1);
    bool halfu = S.half(cur);
    f32x4 acc[2][2][4][2];
#pragma unroll
    for (int a = 0; a < 2; ++a)
#pragma unroll
        for (int b = 0; b < 2; ++b)
#pragma unroll
            for (int m = 0; m < 4; ++m)
#pragma unroll
                for (int n = 0; n < 2; ++n) acc[a][b][m][n] = (f32x4){0.f, 0.f, 0.f, 0.f};
    bf16x8 At[4][2], B0[2][2], B1[2][2];
    const char* cA = S.a_ptr(cur); const char* cB = S.b_ptr(cur);
    { const size_t k0_ = PG8_KOFF(0), k1_ = PG8_KOFF(1);
    PG8_STAGEB(PG8_SB(0, 0), cB + k0_); PG8_STAGEB(PG8_SB(0, 1), cB + hstepB + k0_); PG8_STAGE2(PG8_SA(0, 0), cA + k0_, vA0[0], vA0[1]); PG8_STAGE2(PG8_SA(0, 1), cA + k0_, vA1[0], vA1[1]);
    if (wr == 1) PG8_BAR;
    PG8_WAIT_V(2); PG8_BAR;
    PG8_STAGEB(PG8_SB(1, 0), cB + k1_); PG8_STAGE2(PG8_SA(1, 0), cA + k1_, vA0[0], vA0[1]); PG8_STAGEB(PG8_SB(1, 1), cB + hstepB + k1_); }
    PG8_WAIT_V(6); PG8_BAR;
    for (;;) {
        const bool has_next = S.next(ui + 1, nxt);
        const char* nA = has_next ? S.a_ptr(nxt) : cA; const char* nB = has_next ? S.b_ptr(nxt) : cB;
        if constexpr (Sched::GATHER) { if (has_next) S.gather(nxt, RA, CA, nvA0, nvA1); else { nvA0[0] = vA0[0]; nvA0[1] = vA0[1]; nvA1[0] = vA1[0]; nvA1[1] = vA1[1]; } }
        for (int t = 0; t < nt; t += 2) {
            const bool last = (t == nt - 2);
            const size_t k1_ = PG8_KOFF(t + 1), k2_ = last ? PG8_KOFF(0) : PG8_KOFF(t + 2), k3_ = last ? PG8_KOFF(1) : PG8_KOFF(t + 3);
            const char* a1 = cA + k1_;
            const char* a2 = (last ? nA : cA) + k2_; const char* b2 = (last ? nB : cB) + k2_;
            const char* a3 = (last ? nA : cA) + k3_; const char* b3 = (last ? nB : cB) + k3_;
            unsigned s00 = vA0[0], s01 = vA0[1], s10 = vA1[0], s11 = vA1[1];
            if constexpr (Sched::GATHER) { if (last) { s00 = nvA0[0]; s01 = nvA0[1]; s10 = nvA1[0]; s11 = nvA1[1]; } }
            PG8_LDB(B0, 0, 0); PG8_LDB(B1, 0, 1); PG8_SCHED; PG8_LDA(At, 0, 0); PG8_STAGE2(PG8_SA(1, 1), a1, vA1[0], vA1[1]);
            PG8_WAIT_V(8); PG8_WAIT_L(0); PG8_BAR; PG8_MMA(0, 0, At, B0); PG8_MMA(0, 1, At, B1); PG8_BAR; PG8_SCHED;
            PG8_LDA(At, 0, 1); PG8_STAGEB(PG8_SB(0, 0), b2); PG8_STAGEB(PG8_SB(0, 1), b2 + hstepB); PG8_STAGE2(PG8_SA(0, 0), a2, s00, s01);
            PG8_WAIT_V(8); PG8_WAIT_L(0); PG8_BAR; if (!halfu) { PG8_MMA(1, 0, At, B0); PG8_MMA(1, 1, At, B1); } PG8_BAR; PG8_SCHED;
            PG8_LDB(B0, 1, 0); PG8_LDB(B1, 1, 1); PG8_SCHED; PG8_LDA(At, 1, 0); PG8_STAGE2(PG8_SA(0, 1), a2, s10, s11);
            PG8_WAIT_V(8); PG8_WAIT_L(0); PG8_BAR; PG8_MMA(0, 0, At, B0); PG8_MMA(0, 1, At, B1); PG8_BAR; PG8_SCHED;
            PG8_LDA(At, 1, 1); PG8_STAGEB(PG8_SB(1, 0), b3); PG8_STAGEB(PG8_SB(1, 1), b3 + hstepB); PG8_STAGE2(PG8_SA(1, 0), a3, s00, s01);
            PG8_WAIT_V(8); PG8_WAIT_L(0); PG8_BAR; if (!halfu) { PG8_MMA(1, 0, At, B0); PG8_MMA(1, 1, At, B1); } PG8_BAR; PG8_SCHED;
        }
        if constexpr (ALIGN_EPI) { if (wr == 0) PG8_BAR; }
        E(acc, cur, wr, wc, fr, fq);
        if (!has_next) break;
#pragma unroll
        for (int a = 0; a < 2; ++a)
#pragma unroll
            for (int b = 0; b < 2; ++b)
#pragma unroll
                for (int m = 0; m < 4; ++m)
#pragma unroll
                    for (int n = 0; n < 2; ++n) acc[a][b][m][n] = (f32x4){0.f, 0.f, 0.f, 0.f};
        cur = nxt; cA = nA; cB = nB; ++ui; halfu = S.half(cur);
        if constexpr (Sched::GATHER) { vA0[0] = nvA0[0]; vA0[1] = nvA0[1]; vA1[0] = nvA1[0]; vA1[1] = nvA1[1]; }
        if constexpr (ALIGN_EPI) { if (wr == 1) PG8_BAR; }
    }
    PG8_WAIT_V(0);
    if constexpr (!ALIGN_EPI) { if (wr == 0) PG8_BAR; }
    PG8_BAR;
#undef PG8_KOFF
#undef PG8_SA
#undef PG8_SB
#undef PG8_STAGE2
#undef PG8_STAGEB
#undef PG8_LDA
#undef PG8_LDB
#undef PG8_MMA
#undef PG8_WAIT_V
#undef PG8_WAIT_L
#undef PG8_BAR
#undef PG8_SCHED
}

typedef f32x4 AccT[2][2][4][2];

struct EpiInProj {
    static constexpr bool PERM = true;
    bf16* q; bf16* kt; bf16* vt; bf16* uperm;
    __device__ __forceinline__ void operator()(const AccT& acc, const Unit& u, int wr, int wc, int fr, int fq) const {
        const int row0 = u.pm * BM + wr * 64 + fr; const int col0 = u.pn * BM + wc * 32 + 8 * fq;
        const float sc = (u.pn < 2) ? QSCALE : 1.0f;
#pragma unroll
        for (int ai = 0; ai < 2; ++ai)
#pragma unroll
            for (int m = 0; m < 4; ++m) { const int row = row0 + ai * HALF + m * 16; const int b = row >> 12, sq = row & 4095, tl = sq >> 6, s = sq & 63;
#pragma unroll
                for (int bj = 0; bj < 2; ++bj) { const f32x4 v0 = acc[ai][bj][m][0] * sc, v1 = acc[ai][bj][m][1] * sc; const int col = col0 + bj * HALF;
                    v4u w; w.x = cvtpk(v0[0], v0[1]); w.y = cvtpk(v0[2], v0[3]); w.z = cvtpk(v1[0], v1[1]); w.w = cvtpk(v1[2], v1[3]);
                    if (u.pn < 2) *(v4u*)(q + (size_t)row * 512 + col) = w;
                    else if (u.pn < 4) { const int ck = col - 512, h = ck >> 7, sub = (ck >> 6) & 1, ch = (ck & 63) >> 3;
                        *(v4u*)(kt + ((size_t)((((b * 4 + h) * 2 + sub) * 64 + tl) * 8 + ch) * 512 + s * 8)) = w; }
                    else if (u.pn < 6) { const int cv = col - 1024, h = cv >> 7, d0 = (cv & 127) >> 5, c16 = (cv & 31) >> 3;
                        *(v4u*)(vt + ((size_t)(((b * 4 + h) * 64 + tl) * 4 + d0) * 2048 + s * 32 + c16 * 8)) = w; }
                    else { const int cu = col - 1536, g = cu >> 4, ci0 = cu & 15;
                        *(v4u*)(uperm + ((size_t)(g * 512 + b * 64 + tl) * UP_PITCH + s * 16 + ci0)) = w; } } }
    }
};
struct EpiState {
    static constexpr bool PERM = false;
    float* sstate;
    __device__ __forceinline__ void operator()(const AccT& acc, const Unit& u, int wr, int wc, int fr, int fq) const {
        const int row0 = u.pm * BM + wr * 64 + fr; const int col0 = wc * 32 + 4 * fq;
#pragma unroll
        for (int ai = 0; ai < 2; ++ai)
#pragma unroll
            for (int m = 0; m < 4; ++m) { const int row = row0 + ai * HALF + m * 16;
#pragma unroll
                for (int bj = 0; bj < 2; ++bj)
#pragma unroll
                    for (int n = 0; n < 2; ++n) *(f32x4*)(sstate + ((size_t)(u.aux * 512 + row) * 256 + bj * HALF + col0 + n * 16)) = acc[ai][bj][m][n]; }
    }
};
struct EpiSsmOut {
    static constexpr bool PERM = true;
    const bf16* uperm; const float* dvec; bf16* z;
    __device__ __forceinline__ void operator()(const AccT& acc, const Unit& u, int wr, int wc, int fr, int fq) const {
        const int g = u.aux; const int row0 = u.pm * BM + wr * 64 + fr; const int col0 = u.pn * BM + wc * 32 + 8 * fq;
        const int co0 = col0 & 15;
        const f32x4 d0 = *(const f32x4*)(dvec + g * 16 + co0), d1 = *(const f32x4*)(dvec + g * 16 + co0 + 4);
#pragma unroll
        for (int ai = 0; ai < 2; ++ai)
#pragma unroll
            for (int m = 0; m < 4; ++m) { const int row = row0 + ai * HALF + m * 16; const int b = row >> 6, ch = row & 63;
#pragma unroll
                for (int bj = 0; bj < 2; ++bj) { const int col = col0 + bj * HALF; const int t = col >> 4;
                    const v4u uw = *(const v4u*)(uperm + ((size_t)(g * 512 + row) * UP_PITCH + col));
                    const f32x4 a0 = acc[ai][bj][m][0], a1 = acc[ai][bj][m][1];
                    float y[8];
                    y[0] = a0[0] + d0[0] * bf_lo(uw.x); y[1] = a0[1] + d0[1] * bf_hi(uw.x); y[2] = a0[2] + d0[2] * bf_lo(uw.y); y[3] = a0[3] + d0[3] * bf_hi(uw.y);
                    y[4] = a1[0] + d1[0] * bf_lo(uw.z); y[5] = a1[1] + d1[1] * bf_hi(uw.z); y[6] = a1[2] + d1[2] * bf_lo(uw.w); y[7] = a1[3] + d1[3] * bf_hi(uw.w);
#pragma unroll
                    for (int j = 0; j < 8; ++j) y[j] = gelu_tanh(y[j]);
                    v4u w; w.x = cvtpk(y[0], y[1]); w.y = cvtpk(y[2], y[3]); w.z = cvtpk(y[4], y[5]); w.w = cvtpk(y[6], y[7]);
                    *(v4u*)(z + ((size_t)(b * SEQ + ch * 64 + t) * SSMW + g * 16 + co0)) = w; } }
    }
};
struct EpiGlu {
    static constexpr bool PERM = true;
    const bf16* z; const float* bias; bf16* cat;
    __device__ __forceinline__ void operator()(const AccT& acc, const Unit& u, int wr, int wc, int fr, int fq) const {
        const int row0 = u.pm * BM + wr * 64 + fr; const int col0 = u.pn * BM + wc * 32 + 8 * fq;
#pragma unroll
        for (int bj = 0; bj < 2; ++bj) { const int col = col0 + bj * HALF; const f32x4 b0 = *(const f32x4*)(bias + col), b1 = *(const f32x4*)(bias + col + 4);
#pragma unroll
            for (int ai = 0; ai < 2; ++ai)
#pragma unroll
                for (int m = 0; m < 4; ++m) { const int row = row0 + ai * HALF + m * 16;
                    const v4u zw = *(const v4u*)(z + (size_t)row * SSMW + col);
                    const f32x4 a0 = acc[ai][bj][m][0] + b0, a1 = acc[ai][bj][m][1] + b1;
                    float s[8];
                    s[0] = bf_lo(zw.x) * sigmoidf_(a0[0]); s[1] = bf_hi(zw.x) * sigmoidf_(a0[1]); s[2] = bf_lo(zw.y) * sigmoidf_(a0[2]); s[3] = bf_hi(zw.y) * sigmoidf_(a0[3]);
                    s[4] = bf_lo(zw.z) * sigmoidf_(a1[0]); s[5] = bf_hi(zw.z) * sigmoidf_(a1[1]); s[6] = bf_lo(zw.w) * sigmoidf_(a1[2]); s[7] = bf_hi(zw.w) * sigmoidf_(a1[3]);
                    v4u w; w.x = cvtpk(s[0], s[1]); w.y = cvtpk(s[2], s[3]); w.z = cvtpk(s[4], s[5]); w.w = cvtpk(s[6], s[7]);
                    *(v4u*)(cat + (size_t)row * DM + 512 + col) = w; } }
    }
};
struct EpiOutProj {
    static constexpr bool PERM = true;
    const bf16* xb; bf16* pre; f32x2* stats;
    __device__ __forceinline__ void operator()(const AccT& acc, const Unit& u, int wr, int wc, int fr, int fq) const {
        const int row0 = u.pm * BM + wr * 64 + fr; const int col0 = u.pn * BM + wc * 32 + 8 * fq;
#pragma unroll
        for (int ai = 0; ai < 2; ++ai)
#pragma unroll
            for (int m = 0; m < 4; ++m) { const int row = row0 + ai * HALF + m * 16; const size_t off = (size_t)row * DM + col0;
                f32x4 v[2][2]; float s = 0.f;
#pragma unroll
                for (int bj = 0; bj < 2; ++bj) { const v4u xw = *(const v4u*)(xb + off + bj * HALF);
                    v[bj][0] = (f32x4){bf_lo(xw.x), bf_hi(xw.x), bf_lo(xw.y), bf_hi(xw.y)} * ALPHA + acc[ai][bj][m][0];
                    v[bj][1] = (f32x4){bf_lo(xw.z), bf_hi(xw.z), bf_lo(xw.w), bf_hi(xw.w)} * ALPHA + acc[ai][bj][m][1];
                    v4u w; w.x = cvtpk(v[bj][0][0], v[bj][0][1]); w.y = cvtpk(v[bj][0][2], v[bj][0][3]); w.z = cvtpk(v[bj][1][0], v[bj][1][1]); w.w = cvtpk(v[bj][1][2], v[bj][1][3]);
                    *(v4u*)(pre + off + bj * HALF) = w;
#pragma unroll
                    for (int n = 0; n < 2; ++n) s += (v[bj][n][0] + v[bj][n][1]) + (v[bj][n][2] + v[bj][n][3]); }
                s += __shfl_xor(s, 16); s += __shfl_xor(s, 32);
                const float mw = s * (1.0f / 64.0f); float q = 0.f;
#pragma unroll
                for (int bj = 0; bj < 2; ++bj)
#pragma unroll
                    for (int n = 0; n < 2; ++n) { const f32x4 d = v[bj][n] - mw; q += (d[0] * d[0] + d[1] * d[1]) + (d[2] * d[2] + d[3] * d[3]); }
                q += __shfl_xor(q, 16); q += __shfl_xor(q, 32);
                if (fq == 0) stats[(size_t)row * 16 + u.pn * 4 + wc] = (f32x2){mw, q}; }
    }
};
template <bool WT  > struct EpiMoe1T {
    static constexpr bool PERM = true;
    bf16* hid;
    __device__ __forceinline__ void operator()(const AccT& acc, const Unit& u, int wr, int wc, int fr, int fq) const {
        const int row0 = u.pm * BM + wr * 64 + fr; const int col0 = u.pn * BM + wc * 32 + 8 * fq;
#pragma unroll
        for (int ai = 0; ai < 2; ++ai)
#pragma unroll
            for (int m = 0; m < 4; ++m) { const int row = row0 + ai * HALF + m * 16;
#pragma unroll
                for (int bj = 0; bj < 2; ++bj) { const f32x4 a0 = acc[ai][bj][m][0], a1 = acc[ai][bj][m][1]; const int col = (col0 + bj * HALF) >> 1;
                    const float h0 = a0[0] * sigmoidf_(a0[0]) * a0[1], h1 = a0[2] * sigmoidf_(a0[2]) * a0[3], h2 = a1[0] * sigmoidf_(a1[0]) * a1[1], h3 = a1[2] * sigmoidf_(a1[2]) * a1[3];
                    v2u w; w.x = cvtpk(h0, h1); w.y = cvtpk(h2, h3);
                    if constexpr (WT) __hip_atomic_store((GAS unsigned long long*)(hid + (size_t)row * DEXP + col), ((unsigned long long)w.y << 32) | w.x, __ATOMIC_RELAXED, __HIP_MEMORY_SCOPE_AGENT);
                    else *(v2u*)(hid + (size_t)row * DEXP + col) = w; } }
    }
};
typedef EpiMoe1T<false> EpiMoe1;
struct EpiMoe2 {
    static constexpr bool PERM = true;
    const int* eslot; const float* ew; const PG8_LAS int* ecnt; bf16* y2;
    __device__ __forceinline__ void operator()(const AccT& acc, const Unit& u, int wr, int wc, int fr, int fq) const {
        const int e = u.aux & 255, cnt = ecnt[e]; const int row0 = (u.aux >> 8) * BM + wr * 64 + fr; const int col0 = u.pn * BM + wc * 32 + 8 * fq;
#pragma unroll
        for (int ai = 0; ai < 2; ++ai)
#pragma unroll
            for (int m = 0; m < 4; ++m) { const int idx = row0 + ai * HALF + m * 16; const bool ok = idx < cnt;
                const int slot = ok ? eslot[e * 65536 + idx] : 65536 + (idx & 255); const float wt = ok ? ew[e * 65536 + idx] : 0.f;
#pragma unroll
                for (int bj = 0; bj < 2; ++bj) { const f32x4 v0 = acc[ai][bj][m][0] * wt, v1 = acc[ai][bj][m][1] * wt;
                    v4u w; w.x = cvtpk(v0[0], v0[1]); w.y = cvtpk(v0[2], v0[3]); w.z = cvtpk(v1[0], v1[1]); w.w = cvtpk(v1[2], v1[3]);
                    *(v4u*)(y2 + (size_t)slot * DM + col0 + bj * HALF) = w; } }
    }
};
}

namespace att {
__device__ __forceinline__ int crow(int r, int hi) { return (r & 3) + 8 * (r >> 2) + 4 * hi; }
#define SBAR() __builtin_amdgcn_sched_barrier(0)
constexpr int STAGE = 32768, K_OFF = 0, V_OFF = 16384, WS_OFF = 131072 + 4096;
constexpr float THR = 8.0f;
__device__ __forceinline__ void glds16(const void* gsrc, unsigned lds_dst) { unsigned keep;
    asm volatile("s_mov_b32 %0, m0\n\ts_mov_b32 m0, %2\n\ts_nop 0\n\tglobal_load_lds_dwordx4 %1, off\n\ts_mov_b32 m0, %0" : "=&s"(keep) : "v"(gsrc), "s"(lds_dst) : "memory"); }
#define ATT_WAIT_BAR(N) asm volatile("s_waitcnt vmcnt(" #N ") lgkmcnt(0)\n\ts_barrier" ::: "memory")
#define ATT_BAR_L() asm volatile("s_waitcnt lgkmcnt(0)\n\ts_barrier" ::: "memory")

__device__ __forceinline__ float max3f(float a, float b, float c) { return __builtin_fmaxf(__builtin_fmaxf(a, b), c); }
__device__ __forceinline__ float max2f(float a, float b) { return __builtin_fmaxf(a, b); }
__device__ __forceinline__ float rowmax32(const f32x16& p0, const f32x16& p1) {
    float a = max3f(p0[0], p0[1], p1[0]), b = max3f(p0[2], p0[3], p1[1]); a = max3f(a, p1[2], p1[3]);
#pragma unroll
    for (int r = 4; r < 16; r += 4) { a = max3f(a, p0[r], p0[r + 1]); b = max3f(b, p0[r + 2], p0[r + 3]); a = max3f(a, p1[r], p1[r + 1]); b = max3f(b, p1[r + 2], p1[r + 3]); }
    const float m = max2f(a, b);
    auto rr = __builtin_amdgcn_permlane32_swap(__float_as_uint(m), __float_as_uint(m), false, false);
    return max2f(__uint_as_float(rr[0]), __uint_as_float(rr[1]));
}

__device__ __forceinline__ void attn_unit(int b, int h, int qb, const bf16* PROJ, bf16* CAT, char* shm, float lam, const float* subln_g) {
    const int tid = threadIdx.x, lane = tid & 63, r32 = lane & 31, hi = lane >> 5; const int wid = __builtin_amdgcn_readfirstlane(tid >> 6);
    const int sub = wid >> 2, wq = wid & 3;
    const long rowbase = (long)b * SEQ; const int q0 = qb * 128;
    const bf16* Qw = PROJ + (rowbase + q0 + wq * 32) * 512 + h * 128 + sub * 64;
    const bf16* Kh = PROJ + (size_t)TOK * 512 + (size_t)((b * 4 + h) * 2) * 64 * 4096;
    const bf16* Vh = PROJ + (size_t)TOK * 1024 + (size_t)(b * 4 + h) * 64 * 8192;
    const unsigned lds0 = (unsigned)(uintptr_t)shm;
    float* wsf = (float*)(shm + WS_OFF) + wid * 64;
    const bf16* ksrc0 = Kh + wid * 512 + lane * 8;
    const bf16* ksrc1 = ksrc0 + 64 * 4096;
    const unsigned kdst0 = lds0 + K_OFF + wid * 1024, kdst1 = lds0 + K_OFF + 8192 + wid * 1024;
    const bf16* vsrc0 = Vh + wid * 512 + lane * 8;
    const bf16* vsrc1 = vsrc0 + 4096;
    const unsigned vdst0 = lds0 + V_OFF + wid * 1024, vdst1 = vdst0 + 8192;
#define ATT_DMA(t, so) do { const long rk_ = (long)(t) * 4096, rv_ = (long)(t) * 8192; const unsigned so_ = (unsigned)(so); \
        glds16(ksrc0 + rk_, (unsigned)__builtin_amdgcn_readfirstlane(kdst0 + so_)); glds16(ksrc1 + rk_, (unsigned)__builtin_amdgcn_readfirstlane(kdst1 + so_)); \
        glds16(vsrc0 + rv_, (unsigned)__builtin_amdgcn_readfirstlane(vdst0 + so_)); glds16(vsrc1 + rv_, (unsigned)__builtin_amdgcn_readfirstlane(vdst1 + so_)); } while (0)
    const int NT = 2 * qb + 2; const int my_last = 2 * qb + (wq >> 1);
    ATT_DMA(0, 0); ATT_DMA(1, STAGE); if (NT > 2) ATT_DMA(2, 2 * STAGE);
    bf16x8 qr[4];
#pragma unroll
    for (int d0 = 0; d0 < 4; ++d0) qr[d0] = *reinterpret_cast<const bf16x8*>(&Qw[(long)r32 * 512 + d0 * 16 + hi * 8]);
    float mrun = 0.f, l_reg = 0.f;
    f32x16 o[4];
#pragma unroll
    for (int d = 0; d < 4; ++d) o[d] = f32x16{};
    const int vb0 = (int)(lds0 + V_OFF) + ((lane >> 4) & 1) * 32 + (lane & 3) * 8 + (4 * hi + ((lane & 15) >> 2)) * 64;
    const char* kbase = shm + K_OFF + sub * 8192 + hi * 1024 + r32 * 16;
    const int kb32 = (int)(lds0 + K_OFF) + sub * 8192 + hi * 1024 + r32 * 16;
    if (NT > 2) ATT_WAIT_BAR(4); else ATT_WAIT_BAR(0);
    asm volatile("" :: "v"(qr[0]), "v"(qr[1]), "v"(qr[2]), "v"(qr[3]));
#define ATT_QK(P0, P1, soff) do { const char* kb_ = kbase + (soff); f32x16 negm; _Pragma("unroll") for (int r = 0; r < 16; ++r) negm[r] = -mrun;     \
        _Pragma("unroll") for (int d0 = 0; d0 < 4; ++d0) { \
            const bf16x8 b0_ = *reinterpret_cast<const bf16x8*>(kb_ + d0 * 2048); const bf16x8 b1_ = *reinterpret_cast<const bf16x8*>(kb_ + d0 * 2048 + 512); \
            if (d0 == 0) { P0 = __builtin_amdgcn_mfma_f32_32x32x16_bf16(b0_, qr[0], negm, 0, 0, 0); P1 = __builtin_amdgcn_mfma_f32_32x32x16_bf16(b1_, qr[0], negm, 0, 0, 0); } \
            else { P0 = __builtin_amdgcn_mfma_f32_32x32x16_bf16(b0_, qr[d0], P0, 0, 0, 0); P1 = __builtin_amdgcn_mfma_f32_32x32x16_bf16(b1_, qr[d0], P1, 0, 0, 0); } } } while (0)
    f32x16 pS0, pS1;
    ATT_QK(pS0, pS1, 0);
    if (sub == 1) ATT_BAR_L();
    int cur = 0;
#define ATT_RDV(L, H, d0) do { _Pragma("unroll") for (int ks = 0; ks < 4; ++ks) { \
                    asm volatile("ds_read_b64_tr_b16 %0,%1 offset:%c2" : "=&v"(L[ks]) : "v"(vb), "i"((d0) * 4096 + ks * 1024) : "memory"); \
                    asm volatile("ds_read_b64_tr_b16 %0,%1 offset:%c2" : "=&v"(H[ks]) : "v"(vb), "i"((d0) * 4096 + ks * 1024 + 512) : "memory"); } } while (0)
#define ATT_PK(L, H, k) (bf16x8){L[k][0], L[k][1], L[k][2], L[k][3], H[k][0], H[k][1], H[k][2], H[k][3]}
#define ATT_PV(L, H, d0) do { \
                    o[d0] = __builtin_amdgcn_mfma_f32_32x32x16_bf16(__builtin_bit_cast(bf16x8, pw[0]), ATT_PK(L, H, 0), o[d0], 0, 0, 0); \
                    o[d0] = __builtin_amdgcn_mfma_f32_32x32x16_bf16(__builtin_bit_cast(bf16x8, pw[1]), ATT_PK(L, H, 1), o[d0], 0, 0, 0); \
                    o[d0] = __builtin_amdgcn_mfma_f32_32x32x16_bf16(__builtin_bit_cast(bf16x8, pw[2]), ATT_PK(L, H, 2), o[d0], 0, 0, 0); \
                    o[d0] = __builtin_amdgcn_mfma_f32_32x32x16_bf16(__builtin_bit_cast(bf16x8, pw[3]), ATT_PK(L, H, 3), o[d0], 0, 0, 0); } while (0)
    for (int t = 0; t < NT; ++t) {
        const int nx1 = (cur == 3 * STAGE) ? 0 : cur + STAGE; const int st3 = (cur == 0) ? 3 * STAGE : cur - STAGE;
        const bool more = (t + 3 < NT);
        if (sub == 1 && more) ATT_DMA(t + 3, st3);
        v4u pw[4];
        if (t <= my_last) {
            const float rm = rowmax32(pS0, pS1); bool resc = false;
            if (t == 0 || __any(rm > THR)) {
                const float dl = (t == 0) ? rm : fmaxf(rm, 0.f); mrun += dl;
#pragma unroll
                for (int r = 0; r < 16; ++r) { pS0[r] -= dl; pS1[r] -= dl; }
                if (t != 0) { const float f = fexp2(-dl); l_reg *= f; if (hi == 0) wsf[r32] = f; resc = true; }
            }
            float sacc = 0.f;
#pragma unroll
            for (int r = 0; r < 16; ++r) { pS0[r] = fexp2(pS0[r]); pS1[r] = fexp2(pS1[r]); sacc += pS0[r] + pS1[r]; }
            l_reg += sacc;
            if (resc) { LDS_WAIT();
#pragma unroll
                for (int r = 0; r < 16; ++r) { const float f = wsf[crow(r, hi)];
#pragma unroll
                    for (int d = 0; d < 4; ++d) o[d][r] *= f; } }
            pw[0] = (v4u){cvtpk(pS0[0], pS0[1]), cvtpk(pS0[2], pS0[3]), cvtpk(pS0[4], pS0[5]), cvtpk(pS0[6], pS0[7])};
            pw[1] = (v4u){cvtpk(pS0[8], pS0[9]), cvtpk(pS0[10], pS0[11]), cvtpk(pS0[12], pS0[13]), cvtpk(pS0[14], pS0[15])};
            pw[2] = (v4u){cvtpk(pS1[0], pS1[1]), cvtpk(pS1[2], pS1[3]), cvtpk(pS1[4], pS1[5]), cvtpk(pS1[6], pS1[7])};
            pw[3] = (v4u){cvtpk(pS1[8], pS1[9]), cvtpk(pS1[10], pS1[11]), cvtpk(pS1[12], pS1[13]), cvtpk(pS1[14], pS1[15])};
        }
        if (sub == 0) ATT_BAR_L(); else { if (more) ATT_WAIT_BAR(4); else ATT_WAIT_BAR(0); }
        if (sub == 0 && more) ATT_DMA(t + 3, st3);
        if (t <= my_last) {
            const int vb = vb0 + cur;
            s16x4 la[4], ha[4], lb[4], hb[4];
            ATT_RDV(la, ha, 0); ATT_RDV(lb, hb, 1);
            asm volatile("s_waitcnt lgkmcnt(8)" ::: "memory"); SBAR();
            ATT_PV(la, ha, 0); SBAR();
            ATT_RDV(la, ha, 2);
            asm volatile("s_waitcnt lgkmcnt(8)" ::: "memory"); SBAR();
            ATT_PV(lb, hb, 1); SBAR();
            ATT_RDV(lb, hb, 3);
            asm volatile("s_waitcnt lgkmcnt(8)" ::: "memory"); SBAR();
            ATT_PV(la, ha, 2); SBAR();
            asm volatile("s_waitcnt lgkmcnt(0)" ::: "memory"); SBAR();
            ATT_PV(lb, hb, 3);
        }
        if (t + 1 <= my_last) {
            bf16x8 kA0, kA1, kB0, kB1; const int ka = kb32 + nx1;
#define ATT_KRD(D0, D1, d0) do { asm volatile("ds_read_b128 %0,%1 offset:%c2" : "=&v"(D0) : "v"(ka), "i"((d0) * 2048) : "memory"); \
                                 asm volatile("ds_read_b128 %0,%1 offset:%c2" : "=&v"(D1) : "v"(ka), "i"((d0) * 2048 + 512) : "memory"); } while (0)
            ATT_KRD(kA0, kA1, 0); ATT_KRD(kB0, kB1, 1);
#pragma unroll
            for (int r = 0; r < 16; ++r) { pS0[r] = -mrun; pS1[r] = -mrun; }
            asm volatile("s_waitcnt lgkmcnt(2)" ::: "memory"); SBAR();
            pS0 = __builtin_amdgcn_mfma_f32_32x32x16_bf16(kA0, qr[0], pS0, 0, 0, 0); pS1 = __builtin_amdgcn_mfma_f32_32x32x16_bf16(kA1, qr[0], pS1, 0, 0, 0); SBAR();
            ATT_KRD(kA0, kA1, 2);
            asm volatile("s_waitcnt lgkmcnt(2)" ::: "memory"); SBAR();
            pS0 = __builtin_amdgcn_mfma_f32_32x32x16_bf16(kB0, qr[1], pS0, 0, 0, 0); pS1 = __builtin_amdgcn_mfma_f32_32x32x16_bf16(kB1, qr[1], pS1, 0, 0, 0); SBAR();
            ATT_KRD(kB0, kB1, 3);
            asm volatile("s_waitcnt lgkmcnt(2)" ::: "memory"); SBAR();
            pS0 = __builtin_amdgcn_mfma_f32_32x32x16_bf16(kA0, qr[2], pS0, 0, 0, 0); pS1 = __builtin_amdgcn_mfma_f32_32x32x16_bf16(kA1, qr[2], pS1, 0, 0, 0); SBAR();
            asm volatile("s_waitcnt lgkmcnt(0)" ::: "memory"); SBAR();
            pS0 = __builtin_amdgcn_mfma_f32_32x32x16_bf16(kB0, qr[3], pS0, 0, 0, 0); pS1 = __builtin_amdgcn_mfma_f32_32x32x16_bf16(kB1, qr[3], pS1, 0, 0, 0);
#undef ATT_KRD
        }
        if (sub == 1) ATT_BAR_L(); else { if (more) ATT_WAIT_BAR(4); else ATT_WAIT_BAR(0); }
        cur = nx1;
    }
#undef ATT_QK
#undef ATT_RDV
#undef ATT_PK
#undef ATT_PV
    if (sub == 0) ATT_BAR_L();
    { auto rr = __builtin_amdgcn_permlane32_swap(__float_as_uint(l_reg), __float_as_uint(l_reg), false, false); l_reg = __uint_as_float(rr[0]) + __uint_as_float(rr[1]); }
    if (hi == 0) wsf[32 + r32] = l_reg;
    LDS_WAIT();
    float rli[16];
#pragma unroll
    for (int r = 0; r < 16; ++r) rli[r] = frcp(wsf[32 + crow(r, hi)]);
    float* stg = (float*)shm + wq * 4096;
    if (sub == 1) {
#pragma unroll
        for (int r = 0; r < 16; ++r) { const int orow = crow(r, hi);
#pragma unroll
            for (int d = 0; d < 4; ++d) stg[orow * 128 + d * 32 + r32] = o[d][r] * rli[r]; }
    }
    ATT_WAIT_BAR(0);
    if (sub == 0) {
#pragma unroll
        for (int r = 0; r < 16; ++r) { const int orow = crow(r, hi);
#pragma unroll
            for (int d = 0; d < 4; ++d) { const float v = o[d][r] * rli[r] - lam * stg[orow * 128 + d * 32 + r32]; stg[orow * 128 + d * 32 + r32] = v; } }
        LDS_WAIT();
        const int c8 = (lane & 15) * 8;
        const f32x4 g0 = *(const f32x4*)(subln_g + c8), g1 = *(const f32x4*)(subln_g + c8 + 4);
        bf16* Ow = CAT + (rowbase + q0 + wq * 32) * DM + h * 128 + c8;
#pragma unroll
        for (int i = 0; i < 8; ++i) { const int row = i * 4 + (lane >> 4);
            const f32x4 a = *(const f32x4*)(stg + row * 128 + c8), c = *(const f32x4*)(stg + row * 128 + c8 + 4);
            float ss = (a[0] * a[0] + a[1] * a[1]) + (a[2] * a[2] + a[3] * a[3]) + (c[0] * c[0] + c[1] * c[1]) + (c[2] * c[2] + c[3] * c[3]);
            ss += __shfl_xor(ss, 1); ss += __shfl_xor(ss, 2); ss += __shfl_xor(ss, 4); ss += __shfl_xor(ss, 8);
            const float sc = (1.0f - LAM_INIT) / sqrtf(ss * (1.0f / 128.0f) + RMS_EPS);
            v4u w; w.x = cvtpk(a[0] * sc * g0[0], a[1] * sc * g0[1]); w.y = cvtpk(a[2] * sc * g0[2], a[3] * sc * g0[3]);
            w.z = cvtpk(c[0] * sc * g1[0], c[1] * sc * g1[1]); w.w = cvtpk(c[2] * sc * g1[2], c[3] * sc * g1[3]);
            *(v4u*)(Ow + (long)row * DM) = w; }
    }
    ATT_WAIT_BAR(0);
#undef ATT_DMA
}
#undef SBAR
}

#define XB_TMO      128
#define XB_XCNT(j)  (256  + 64 * (j))
#define XB_XSUB(j)  (1280 + 64 * (j))
#define XB_XGEN(j)  (2304 + 64 * (j))
#define XB_TOP      3328
#define XB_TOPGEN   3392
#define XCD_BAR_WORDS 3456
#define XB_SPIN_CAP (1u << 18)
__device__ __forceinline__ unsigned xb_ld(unsigned* p)              { return __hip_atomic_load(p, __ATOMIC_RELAXED, __HIP_MEMORY_SCOPE_AGENT); }
__device__ __forceinline__ unsigned xb_add(unsigned* p, unsigned v) { return __hip_atomic_fetch_add(p, v, __ATOMIC_RELAXED, __HIP_MEMORY_SCOPE_AGENT); }
__device__ __forceinline__ unsigned xb_xcc_id() { return (unsigned)__builtin_amdgcn_s_getreg((3 << 11) | 20) & 0xFu; }
#define XB_SPIN(cond, bar) do { unsigned _sp = 0; while (cond) { __builtin_amdgcn_s_sleep(1); \
    if ((++_sp & 255u) == 0u) { if (xb_ld(&(bar)[XB_TMO])) break; if (_sp > XB_SPIN_CAP) { atomicAdd(&(bar)[XB_TMO], 1u); break; } } } } while (0)
struct XcdBarrier { unsigned* bar; unsigned x; volatile LAS unsigned* st; };
__device__ __forceinline__ XcdBarrier xcd_barrier_post(unsigned* bar, volatile LAS unsigned* st) {
    XcdBarrier b; b.bar = bar; b.x = xb_xcc_id(); b.st = st;
    if (threadIdx.x == 0) (void)xb_add(&bar[XB_XCNT(b.x)], 1u);
    return b;
}
__device__ __forceinline__ void xcd_barrier_complete(unsigned* bar, unsigned x, unsigned& nloc, unsigned& nx) {
    const unsigned G = gridDim.x * gridDim.y * gridDim.z;
    unsigned sum, cnt, mine, sp = 0u;
    for (;;) {
        sum = 0u; cnt = 0u; mine = 0u;
#pragma unroll
        for (unsigned j = 0; j < 16; ++j) { const unsigned c = xb_ld(&bar[XB_XCNT(j)]); sum += c; cnt += (c > 0u) ? 1u : 0u; mine = (j == x) ? c : mine; }
        if (sum == G) break;
        __builtin_amdgcn_s_sleep(1);
        if ((++sp & 255u) == 0u) { if (xb_ld(&bar[XB_TMO])) break; if (sp > XB_SPIN_CAP) { atomicAdd(&bar[XB_TMO], 1u); break; } }
    }
    nloc = mine > 0u ? mine : 1u; nx = cnt > 0u ? cnt : 1u;
}
__device__ __forceinline__ void xcd_barrier(const XcdBarrier& b) {
    asm volatile("s_waitcnt vmcnt(0)" ::: "memory");
    __syncthreads();
    if (threadIdx.x == 0) {
        unsigned* bar = b.bar;
        __builtin_amdgcn_s_waitcnt(0);
        unsigned nloc = b.st[0], nx = b.st[1];
        if (nloc == 0u) { xcd_barrier_complete(bar, b.x, nloc, nx); b.st[0] = nloc; b.st[1] = nx; }
        const unsigned old = xb_add(&bar[XB_XSUB(b.x)], 1u);
        const unsigned gen = old / nloc;
        if (old + 1u == (gen + 1u) * nloc) {
            __builtin_amdgcn_fence(__ATOMIC_RELEASE, "agent");
            asm volatile("s_waitcnt vmcnt(0)" ::: "memory");
            const unsigned og = xb_add(&bar[XB_TOP], 1u);
            const unsigned tg = og / nx;
            if (og + 1u == (tg + 1u) * nx) xb_add(&bar[XB_TOPGEN], 1u);
            else XB_SPIN(xb_ld(&bar[XB_TOPGEN]) == tg, bar);
            __builtin_amdgcn_fence(__ATOMIC_ACQUIRE, "agent");
            xb_add(&bar[XB_XGEN(b.x)], 1u);
            asm volatile("s_waitcnt vmcnt(0)" ::: "memory");
        } else {
            XB_SPIN(xb_ld(&bar[XB_XGEN(b.x)]) == gen, bar);
            __builtin_amdgcn_fence(__ATOMIC_ACQUIRE, "agent");
            asm volatile("s_waitcnt vmcnt(0)" ::: "memory");
        }
    }
    __syncthreads();
}

constexpr int NWAVES = 8;
constexpr int NPHASES = 11;
struct Args { const void* in[27]; float* out; unsigned char* ws; int ph_lo, ph_hi, li, pad; };

struct Frame {
    LAS unsigned char* lds; unsigned char* ws; int tid, lane, wave, G, bid;
};

__device__ __forceinline__ void p0_transpose_tile(const float* W, int K, int N, bf16* WT, int row_off, int rmul, LAS float* scr, int tile, int tid) {
    const int nnb = N / 512, kb = tile / nnb, nb = tile % nnb, k0 = 64 * kb, n0 = 512 * nb;
    const int c4 = tid & 127, rr = tid >> 7;
    f32x4 v[16];
#pragma unroll
    for (int i = 0; i < 16; ++i) v[i] = *(const GAS f32x4*)(W + (size_t)(k0 + 4 * i + rr) * N + n0 + 4 * c4);
#pragma unroll
    for (int i = 0; i < 16; ++i) { const int k = 4 * i + rr; *(LAS f32x4*)(scr + k * 512 + ((4 * c4) ^ (4 * ((k >> 3) & 7)))) = v[i]; }
    __syncthreads();
    const int c = tid & 7, dn = tid >> 3;
#pragma unroll
    for (int j = 0; j < 8; ++j) { const int n = 64 * j + dn; const LAS float* sp = scr + (8 * c) * 512 + (n ^ (4 * c));
        v4u o; o.x = cvtpk(sp[0 * 512], sp[1 * 512]); o.y = cvtpk(sp[2 * 512], sp[3 * 512]); o.z = cvtpk(sp[4 * 512], sp[5 * 512]); o.w = cvtpk(sp[6 * 512], sp[7 * 512]);
        *(GAS v4u*)(WT + (size_t)(row_off + rmul * (n0 + n)) * K + k0 + 8 * c) = o; }
    __syncthreads();
}

__device__ __forceinline__ void p0_ssm_job(Frame& F, const Args& a, int job) {
    const int g = job >> 3, i = job & 7, tid = F.tid;
    const float* a_re = (const float*)a.in[7]; const float* a_im = (const float*)a.in[8]; const float* log_dt = (const float*)a.in[9];
    const float* b_re = (const float*)a.in[10]; const float* b_im = (const float*)a.in[11]; const float* c_re = (const float*)a.in[12]; const float* c_im = (const float*)a.in[13];
    LAS float* PW = (LAS float*)(F.lds);
    LAS float* BB = (LAS float*)(F.lds + 33280);
    LAS float* CC = (LAS float*)(F.lds + 41472);
    LAS bf16* KT = (LAS bf16*)(F.lds + 49664);
    if (tid < 64) {
        const int p = tid; const float are = a_re[g * 64 + p], aim = a_im[g * 64 + p]; const float dt = expf(log_dt[g]);
        const float mag = expf(are * dt), th = aim * dt; const float lr = mag * cosf(th), li = mag * sinf(th);
        float pr = 1.0f, pi = 0.0f;
        for (int j = 0; j <= 32; ++j) { PW[(j * 64 + p) * 2] = pr; PW[(j * 64 + p) * 2 + 1] = pi; const float nr = pr * lr - pi * li, ni = pr * li + pi * lr; pr = nr; pi = ni; }
        const float den = are * are + aim * aim; const float nr_ = lr - 1.0f, ni_ = li;
        const float fr_ = (nr_ * are + ni_ * aim) / den, fi_ = (ni_ * are - nr_ * aim) / den;
        for (int ci = 0; ci < 16; ++ci) { const float br = b_re[(g * 64 + p) * 16 + ci], bi = b_im[(g * 64 + p) * 16 + ci];
            BB[(p * 16 + ci) * 2] = fr_ * br - fi_ * bi; BB[(p * 16 + ci) * 2 + 1] = fr_ * bi + fi_ * br; }
    }
    for (int e = tid; e < 1024; e += 512) { CC[e * 2] = c_re[g * 1024 + e]; CC[e * 2 + 1] = c_im[g * 1024 + e]; }
    __syncthreads();
    {
        const int ci = tid & 15, c2 = (tid >> 4) & 1, jq = tid >> 5, co = 2 * i + c2;
        float acc[2] = {0.f, 0.f};
        for (int p = 0; p < 64; ++p) { const float cr = CC[(co * 64 + p) * 2], cim = CC[(co * 64 + p) * 2 + 1], br = BB[(p * 16 + ci) * 2], bi = BB[(p * 16 + ci) * 2 + 1];
            const float xr = cr * br - cim * bi, xi = cr * bi + cim * br;
#pragma unroll
            for (int q = 0; q < 2; ++q) { const int j = 2 * jq + q; acc[q] += xr * PW[(j * 64 + p) * 2] - xi * PW[(j * 64 + p) * 2 + 1]; } }
#pragma unroll
        for (int q = 0; q < 2; ++q) { const int j = 2 * jq + q; KT[(j * 2 + c2) * 16 + ci] = (bf16)(cvtpk(acc[q], 0.f) & 0xffffu); }
    }
    __syncthreads();
    bf16* toep = (bf16*)(F.ws + WS_TOEP) + (size_t)g * 1024 * UP_PITCH;
    for (int q = tid; q < 128 * 64; q += 512) { const int rl = q >> 6, chn = q & 63; const int t = rl >> 1, c2 = rl & 1, s = (t & 32) + (chn >> 1), half = chn & 1; const int n = t * 16 + 2 * i + c2;
        v4u w = (v4u){0u, 0u, 0u, 0u};
        if (t >= s) w = *(const LAS v4u*)(KT + ((t - s) * 2 + c2) * 16 + half * 8);
        *(GAS v4u*)(toep + (size_t)n * UP_PITCH + s * 16 + half * 8) = w; }
    for (int q = tid; q < 128 * 64; q += 512) { const int rl = q >> 6, p = q & 63; const int t = rl >> 1, c2 = rl & 1, co = 2 * i + c2; const int n = t * 16 + co; const int j = (t & 31) + 1;
        const float cr = CC[(co * 64 + p) * 2], cim = CC[(co * 64 + p) * 2 + 1], wr_ = PW[(j * 64 + p) * 2], wi_ = PW[(j * 64 + p) * 2 + 1];
        const float re = cr * wr_ - cim * wi_, im = cr * wi_ + cim * wr_;
        bf16* d = toep + (size_t)n * UP_PITCH + 1024 + 128 * (t >> 5) + p;
        d[0] = (bf16)(cvtpk(re, 0.f) & 0xffffu); d[64] = (bf16)(cvtpk(-im, 0.f) & 0xffffu); }
    bf16* wsin = (bf16*)(F.ws + WS_WSIN) + (size_t)g * 256 * 1024;
    for (int q = tid; q < 32 * 128; q += 512) { const int rl = q >> 7, k8 = (q & 127) * 8; const int pp = 32 * i + rl, p = pp & 63, s = k8 >> 4, ci0 = k8 & 15;
        float v[8];
#pragma unroll
        for (int c = 0; c < 8; ++c) v[c] = 0.f;
        if ((s >> 5) == (pp >> 7)) { const int j = 31 - (s & 31); const float wr_ = PW[(j * 64 + p) * 2], wi_ = PW[(j * 64 + p) * 2 + 1];
#pragma unroll
            for (int c = 0; c < 8; ++c) { const float br = BB[(p * 16 + ci0 + c) * 2], bi = BB[(p * 16 + ci0 + c) * 2 + 1]; v[c] = ((pp & 64) == 0) ? (wr_ * br - wi_ * bi) : (wr_ * bi + wi_ * br); } }
        *(GAS v4u*)(wsin + (size_t)pp * 1024 + k8) = (v4u){cvtpk(v[0], v[1]), cvtpk(v[2], v[3]), cvtpk(v[4], v[5]), cvtpk(v[6], v[7])}; }
    if (i == 0 && tid < 64) { float* lamb = (float*)(F.ws + WS_LAMB) + (g * 64 + tid) * 2; lamb[0] = PW[(32 * 64 + tid) * 2]; lamb[1] = PW[(32 * 64 + tid) * 2 + 1]; }
    __syncthreads();
}

__device__ __forceinline__ void p0_prologue(Frame& F, const Args& a) {
    for (int job = F.bid; job < 256; job += F.G) p0_ssm_job(F, a, job);
    LAS float* scr = (LAS float*)(F.lds);
    const int gw = F.bid * NWAVES + F.wave, NGW = F.G * NWAVES;
    const float* w_in = (const float*)a.in[1]; const float* w_glu = (const float*)a.in[15]; const float* w_out = (const float*)a.in[17];
    const float* wg = (const float*)a.in[22]; const float* wu = (const float*)a.in[23]; const float* wd = (const float*)a.in[24];
    constexpr int I_IN = 16 * 4, I_GLU = 8 * 1, I_OUT = 16 * 2, I_G = 16 * 1, I_D = 8 * 2;
    constexpr int NTILES = I_IN + I_GLU + I_OUT + NEXP * (2 * I_G);
    for (int it = F.bid; it < NTILES; it += F.G) {
        int r = it;
        if (r < I_IN) { p0_transpose_tile(w_in, 1024, 2048, (bf16*)(F.ws + WS_WIN_T), 0, 1, scr, r, F.tid); continue; } r -= I_IN;
        if (r < I_GLU) { p0_transpose_tile(w_glu, 512, 512, (bf16*)(F.ws + WS_WGLU_T), 0, 1, scr, r, F.tid); continue; } r -= I_GLU;
        if (r < I_OUT) { p0_transpose_tile(w_out, 1024, 1024, (bf16*)(F.ws + WS_WOUT_T), 0, 1, scr, r, F.tid); continue; } r -= I_OUT;
        const int e = r / (2 * I_G); r -= e * (2 * I_G);
        if (r < I_G) { p0_transpose_tile(wg + (size_t)e * 1024 * 512, 1024, 512, (bf16*)(F.ws + WS_WG1) + (size_t)e * 1024 * 1024, 0, 2, scr, r, F.tid); continue; } r -= I_G;
        p0_transpose_tile(wu + (size_t)e * 1024 * 512, 1024, 512, (bf16*)(F.ws + WS_WG1) + (size_t)e * 1024 * 1024, 1, 2, scr, r, F.tid);
    }
    (void)wd; (void)I_D;
    const float* x = (const float*)a.in[0]; bf16* xb = (bf16*)(F.ws + WS_XB);
    for (int m = gw; m < TOK; m += NGW) {
        const GAS f32x4* xr = (const GAS f32x4*)(x + (size_t)m * DM) + F.lane; GAS v2u* o8 = (GAS v2u*)(xb + (size_t)m * DM) + F.lane;
        f32x4 v[4];
#pragma unroll
        for (int j = 0; j < 4; ++j) v[j] = xr[64 * j];
#pragma unroll
        for (int j = 0; j < 4; ++j) o8[64 * j] = (v2u){cvtpk(v[j][0], v[j][1]), cvtpk(v[j][2], v[j][3])};
    }
}

__device__ __forceinline__ void p2_tail_transposes(Frame& F, const Args& a, int first_wg) {
    const float* wd = (const float*)a.in[24]; LAS float* scr = (LAS float*)(F.lds);
    const int nw = F.G - first_wg;
    if (nw > 0 && F.bid < first_wg) return;
    const int me = nw > 0 ? F.bid - first_wg : F.bid, step = nw > 0 ? nw : F.G;
    for (int it = me; it < NEXP * 16; it += step) { const int e = it >> 4, r = it & 15;
        p0_transpose_tile(wd + (size_t)e * 512 * 1024, 512, 1024, (bf16*)(F.ws + WS_WD) + (size_t)e * 1024 * 512, 0, 1, scr, r, F.tid); }
}

__device__ __forceinline__ void p3_scan(Frame& F, const float* sstate, int g, int pm) {
    const int tid = F.tid, lane = F.lane, wave = F.wave;
    const unsigned lds0 = (unsigned)(uintptr_t)(F.lds);
    LAS float* SB = (LAS float*)F.lds;
    LAS bf16* HS = (LAS bf16*)(F.lds + 98304);
    const float* ss = sstate + (size_t)(g * 512 + 4 * pm * 64) * 256;
    bf16* up = (bf16*)(F.ws + WS_UPERM) + (size_t)(g * 512 + 4 * pm * 64) * UP_PITCH + 1024;
#define P3_DMA(k, buf) do { _Pragma("unroll") for (int q_ = 0; q_ < 8; ++q_) { const int r_ = 8 * wave + q_; \
        att::glds16(ss + (size_t)((r_ >> 3) * 64 + 8 * (k) + (r_ & 7)) * 256 + lane * 4, (unsigned)__builtin_amdgcn_readfirstlane(lds0 + (buf) * 32768 + r_ * 1024)); } } while (0)
    if (wave < 4) {
        const int bb = tid >> 6, p = tid & 63;
        const float* lamb = (const float*)(F.ws + WS_LAMB) + (g * 64 + p) * 2; const float lr = lamb[0], li = lamb[1];
        asm volatile("s_waitcnt vmcnt(0)" :: "v"(lr), "v"(li) : "memory");
        float hr = 0.f, hi_ = 0.f;
        P3_DMA(0, 0); P3_DMA(1, 1);
        int buf = 0;
        for (int k = 0; k < 8; ++k) {
            if (k < 7) asm volatile("s_waitcnt vmcnt(8) lgkmcnt(0)\n\ts_barrier" ::: "memory"); else asm volatile("s_waitcnt vmcnt(0) lgkmcnt(0)\n\ts_barrier" ::: "memory");
            if (k + 2 < 8) { const int b2 = (buf >= 1) ? buf - 1 : buf + 2; P3_DMA(k + 2, b2); }
            const LAS float* sb = SB + buf * 8192 + bb * 8 * 256 + p; LAS bf16* hs = HS + (k & 1) * 8192 + bb * 8 * 256 + p;
#pragma unroll
            for (int j = 0; j < 8; ++j) { const float s0r = sb[j * 256], s0i = sb[j * 256 + 64], s1r = sb[j * 256 + 128], s1i = sb[j * 256 + 192];
                hs[j * 256] = (bf16)(cvtpk(hr, 0.f) & 0xffffu); hs[j * 256 + 64] = (bf16)(cvtpk(hi_, 0.f) & 0xffffu);
                float nr = lr * hr - li * hi_ + s0r, ni = lr * hi_ + li * hr + s0i; hr = nr; hi_ = ni;
                hs[j * 256 + 128] = (bf16)(cvtpk(hr, 0.f) & 0xffffu); hs[j * 256 + 192] = (bf16)(cvtpk(hi_, 0.f) & 0xffffu);
                nr = lr * hr - li * hi_ + s1r; ni = lr * hi_ + li * hr + s1i; hr = nr; hi_ = ni; }
            asm volatile("s_waitcnt lgkmcnt(0)\n\ts_barrier" ::: "memory");
            buf = (buf == 2) ? 0 : buf + 1;
        }
    } else {
        const int t2 = tid - 256;
        for (int k = 0; k < 8; ++k) {
            asm volatile("s_waitcnt lgkmcnt(0)\n\ts_barrier" ::: "memory");
            asm volatile("s_waitcnt lgkmcnt(0)\n\ts_barrier" ::: "memory");
#pragma unroll
            for (int q = 0; q < 4; ++q) { const int idx = t2 + 256 * q; const int r = idx >> 5, ch = idx & 31;
                const v4u w = *(const LAS v4u*)(HS + (k & 1) * 8192 + r * 256 + ch * 8);
                *(GAS v4u*)(up + (size_t)((r >> 3) * 64 + 8 * k + (r & 7)) * UP_PITCH + ch * 8) = w; }
        }
    }
#undef P3_DMA
    VM_WAIT(); LDS_WAIT(); __syncthreads();
}

__device__ __forceinline__ void p6_job(Frame& F, const Args& a, int job) {
    const int tid = F.tid, lane = F.lane, wave = F.wave;
    LAS _Float16* WR = (LAS _Float16*)F.lds;
    LAS float* LG = (LAS float*)(F.lds + 99072) + wave * 768;
    LAS int* SLE = (LAS int*)(F.lds + 99072 + 24576);
    LAS float* SLW = (LAS float*)(F.lds + 99072 + 24576 + 1024);
    LAS int* LCNT = (LAS int*)(F.lds + 99072 + 24576 + 2048);
    LAS int* LBASE = LCNT + 32; LAS int* LRANK = LCNT + 64;
    const bf16* pre = (const bf16*)(F.ws + WS_PREB); const f32x2* stats = (const f32x2*)(F.ws + WS_STATS);
    const float* g1 = (const float*)a.in[18]; const float* b1 = (const float*)a.in[19];
    bf16* hb = (bf16*)(F.ws + WS_HB);
    if (tid < 32) LCNT[tid] = 0;
    const int r0 = job * 128 + wave * 16; const int row = r0 + (lane & 15), kg = lane >> 4;
    float mean, rstd;
    { const f32x4* sp = (const f32x4*)(stats + (size_t)row * 16); float ms = 0.f; f32x4 q[8];
#pragma unroll
        for (int j = 0; j < 8; ++j) { q[j] = sp[j]; ms += q[j][0] + q[j][2]; }
        mean = ms * (1.0f / 16.0f); float m2 = 0.f;
#pragma unroll
        for (int j = 0; j < 8; ++j) { const float d0 = q[j][0] - mean, d1 = q[j][2] - mean; m2 += q[j][1] + q[j][3] + 64.0f * (d0 * d0 + d1 * d1); }
        rstd = 1.0f / sqrtf(m2 * (1.0f / 1024.0f) + LN_EPS); }
    f32x4 acc[3] = {(f32x4){0.f, 0.f, 0.f, 0.f}, (f32x4){0.f, 0.f, 0.f, 0.f}, (f32x4){0.f, 0.f, 0.f, 0.f}};
    const LAS float* GL = (const LAS float*)(F.lds + LDSCTL_OFF + 4096);
    v4u xq[8];
#pragma unroll
    for (int j = 0; j < 8; ++j) xq[j] = *(const v4u*)(pre + (size_t)row * DM + j * 32 + kg * 8);
#pragma unroll 1
    for (int kb = 0; kb < 4; ++kb) {
#pragma unroll
        for (int j = 0; j < 8; ++j) {
            const int ks = kb * 8 + j; const int col = ks * 32 + kg * 8;
            const v4u xw = xq[j];
            if (kb < 3) xq[j] = *(const v4u*)(pre + (size_t)row * DM + col + 256);
            const f32x4 x0 = (f32x4){bf_lo(xw.x), bf_hi(xw.x), bf_lo(xw.y), bf_hi(xw.y)}, x1 = (f32x4){bf_lo(xw.z), bf_hi(xw.z), bf_lo(xw.w), bf_hi(xw.w)};
            const f32x4 ga = *(const LAS f32x4*)(GL + col), gb = *(const LAS f32x4*)(GL + col + 4), ba = *(const LAS f32x4*)(GL + 1024 + col), bb = *(const LAS f32x4*)(GL + 1024 + col + 4);
            const f32x4 h0 = (x0 - mean) * rstd * ga + ba, h1 = (x1 - mean) * rstd * gb + bb;
            v4u w; w.x = cvtpk(h0[0], h0[1]); w.y = cvtpk(h0[2], h0[3]); w.z = cvtpk(h1[0], h1[1]); w.w = cvtpk(h1[2], h1[3]);
            *(v4u*)(hb + (size_t)row * DM + col) = w;
            f16x8 af; af[0] = (_Float16)h0[0]; af[1] = (_Float16)h0[1]; af[2] = (_Float16)h0[2]; af[3] = (_Float16)h0[3]; af[4] = (_Float16)h1[0]; af[5] = (_Float16)h1[1]; af[6] = (_Float16)h1[2]; af[7] = (_Float16)h1[3];
#pragma unroll
            for (int ntile = 0; ntile < 3; ++ntile) { const f16x8 bf = *(const LAS f16x8*)(WR + (ntile * 16 + (lane & 15)) * 1032 + col);
                acc[ntile] = __builtin_amdgcn_mfma_f32_16x16x32_f16(af, bf, acc[ntile], 0, 0, 0); }
        }
    }
#pragma unroll
    for (int ntile = 0; ntile < 3; ++ntile)
#pragma unroll
        for (int i = 0; i < 4; ++i) LG[(4 * kg + i) * 48 + ntile * 16 + (lane & 15)] = acc[ntile][i];
    LDS_WAIT(); asm volatile("" ::: "memory");
    if (lane < 16) {
        const LAS float* L = LG + lane * 48;
        float gm = L[0]; int gi = 0;
#pragma unroll
        for (int j = 1; j < 4; ++j) { const float v = L[j]; if (v > gm) { gm = v; gi = j; } }
        float gs = 0.f;
#pragma unroll
        for (int j = 0; j < 4; ++j) gs += __expf(L[j] - gm);
        const float gp = 1.0f / gs;
        float ev[8];
#pragma unroll
        for (int j = 0; j < 8; ++j) ev[j] = L[4 + gi * 8 + j];
        float m1 = ev[0]; int i1 = 0;
#pragma unroll
        for (int j = 1; j < 8; ++j) if (ev[j] > m1) { m1 = ev[j]; i1 = j; }
        float m2 = -INFINITY; int i2 = 0;
#pragma unroll
        for (int j = 0; j < 8; ++j) if (j != i1 && ev[j] > m2) { m2 = ev[j]; i2 = j; }
        const float ex = __expf(m2 - m1); const float w1 = 1.0f / (1.0f + ex), w2 = ex * w1;
        const int sl = (wave * 16 + lane) * 2;
        SLE[sl] = gi * 8 + i1; SLE[sl + 1] = gi * 8 + i2; SLW[sl] = gp * w1; SLW[sl + 1] = gp * w2;
    }
    __syncthreads();
    int e = 0;
    if (tid < 256) { e = SLE[tid]; LRANK[tid] = __hip_atomic_fetch_add(LCNT + e, 1, __ATOMIC_RELAXED, __HIP_MEMORY_SCOPE_WORKGROUP); }
    __syncthreads();
    if (tid < 32) LBASE[tid] = (int)__hip_atomic_fetch_add((gu32*)(F.ws + WS_CTL) + CW_GCNT + tid, (unsigned)LCNT[tid], RLX_AGENT);
    __syncthreads();
    if (tid < 256) { const int pos = LBASE[e] + LRANK[tid];
        ((int*)(F.ws + WS_ESLOT))[e * 65536 + pos] = job * 256 + tid; ((float*)(F.ws + WS_EW))[e * 65536 + pos] = SLW[tid]; }
    __syncthreads();
}

__device__ __forceinline__ int moe_layout(Frame& F, LAS int* pstart) {
    LAS int* tile_e = (LAS int*)(F.lds + TILE_E_OFF); LAS int* ecnt = pstart + 40;
    if (F.tid < 64) { const int e = F.tid & 31;
        const int c = (int)__hip_atomic_load((gu32*)(F.ws + WS_CTL) + CW_GCNT + e, RLX_AGENT); const int nf = c >> 8, hp = (c & 255) ? 1 : 0;
        int inf = nf, inp = hp;
#pragma unroll
        for (int o = 1; o < 32; o <<= 1) { const int v = __shfl_up(inf, o, 32), w = __shfl_up(inp, o, 32); if (e >= o) { inf += v; inp += w; } }
        const int totf = __shfl(inf, 31, 32), totp = __shfl(inp, 31, 32);
        if (F.tid < 32) { ecnt[e] = c; if (e == 0) pstart[32] = (totf + totp) << 8;
            const int sf = inf - nf; for (int t = 0; t < nf; ++t) tile_e[sf + t] = e | (t << 8);
            if (hp) tile_e[totf + inp - 1] = e | (nf << 8); } }
    __syncthreads();
    return pstart[NEXP] >> 8;
}

__global__ void __launch_bounds__(NWAVES * 64, 2) trunk_fwd(Args args) {
    extern __shared__ __attribute__((aligned(16))) unsigned char lds[];
    Frame F; F.lds = (LAS unsigned char*)lds; F.ws = args.ws; F.tid = threadIdx.x; F.lane = F.tid & 63; F.wave = __builtin_amdgcn_readfirstlane(F.tid >> 6); F.G = gridDim.x; F.bid = blockIdx.x;
    volatile LAS unsigned* MISC = (volatile LAS unsigned*)(F.lds + MISC_OFF);
    LAS int* PSTART = (LAS int*)(F.lds + LDSCTL_OFF);
    for (int u = F.tid; u < (LDS_BYTES - LDSCTL_OFF) / 4; u += NWAVES * 64) ((LAS unsigned*)(F.lds + LDSCTL_OFF))[u] = 0u;
    __syncthreads();
    gu32* ctl = (gu32*)(args.ws + WS_CTL);
    const int lo = args.ph_lo, hi = args.ph_hi;
    const bool multi = (hi - lo) > 1;
    XcdBarrier bar; bar.bar = (unsigned*)ctl + CW_BAR + args.li * XCD_BAR_WORDS; bar.x = 0; bar.st = nullptr;
    if (multi) bar = xcd_barrier_post((unsigned*)ctl + CW_BAR + args.li * XCD_BAR_WORDS, MISC + 8);
#define IN(k) (lo <= (k) && (k) < hi)
#define SEAM(k) do { if (IN(k) && IN((k) + 1)) xcd_barrier(bar); } while (0)
    bf16* const XB = (bf16*)(args.ws + WS_XB); bf16* const PROJ = (bf16*)(args.ws + WS_PROJ); bf16* const UPERM = (bf16*)(args.ws + WS_UPERM);
    bf16* const ZB = (bf16*)(args.ws + WS_Z); bf16* const CAT = (bf16*)(args.ws + WS_CAT); bf16* const HB = (bf16*)(args.ws + WS_HB);
    bf16* const HID = (bf16*)(args.ws + WS_HID); bf16* const Y2 = (bf16*)(args.ws + WS_Y2); bf16* const PREB = (bf16*)(args.ws + WS_PREB);

    if (IN(0)) { p0_prologue(F, args); }
    SEAM(0);
    if (IN(1)) {
        pg8::DenseOrder S; S.init(XB, args.ws + WS_WIN_T, 1024, 1024, TOK, NPROJ, F.G, F.bid);
        pg8::EpiInProj E{PROJ, PROJ + (size_t)TOK * 512, PROJ + (size_t)TOK * 1024, UPERM};
        pg8::gemm_phase<pg8::EpiInProj, pg8::DenseOrder, true>(F.lds, 1024, 1024, 1024, S, E);
    }
    SEAM(1);
    if (IN(2)) {
        for (int u = F.bid; u < 64; u += F.G) {
            const int g = u >> 1, pm = u & 1;
            pg8::OneUnit S; S.A = (const char*)(UPERM + (size_t)(g * 512 + pm * 256) * UP_PITCH); S.Bt = (const char*)((bf16*)(args.ws + WS_WSIN) + (size_t)g * 256 * 1024); S.u0 = pg8::Unit{pm, 0, g};
            pg8::EpiState E{args.out};
            pg8::gemm_phase<pg8::EpiState, pg8::OneUnit, true>(F.lds, 1024, UP_PITCH, 1024, S, E);
        }
        const float* lq1 = (const float*)args.in[2]; const float* lk1 = (const float*)args.in[3]; const float* lq2 = (const float*)args.in[4]; const float* lk2 = (const float*)args.in[5];
        const float s1 = wave_sum(lq1[F.lane] * lk1[F.lane]), s2 = wave_sum(lq2[F.lane] * lk2[F.lane]);
        const float lam = expf(s1) - expf(s2) + LAM_INIT;
        const int vcu = (F.G % 8 == 0) ? (F.bid % 8) * (F.G / 8) + F.bid / 8 : F.bid;
        for (int v = vcu; v < 256; v += F.G) {
            const int xg = v >> 5, j = v & 31;
#pragma unroll 1
            for (int i = 0; i < 4; ++i) { const int bh = xg * 4 + i; const int qb = (i & 1) ? 31 - j : j;
                att::attn_unit(bh >> 2, bh & 3, qb, PROJ, CAT, (char*)lds, lam, (const float*)args.in[6]); }
        }
        p2_tail_transposes(F, args, 64);
    }
    SEAM(2);
    if (IN(3)) {
        for (int u = F.bid; u < 256; u += F.G) {
            const int g = u >> 3, pm = (u >> 2) & 1, pn = u & 3;
            p3_scan(F, args.out, g, pm);
            pg8::SsmUnit S; S.A = (const char*)(UPERM + (size_t)(g * 512 + pm * 256) * UP_PITCH); S.Bt = (const char*)((bf16*)(args.ws + WS_TOEP) + (size_t)(g * 1024 + pn * 256) * UP_PITCH); S.u0 = pg8::Unit{pm, pn, g}; S.first = 8 * (pn >> 1); S.cnt = 4 * (pn & 1) + 4; S.st = 16 + 2 * (pn >> 1);
            pg8::EpiSsmOut E{UPERM, (const float*)args.in[14], ZB};
            pg8::gemm_phase<pg8::EpiSsmOut, pg8::SsmUnit, true>(F.lds, UP_PITCH, UP_PITCH, UP_PITCH, S, E);
        }
    }
    SEAM(3);
    if (IN(4)) {
        pg8::DenseOrder S; S.init(ZB, args.ws + WS_WGLU_T, 512, 512, TOK, SSMW, F.G, F.bid);
        pg8::EpiGlu E{ZB, (const float*)args.in[16], CAT};
        pg8::gemm_phase<pg8::EpiGlu, pg8::DenseOrder, true>(F.lds, 512, 512, 512, S, E);
    }
    SEAM(4);
    if (IN(5)) {
        pg8::DenseOrder S; S.init(CAT, args.ws + WS_WOUT_T, 1024, 1024, TOK, DM, F.G, F.bid);
        pg8::EpiOutProj E{XB, PREB, (f32x2*)(args.ws + WS_STATS)};
        pg8::gemm_phase<pg8::EpiOutProj, pg8::DenseOrder, true>(F.lds, 1024, 1024, 1024, S, E);
    }
    SEAM(5);
    if (IN(6)) {
        {
            LAS _Float16* WR = (LAS _Float16*)F.lds; const float* wrg = (const float*)args.in[20]; const float* wre = (const float*)args.in[21];
            for (int q = F.tid; q < 1024 * 4; q += 512) { const int k = q >> 2, n = q & 3; WR[n * 1032 + k] = (_Float16)wrg[q]; }
            for (int q = F.tid; q < 1024 * 32; q += 512) { const int k = q >> 5, n = q & 31; WR[(4 + n) * 1032 + k] = (_Float16)wre[q]; }
            for (int q = F.tid; q < 12 * 1032; q += 512) WR[36 * 1032 + q] = (_Float16)0.f;
            LAS float* GL = (LAS float*)(F.lds + LDSCTL_OFF + 4096); const float* g1_ = (const float*)args.in[18]; const float* b1_ = (const float*)args.in[19];
            for (int q = F.tid; q < 1024; q += 512) { GL[q] = g1_[q]; GL[1024 + q] = b1_[q]; }
        }
        __syncthreads();
        for (int job = F.bid; job < 256; job += F.G) p6_job(F, args, job);
    }
    SEAM(6);
    if (IN(8)) {
        const int ntiles = moe_layout(F, PSTART);
        pg8::MoeOrder<true> S; S.A = (const char*)HB; S.W = (const char*)(args.ws + WS_WG1); S.eslot = (const int*)(args.ws + WS_ESLOT); S.tile_e = (const LAS int*)(F.lds + TILE_E_OFF); S.ecnt = PSTART + 40; S.ntiles = ntiles; S.G = F.G; S.c = F.bid; S.lda = 1024; S.ldb = 1024;
        { const int per = F.G >> 5, chunk = (ntiles + 7) >> 3; S.lt_lim = (chunk / per) * per; }
        pg8::EpiMoe1 E{HID};
        pg8::gemm_phase<pg8::EpiMoe1, pg8::MoeOrder<true>, true>(F.lds, 1024, 1024, 1024, S, E);
    }
    SEAM(8);
    if (IN(9)) {
        const int ntiles = moe_layout(F, PSTART);
        const int x = F.bid & 7, j = F.bid >> 3, per = F.G >> 5, chunk = (ntiles + 7) >> 3, lt_main = (chunk / per) * per;
        int tiles_x = ntiles - x * chunk; tiles_x = tiles_x < 0 ? 0 : (tiles_x > chunk ? chunk : tiles_x);
        const int tail0 = lt_main < tiles_x ? lt_main : tiles_x; const int P = 4 * (tiles_x - tail0), U = 4 * tiles_x;
        const LAS int* tile_e = (const LAS int*)(F.lds + TILE_E_OFF);
        if (j < P) {
            pg8::MoeUnits<true> S; S.A = (const char*)HB; S.W = (const char*)(args.ws + WS_WG1); S.eslot = (const int*)(args.ws + WS_ESLOT); S.tile_e = tile_e; S.ecnt = PSTART + 40;
            S.tile0 = x * chunk; S.u_lo = 4 * tail0 + j; S.u_hi = S.u_lo + 1; S.lda = 1024; S.ldb = 1024;
            pg8::EpiMoe1T<true> E{HID};
            pg8::gemm_phase<pg8::EpiMoe1T<true>, pg8::MoeUnits<true>, true>(F.lds, 1024, 1024, 1024, S, E);
            if (F.tid == 0) __hip_atomic_fetch_add(ctl + CW_TAILCNT + x * chunk + tail0 + (j >> 2), 1u, RLX_AGENT);
        }
        const int tot = U + P, E_ = tot >> 5, rem = tot & 31, A_ = 32 - rem;
        const int sA = P < A_ ? P : A_, sB = P < A_ ? A_ : P;
        const int quota = E_ - 1 + (j >= sA ? 1 : 0) + (j >= sB ? 1 : 0);
        pg8::MoeRounds S; S.A = (const char*)HID; S.W = (const char*)(args.ws + WS_WD); S.tile_e = tile_e; S.ecnt = PSTART + 40; S.tile0 = x * chunk; S.j = j; S.E = E_; S.sA = sA; S.sB = sB; S.lda = 512; S.ldb = 512;
        int r_split = quota; for (int r = quota - 1; r >= 0; --r) if (S.lt_of(r) >= tail0) r_split = r;
        pg8::EpiMoe2 E{(const int*)(args.ws + WS_ESLOT), (const float*)(args.ws + WS_EW), PSTART + 40, Y2};
        S.r_lo = 0; S.r_hi = r_split;
        pg8::gemm_phase<pg8::EpiMoe2, pg8::MoeRounds, true>(F.lds, 512, 512, 512, S, E);
        if (quota > r_split) {
            if (F.tid == 0) {
                for (int r = r_split; r < quota; ++r) { gu32* cw = ctl + CW_TAILCNT + x * chunk + S.lt_of(r); unsigned sp = 0;
                    while (__hip_atomic_load(cw, RLX_AGENT) < 4u) { __builtin_amdgcn_s_sleep(2); if (++sp > (1u << 22)) break; } }
                __builtin_amdgcn_fence(__ATOMIC_ACQUIRE, "agent"); asm volatile("s_waitcnt vmcnt(0)" ::: "memory");
            }
            __syncthreads();
            S.r_lo = r_split; S.r_hi = quota;
            pg8::gemm_phase<pg8::EpiMoe2, pg8::MoeRounds, true>(F.lds, 512, 512, 512, S, E);
        }
    }
    SEAM(9);
    if (IN(10)) {
        const int gw = F.bid * NWAVES + F.wave, NGW = F.G * NWAVES;
        const float* g2 = (const float*)args.in[25]; const float* b2 = (const float*)args.in[26];
        for (int m = gw; m < TOK; m += NGW) {
            const GAS v2u* hr = (const GAS v2u*)(HB + (size_t)m * DM) + F.lane; const GAS v2u* y0 = (const GAS v2u*)(Y2 + (size_t)(2 * m) * DM) + F.lane; const GAS v2u* y1 = (const GAS v2u*)(Y2 + (size_t)(2 * m + 1) * DM) + F.lane;
            f32x4 v[4]; float s = 0.f;
#pragma unroll
            for (int j = 0; j < 4; ++j) { const v2u a = hr[64 * j], b = y0[64 * j], c = y1[64 * j];
                v[j][0] = ALPHA * bf_lo(a.x) + bf_lo(b.x) + bf_lo(c.x); v[j][1] = ALPHA * bf_hi(a.x) + bf_hi(b.x) + bf_hi(c.x);
                v[j][2] = ALPHA * bf_lo(a.y) + bf_lo(b.y) + bf_lo(c.y); v[j][3] = ALPHA * bf_hi(a.y) + bf_hi(b.y) + bf_hi(c.y);
                s += (v[j][0] + v[j][1]) + (v[j][2] + v[j][3]); }
            const float mean = wave_sum(s) * (1.f / DM); float s2 = 0.f;
#pragma unroll
            for (int j = 0; j < 4; ++j) { v[j] = v[j] - mean; s2 += (v[j][0] * v[j][0] + v[j][1] * v[j][1]) + (v[j][2] * v[j][2] + v[j][3] * v[j][3]); }
            const float rstd = 1.f / sqrtf(wave_sum(s2) * (1.f / DM) + LN_EPS);
            GAS f32x4* o = (GAS f32x4*)(args.out + (size_t)m * DM) + F.lane;
#pragma unroll
            for (int j = 0; j < 4; ++j) { const f32x4 gg = *((const GAS f32x4*)g2 + F.lane + 64 * j), bb = *((const GAS f32x4*)b2 + F.lane + 64 * j); o[64 * j] = v[j] * rstd * gg + bb; }
        }
    }
#undef IN
#undef SEAM
}

extern "C" void kernel_launch(void* const* d_in, const int* in_sizes, int n_in, void* d_out, int out_size, void* d_ws, size_t ws_size, hipStream_t stream) {
    static int grid = 0;
    if (grid == 0) {
        if (n_in != 27 || in_sizes[0] != TOK * DM || out_size != TOK * DM || ws_size < WS_END) { fprintf(stderr, "kernel_launch: unexpected shapes (n_in %d, in0 %d, out %d, ws %zu); nothing launched\n", n_in, n_in > 0 ? in_sizes[0] : -1, out_size, ws_size); grid = -1; return; }
        int dev = 0, cus = 0, per_cu = 0;
        if (hipGetDevice(&dev) != hipSuccess || hipDeviceGetAttribute(&cus, hipDeviceAttributeMultiprocessorCount, dev) != hipSuccess) { fprintf(stderr, "kernel_launch: device query failed\n"); grid = -1; return; }
        if (hipFuncSetAttribute((const void*)trunk_fwd, hipFuncAttributeMaxDynamicSharedMemorySize, LDS_BYTES) != hipSuccess) { fprintf(stderr, "kernel_launch: hipFuncSetAttribute failed\n"); grid = -1; return; }
        if (hipOccupancyMaxActiveBlocksPerMultiprocessor(&per_cu, (const void*)trunk_fwd, NWAVES * 64, LDS_BYTES) != hipSuccess || per_cu < 1) { fprintf(stderr, "kernel_launch: occupancy query reports %d blocks per CU\n", per_cu); per_cu = 1; }
        (void)hipGetLastError();
        grid = cus;
        if (grid != 256) fprintf(stderr, "kernel_launch: note: %d CUs (kernel tuned for 256)\n", grid);
    }
    if (grid < 0) return;
    (void)hipMemsetAsync((char*)d_ws + WS_CTL, 0, CTL_ZERO_BYTES, stream);
    Args a{};
    for (int i = 0; i < 27; ++i) a.in[i] = d_in[i];
    a.out = (float*)d_out; a.ws = (unsigned char*)d_ws;
    if (PROBE_DUP >= 0) { a.ph_lo = 0; a.ph_hi = PROBE_DUP + 1; a.li = 0; hipLaunchKernelGGL(trunk_fwd, dim3(grid), dim3(NWAVES * 64), LDS_BYTES, stream, a);
        a.ph_lo = PROBE_DUP; a.ph_hi = NPHASES; a.li = 1; hipLaunchKernelGGL(trunk_fwd, dim3(grid), dim3(NWAVES * 64), LDS_BYTES, stream, a); }
    else if (MK_N_LAUNCHES == 1) { a.ph_lo = 0; a.ph_hi = NPHASES; hipLaunchKernelGGL(trunk_fwd, dim3(grid), dim3(NWAVES * 64), LDS_BYTES, stream, a); }
    else { for (int p = 0; p < NPHASES; ++p) { a.ph_lo = p; a.ph_hi = p + 1; hipLaunchKernelGGL(trunk_fwd, dim3(grid), dim3(NWAVES * 64), LDS_BYTES, stream, a); } }
}
```

```cpp
#include <hip/hip_runtime.h>
#include <cstdio>
#include <cstdint>
#include <cmath>

#ifndef MK_N_LAUNCHES
#define MK_N_LAUNCHES 1
#endif
#ifndef PROBE_DUP
#define PROBE_DUP (-1)
#endif

constexpr int BATCH = 8, SEQ = 4096, DM = 1024, TOK = BATCH * SEQ;
constexpr int NPROJ = 2048, QKV_PITCH = 1536;
constexpr int NGRP = 32, GCH = 16, NSTATE = 64, SSMW = 512;
constexpr int NEXP = 32, DEXP = 512;
constexpr int UP_PITCH = 1280;
constexpr float LN_EPS = 1e-5f, RMS_EPS = 1e-5f;
constexpr float ALPHA = 1.189207115002721f;
constexpr float QSCALE = 0.125f * 1.4426950408889634f;
constexpr float LAM_INIT = 0.2f;
constexpr int MOE_MAXTILES = 288;
constexpr int MOE_MAXROWS = MOE_MAXTILES * 256;

constexpr size_t MiB = 1u << 20;
constexpr size_t WS_CTL = 0, CTL_ZERO_BYTES = 64 * 1024;
constexpr size_t WS_STATS = 1 * MiB;
constexpr size_t WS_LAMB = 7 * MiB + 512 * 1024;
constexpr size_t WS_WIN_T = 8 * MiB;
constexpr size_t WS_WOUT_T = 12 * MiB;
constexpr size_t WS_WGLU_T = 14 * MiB;
constexpr size_t WS_WG1 = 24 * MiB;
constexpr size_t WS_WD = 88 * MiB;
constexpr size_t WS_TOEP = 120 * MiB;
constexpr size_t WS_HB = 120 * MiB;
constexpr size_t WS_WSIN = 200 * MiB;
constexpr size_t WS_ESLOT = 200 * MiB;
constexpr size_t WS_EW = 208 * MiB;
constexpr size_t WS_XB = 216 * MiB;
constexpr size_t WS_PROJ = 280 * MiB;
constexpr size_t WS_UPERM = 376 * MiB;
constexpr size_t WS_PREB = 280 * MiB;
constexpr size_t WS_Y2 = 280 * MiB;
constexpr size_t WS_Z = 416 * MiB;
constexpr size_t WS_CAT = 448 * MiB;
constexpr size_t WS_HID = 416 * MiB;
constexpr size_t WS_END = 512 * MiB;
static_assert(WS_Y2 + (size_t)(65536 + 256) * 1024 * 2 <= WS_Z && WS_TOEP + (size_t)32 * 1024 * UP_PITCH * 2 <= WS_WSIN && WS_XB + (size_t)TOK * DM * 2 <= WS_PROJ && WS_PROJ + (size_t)TOK * 1536 * 2 <= WS_UPERM, "ws map");
static_assert(WS_HID + (size_t)MOE_MAXROWS * 512 * 2 <= WS_END, "HID overlay");
static_assert(WS_UPERM + (size_t)32 * 512 * UP_PITCH * 2 <= WS_Z, "UPERM");
constexpr int CW_TMO = 0, CW_CODE = 1;
constexpr int CW_GCNT = 64;
constexpr int CW_TAILCNT = 128;
constexpr int CW_SCANFLAG = 1024;
constexpr int CW_P4Q = 2048;
constexpr int CW_BAR = 4096;

constexpr int RING_BYTES = 131072;
constexpr int LDSCTL_OFF = RING_BYTES, MISC_OFF = LDSCTL_OFF + 320, TILE_E_OFF = LDSCTL_OFF + 512;
constexpr int LDS_BYTES = 147456;

#define GAS __attribute__((address_space(1)))
#define LAS __attribute__((address_space(3)))
typedef unsigned short bf16;
typedef unsigned v4u __attribute__((ext_vector_type(4)));
typedef unsigned v2u __attribute__((ext_vector_type(2)));
typedef float f32x4 __attribute__((ext_vector_type(4)));
typedef float f32x2 __attribute__((ext_vector_type(2)));
typedef float f32x16 __attribute__((ext_vector_type(16)));
typedef short bf16x8 __attribute__((ext_vector_type(8)));
typedef short s16x4 __attribute__((ext_vector_type(4)));
typedef _Float16 f16x8 __attribute__((ext_vector_type(8)));
typedef __bf16 bf16x2_t __attribute__((ext_vector_type(2)));
typedef GAS unsigned gu32;
#define RLX_AGENT __ATOMIC_RELAXED, __HIP_MEMORY_SCOPE_AGENT
#define LDS_WAIT() asm volatile("s_waitcnt lgkmcnt(0)" ::: "memory")
#define VM_WAIT() asm volatile("s_waitcnt vmcnt(0)" ::: "memory")

__device__ __forceinline__ unsigned cvtpk(float lo, float hi) { f32x2 v = {lo, hi}; bf16x2_t b = __builtin_convertvector(v, bf16x2_t); return __builtin_bit_cast(unsigned, b); }
__device__ __forceinline__ float bf_lo(unsigned w) { return __uint_as_float(w << 16); }
__device__ __forceinline__ float bf_hi(unsigned w) { return __uint_as_float(w & 0xffff0000u); }
__device__ __forceinline__ float fexp2(float x) { return __builtin_amdgcn_exp2f(x); }
__device__ __forceinline__ float frcp(float x) { return __builtin_amdgcn_rcpf(x); }
__device__ __forceinline__ float sigmoidf_(float x) { return frcp(1.0f + fexp2(-1.4426950408889634f * x)); }
__device__ __forceinline__ float gelu_tanh(float y) { const float t = y * (1.0f + 0.044715f * y * y) * (-2.302208198f); return y * frcp(1.0f + fexp2(t)); }
template <int CTRL> __device__ __forceinline__ float dppf(float v) { return __uint_as_float(__builtin_amdgcn_update_dpp(0u, __float_as_uint(v), CTRL, 0xf, 0xf, true)); }
__device__ __forceinline__ float row16_sum(float v) {
    v += dppf<0xB1>(v); v += dppf<0x4E>(v);
    v += dppf<0x141>(v); v += dppf<0x140>(v);
    return v;
}
__device__ __forceinline__ float fq_sum(float v) {
    { auto r = __builtin_amdgcn_permlane16_swap(__float_as_uint(v), __float_as_uint(v), false, false); v = __uint_as_float(r[0]) + __uint_as_float(r[1]); }
    { auto r = __builtin_amdgcn_permlane32_swap(__float_as_uint(v), __float_as_uint(v), false, false); v = __uint_as_float(r[0]) + __uint_as_float(r[1]); }
    return v;
}
__device__ __forceinline__ float wave_sum(float v) {
    v = row16_sum(v);
    return (__int_as_float(__builtin_amdgcn_readlane(__float_as_int(v), 0)) + __int_as_float(__builtin_amdgcn_readlane(__float_as_int(v), 16))) +
           (__int_as_float(__builtin_amdgcn_readlane(__float_as_int(v), 32)) + __int_as_float(__builtin_amdgcn_readlane(__float_as_int(v), 48)));
}

namespace pg8 {
#define PG8_LAS __attribute__((address_space(3)))
constexpr int BM = 256, BK = 64, HALF = 128, HTB = HALF * BK * 2, STAGE_BYTES = 8 * HTB, NXCD = 8, WGM = 8;
__host__ __device__ __forceinline__ int lds_byte(int r, int c) { const int st = (r >> 4) * 2 + (c >> 5), rr = r & 15, cc = c & 31, ob = rr * 64 + cc * 2; return st * 1024 + (ob ^ (((ob >> 9) & 1) << 5)); }
__host__ __device__ __forceinline__ void stage_rc(int b, int& R, int& C) { const int st = b / 1024, sb = b % 1024, swz = sb ^ (((sb >> 9) & 1) << 5); R = (st >> 1) * 16 + swz / 64; C = (st & 1) * 32 + (swz % 64) / 2; }
__host__ __device__ __forceinline__ int perm32(int rho) { const int n = rho >> 4, i = rho & 15; return 8 * (i >> 2) + 4 * n + (i & 3); }

struct Unit { int pm, pn, aux; };

struct DenseOrder {
    static constexpr bool GATHER = false, KMAP = false;
    __device__ __forceinline__ int nt() const { return 0; }
    __device__ __forceinline__ size_t koff(int t) const { return (size_t)t * 128; }
    __device__ __forceinline__ bool half(const Unit&) const { return false; }
    const char* A; const char* Bt; int lda, ldb; int nM, nN, nwg, G, c; int i0 = 0, ilim = 0x7fffffff;
    __device__ void init(const void* A_, const void* Bt_, int lda_, int ldb_, int M, int N, int G_, int c_) { A = (const char*)A_; Bt = (const char*)Bt_; lda = lda_; ldb = ldb_; nM = M / BM; nN = N / BM; nwg = nM * nN; G = G_; c = c_; }
    __device__ __forceinline__ bool next(int i, Unit& u) const {
        i += i0; if (i >= ilim) return false;
        const long L = (long)i * G + c; if (L >= nwg) return false;
        int wgid = (int)L; { const int q = nwg / NXCD, r = nwg % NXCD, xcd = wgid % NXCD, off = wgid / NXCD; wgid = (xcd < r ? xcd * (q + 1) : r * (q + 1) + (xcd - r) * q) + off; }
        const int nig = WGM * nN, gid = wgid / nig, fm = gid * WGM, gsz = (nM - fm) < WGM ? (nM - fm) : WGM;
        u.pm = fm + ((wgid % nig) % gsz); u.pn = (wgid % nig) / gsz; u.aux = 0; return true;
    }
    __device__ __forceinline__ const char* a_ptr(const Unit& u) const { return A + (size_t)u.pm * BM * lda * 2; }
    __device__ __forceinline__ const char* b_ptr(const Unit& u) const { return Bt + (size_t)u.pn * BM * ldb * 2; }
    __device__ __forceinline__ void gather(const Unit&, const int*, const int*, unsigned*, unsigned*) const {}
};
struct OneUnit {
    static constexpr bool GATHER = false, KMAP = false;
    __device__ __forceinline__ int nt() const { return 0; }
    __device__ __forceinline__ size_t koff(int t) const { return (size_t)t * 128; }
    __device__ __forceinline__ bool half(const Unit&) const { return false; }
    const char* A; const char* Bt; Unit u0;
    __device__ __forceinline__ bool next(int i, Unit& u) const { if (i > 0) return false; u = u0; return true; }
    __device__ __forceinline__ const char* a_ptr(const Unit&) const { return A; }
    __device__ __forceinline__ const char* b_ptr(const Unit&) const { return Bt; }
    __device__ __forceinline__ void gather(const Unit&, const int*, const int*, unsigned*, unsigned*) const {}
};
struct SsmUnit {
    static constexpr bool GATHER = false, KMAP = true;
    const char* A; const char* Bt; Unit u0; int first, cnt, st;
    __device__ __forceinline__ bool next(int i, Unit& u) const { if (i > 0) return false; u = u0; return true; }
    __device__ __forceinline__ const char* a_ptr(const Unit&) const { return A; }
    __device__ __forceinline__ const char* b_ptr(const Unit&) const { return Bt; }
    __device__ __forceinline__ void gather(const Unit&, const int*, const int*, unsigned*, unsigned*) const {}
    __device__ __forceinline__ int nt() const { return cnt + 2; }
    __device__ __forceinline__ bool half(const Unit&) const { return false; }
    __device__ __forceinline__ size_t koff(int t) const { return (size_t)((t < cnt) ? first + t : st + (t - cnt)) * 128; }
};
template <bool GATHER_> struct MoeOrder {
    static constexpr bool GATHER = GATHER_, KMAP = false;
    __device__ __forceinline__ int nt() const { return 0; }
    __device__ __forceinline__ size_t koff(int t) const { return (size_t)t * 128; }
    const char* A; const char* W; const int* eslot; const PG8_LAS int* tile_e; const PG8_LAS int* ecnt; int ntiles, G, c, lda, ldb, lt_lim;
    const PG8_LAS int* tokr = nullptr; const PG8_LAS int* pre_tile = nullptr;
    __device__ __forceinline__ bool next(int i, Unit& u) const { const int x = c & 7, j = c >> 3, per = G >> 5;
        const int chunk = (ntiles + 7) >> 3; const int lt = i * per + (j >> 2); const int rt = x * chunk + lt;
        if ((j >> 2) >= per || lt >= chunk || lt >= lt_lim || rt >= ntiles) return false; u.pm = rt; u.pn = j & 3; u.aux = tile_e[rt]; return true; }
    __device__ __forceinline__ bool half(const Unit& u) const { return ecnt[u.aux & 255] - (u.aux >> 8) * BM <= HALF; }
    __device__ __forceinline__ const char* a_ptr(const Unit& u) const { return GATHER_ ? A : A + (size_t)u.pm * BM * lda * 2; }
    __device__ __forceinline__ const char* b_ptr(const Unit& u) const { return W + ((size_t)(u.aux & 255) * 1024 + (size_t)u.pn * BM) * ldb * 2; }
    __device__ __forceinline__ void gather(const Unit& u, const int* RA, const int* CA, unsigned* v0, unsigned* v1) const {
        const int e = u.aux & 255, r0 = (u.aux >> 8) * BM, cnt = ecnt[e];
        int rr = -1;
        if (pre_tile) {
#pragma unroll
            for (int k = 0; k < 6; ++k) rr = (pre_tile[k] == u.pm) ? k : rr; }
#pragma unroll
        for (int i = 0; i < 2; ++i) { const int i0 = r0 + RA[i], i1 = i0 + HALF; int t0, t1;
            if (rr >= 0) { t0 = tokr[rr * 256 + RA[i]]; t1 = tokr[rr * 256 + RA[i] + HALF]; }
            else { t0 = (i0 < cnt) ? (eslot[e * 65536 + i0] >> 1) : 0; t1 = (i1 < cnt) ? (eslot[e * 65536 + i1] >> 1) : 0; }
            v0[i] = (unsigned)(t0 * lda + CA[i]) * 2u; v1[i] = (unsigned)(t1 * lda + CA[i]) * 2u; }
    }
};

template <bool GATHER_> struct MoeUnits {
    static constexpr bool GATHER = GATHER_, KMAP = false;
    __device__ __forceinline__ int nt() const { return 0; }
    __device__ __forceinline__ size_t koff(int t) const { return (size_t)t * 128; }
    const char* A; const char* W; const int* eslot; const PG8_LAS int* tile_e; const PG8_LAS int* ecnt; int tile0, u_lo, u_hi, lda, ldb;
    __device__ __forceinline__ bool next(int i, Unit& u) const { const int q = u_lo + i; if (q >= u_hi) return false; u.pm = tile0 + (q >> 2); u.pn = q & 3; u.aux = tile_e[u.pm]; return true; }
    __device__ __forceinline__ bool half(const Unit& u) const { return ecnt[u.aux & 255] - (u.aux >> 8) * BM <= HALF; }
    __device__ __forceinline__ const char* a_ptr(const Unit& u) const { return GATHER_ ? A : A + (size_t)u.pm * BM * lda * 2; }
    __device__ __forceinline__ const char* b_ptr(const Unit& u) const { return W + ((size_t)(u.aux & 255) * 1024 + (size_t)u.pn * BM) * ldb * 2; }
    __device__ __forceinline__ void gather(const Unit& u, const int* RA, const int* CA, unsigned* v0, unsigned* v1) const {
        const int e = u.aux & 255, r0 = (u.aux >> 8) * BM, cnt = ecnt[e];
#pragma unroll
        for (int i = 0; i < 2; ++i) { const int i0 = r0 + RA[i], i1 = i0 + HALF;
            const int t0 = (i0 < cnt) ? (eslot[e * 65536 + i0] >> 1) : 0, t1 = (i1 < cnt) ? (eslot[e * 65536 + i1] >> 1) : 0;
            v0[i] = (unsigned)(t0 * lda + CA[i]) * 2u; v1[i] = (unsigned)(t1 * lda + CA[i]) * 2u; }
    }
};

struct MoeRounds {
    static constexpr bool GATHER = false, KMAP = false;
    __device__ __forceinline__ int nt() const { return 0; }
    __device__ __forceinline__ size_t koff(int t) const { return (size_t)t * 128; }
    const char* A; const char* W; const PG8_LAS int* tile_e; const PG8_LAS int* ecnt; int tile0, j, E, sA, sB, r_lo, r_hi, lda, ldb;
    __device__ __forceinline__ int lt_of(int r) const { const int s = r < E - 1 ? 0 : (r == E - 1 ? sA : sB); const int base = r < E ? 8 * r : 8 * (E - 1) + ((32 - sA) >> 2); return base + ((j - s) >> 2); }
    __device__ __forceinline__ bool next(int i, Unit& u) const { const int r = r_lo + i; if (r >= r_hi) return false; const int s = r < E - 1 ? 0 : (r == E - 1 ? sA : sB);
        u.pm = tile0 + lt_of(r); u.pn = (j - s) & 3; u.aux = tile_e[u.pm]; return true; }
    __device__ __forceinline__ bool half(const Unit& u) const { return ecnt[u.aux & 255] - (u.aux >> 8) * BM <= HALF; }
    __device__ __forceinline__ const char* a_ptr(const Unit& u) const { return A + (size_t)u.pm * BM * lda * 2; }
    __device__ __forceinline__ const char* b_ptr(const Unit& u) const { return W + ((size_t)(u.aux & 255) * 1024 + (size_t)u.pn * BM) * ldb * 2; }
    __device__ __forceinline__ void gather(const Unit&, const int*, const int*, unsigned*, unsigned*) const {}
};

template <class Epi, class Sched, bool ALIGN_EPI>
__device__ __forceinline__ void gemm_phase(PG8_LAS unsigned char* lds, const int K, const int lda, const int ldb, const Sched& S, const Epi& E) {
    int tid = threadIdx.x; asm volatile("" : "+v"(tid));
    const int wid = __builtin_amdgcn_readfirstlane(tid >> 6), lane = tid & 63, wr = wid >> 2, wc = wid & 3, fr = lane & 15, fq = lane >> 4;
    int nt = K / BK; if constexpr (Sched::KMAP) nt = S.nt();
#define PG8_KOFF(t) (Sched::KMAP ? S.koff(t) : (size_t)(t) * kstep)
    unsigned vA0[2], vA1[2], nvA0[2], nvA1[2], voffB[2]; int RA[2], CA[2];
#pragma unroll
    for (int i = 0; i < 2; ++i) { int R, C; stage_rc(tid * 16 + i * 8192, R, C); const int Rb = Epi::PERM ? ((R & ~31) + perm32(R & 31)) : R;
        RA[i] = R; CA[i] = C; vA0[i] = (unsigned)(R * lda + C) * 2u; vA1[i] = (unsigned)((R + HALF) * lda + C) * 2u; voffB[i] = (unsigned)(Rb * ldb + C) * 2u; nvA0[i] = vA0[i]; nvA1[i] = vA1[i]; }
    const size_t kstep = (size_t)(BK * 2);
    const size_t hstepB = (size_t)HALF * ldb * 2;
    const unsigned ldsw = (unsigned)wid * 1024u;
    const int aoff = lds_byte(wr * 64 + fr, fq * 8), boff = lds_byte(wc * 32 + fr, fq * 8);
#define PG8_SA(b, h) (((b) * 2 + (h)) * HTB)
#define PG8_SB(b, h) ((4 + (b) * 2 + (h)) * HTB)
#define PG8_STAGE2(bufoff, gbase, o0, o1) do { \
        __builtin_amdgcn_global_load_lds((const unsigned*)((const char*)(gbase) + (o0)), (PG8_LAS unsigned*)(lds + (bufoff) + ldsw), 16, 0, 0); \
        __builtin_amdgcn_global_load_lds((const unsigned*)((const char*)(gbase) + (o1)), (PG8_LAS unsigned*)(lds + (bufoff) + ldsw + 8192), 16, 0, 0); } while (0)
#define PG8_STAGEB(bufoff, gbase) PG8_STAGE2(bufoff, gbase, voffB[0], voffB[1])
#define PG8_LDA(dst, b, h) do { _Pragma("unroll") for (int m = 0; m < 4; ++m) _Pragma("unroll") for (int k = 0; k < 2; ++k) dst[m][k] = *(const PG8_LAS bf16x8*)(lds + PG8_SA(b, h) + aoff + m * 2048 + k * 1024); } while (0)
#define PG8_LDB(dst, b, h) do { _Pragma("unroll") for (int n = 0; n < 2; ++n) _Pragma("unroll") for (int k = 0; k < 2; ++k) dst[n][k] = *(const PG8_LAS bf16x8*)(lds + PG8_SB(b, h) + boff + n * 2048 + k * 1024); } while (0)
#define PG8_MMA(ai, bj, At, Bt) do { __builtin_amdgcn_s_setprio(1); _Pragma("unroll") for (int m = 0; m < 4; ++m) _Pragma("unroll") for (int n = 0; n < 2; ++n) _Pragma("unroll") for (int k = 0; k < 2; ++k) \
        acc[ai][bj][m][n] = __builtin_amdgcn_mfma_f32_16x16x32_bf16(Bt[n][k], At[m][k], acc[ai][bj][m][n], 0, 0, 0); __builtin_amdgcn_s_setprio(0); } while (0)
#define PG8_WAIT_V(n) asm volatile("s_waitcnt vmcnt(" #n ")" ::: "memory")
#define PG8_WAIT_L(n) asm volatile("s_waitcnt lgkmcnt(" #n ")" ::: "memory")
#define PG8_BAR __builtin_amdgcn_s_barrier()
#define PG8_SCHED __builtin_amdgcn_sched_barrier(0)
    Unit cur, nxt; int ui = 0;
    if (!S.next(0, cur)) return;
    if constexpr (Sched::GATHER) S.gather(cur, RA, CA, vA0, vA1);
    bool halfu = S.half(cur);
    f32x4 acc[2][2][4][2];
#pragma unroll
    for (int a = 0; a < 2; ++a)
#pragma unroll
        for (int b = 0; b < 2; ++b)
#pragma unroll
            for (int m = 0; m < 4; ++m)
#pragma unroll
                for (int n = 0; n < 2; ++n) acc[a][b][m][n] = (f32x4){0.f, 0.f, 0.f, 0.f};
    bf16x8 At[4][2], B0[2][2], B1[2][2];
    const char* cA = S.a_ptr(cur); const char* cB = S.b_ptr(cur);
    { const size_t k0_ = PG8_KOFF(0), k1_ = PG8_KOFF(1);
    PG8_STAGEB(PG8_SB(0, 0), cB + k0_); PG8_STAGEB(PG8_SB(0, 1), cB + hstepB + k0_); PG8_STAGE2(PG8_SA(0, 0), cA + k0_, vA0[0], vA0[1]); PG8_STAGE2(PG8_SA(0, 1), cA + k0_, vA1[0], vA1[1]);
    if (wr == 1) PG8_BAR;
    PG8_WAIT_V(2); PG8_BAR;
    PG8_STAGEB(PG8_SB(1, 0), cB + k1_); PG8_STAGE2(PG8_SA(1, 0), cA + k1_, vA0[0], vA0[1]); PG8_STAGEB(PG8_SB(1, 1), cB + hstepB + k1_); }
    PG8_WAIT_V(6); PG8_BAR;
    for (;;) {
        const bool has_next = S.next(ui + 1, nxt);
        const char* nA = has_next ? S.a_ptr(nxt) : cA; const char* nB = has_next ? S.b_ptr(nxt) : cB;
        if constexpr (Sched::GATHER) { if (has_next) S.gather(nxt, RA, CA, nvA0, nvA1); else { nvA0[0] = vA0[0]; nvA0[1] = vA0[1]; nvA1[0] = vA1[0]; nvA1[1] = vA1[1]; } }
        for (int t = 0; t < nt; t += 2) {
            const bool last = (t == nt - 2);
            const size_t k1_ = PG8_KOFF(t + 1), k2_ = last ? PG8_KOFF(0) : PG8_KOFF(t + 2), k3_ = last ? PG8_KOFF(1) : PG8_KOFF(t + 3);
            const char* a1 = cA + k1_;
            const char* a2 = (last ? nA : cA) + k2_; const char* b2 = (last ? nB : cB) + k2_;
            const char* a3 = (last ? nA : cA) + k3_; const char* b3 = (last ? nB : cB) + k3_;
            unsigned s00 = vA0[0], s01 = vA0[1], s10 = vA1[0], s11 = vA1[1];
            if constexpr (Sched::GATHER) { if (last) { s00 = nvA0[0]; s01 = nvA0[1]; s10 = nvA1[0]; s11 = nvA1[1]; } }
            PG8_LDB(B0, 0, 0); PG8_LDB(B1, 0, 1); PG8_SCHED; PG8_LDA(At, 0, 0); PG8_STAGE2(PG8_SA(1, 1), a1, vA1[0], vA1[1]);
            PG8_WAIT_V(8); PG8_WAIT_L(0); PG8_BAR; PG8_MMA(0, 0, At, B0); PG8_MMA(0, 1, At, B1); PG8_BAR; PG8_SCHED;
            PG8_LDA(At, 0, 1); PG8_STAGEB(PG8_SB(0, 0), b2); PG8_STAGEB(PG8_SB(0, 1), b2 + hstepB); PG8_STAGE2(PG8_SA(0, 0), a2, s00, s01);
            PG8_WAIT_V(8); PG8_WAIT_L(0); PG8_BAR; if (!halfu) { PG8_MMA(1, 0, At, B0); PG8_MMA(1, 1, At, B1); } PG8_BAR; PG8_SCHED;
            PG8_LDB(B0, 1, 0); PG8_LDB(B1, 1, 1); PG8_SCHED; PG8_LDA(At, 1, 0); PG8_STAGE2(PG8_SA(0, 1), a2, s10, s11);
            PG8_WAIT_V(8); PG8_WAIT_L(0); PG8_BAR; PG8_MMA(0, 0, At, B0); PG8_MMA(0, 1, At, B1); PG8_BAR; PG8_SCHED;
            PG8_LDA(At, 1, 1); PG8_STAGEB(PG8_SB(1, 0), b3); PG8_STAGEB(PG8_SB(1, 1), b3 + hstepB); PG8_STAGE2(PG8_SA(1, 0), a3, s00, s01);
            PG8_WAIT_V(8); PG8_WAIT_L(0); PG8_BAR; if (!halfu) { PG8_MMA(1, 0, At, B0); PG8_MMA(1, 1, At, B1); } PG8_BAR; PG8_SCHED;
        }
        if constexpr (ALIGN_EPI) { if (wr == 0) PG8_BAR; }
        E(acc, cur, wr, wc, fr, fq);
        if (!has_next) break;
#pragma unroll
        for (int a = 0; a < 2; ++a)
#pragma unroll
            for (int b = 0; b < 2; ++b)
#pragma unroll
                for (int m = 0; m < 4; ++m)
#pragma unroll
                    for (int n = 0; n < 2; ++n) acc[a][b][m][n] = (f32x4){0.f, 0.f, 0.f, 0.f};
        cur = nxt; cA = nA; cB = nB; ++ui; halfu = S.half(cur);
        if constexpr (Sched::GATHER) { vA0[0] = nvA0[0]; vA0[1] = nvA0[1]; vA1[0] = nvA1[0]; vA1[1] = nvA1[1]; }
        if constexpr (ALIGN_EPI) { if (wr == 1) PG8_BAR; }
    }
    PG8_WAIT_V(0);
    if constexpr (!ALIGN_EPI) { if (wr == 0) PG8_BAR; }
    PG8_BAR;
#undef PG8_KOFF
#undef PG8_SA
#undef PG8_SB
#undef PG8_STAGE2
#undef PG8_STAGEB
#undef PG8_LDA
#undef PG8_LDB
#undef PG8_MMA
#undef PG8_WAIT_V
#undef PG8_WAIT_L
#undef PG8_BAR
#undef PG8_SCHED
}

typedef f32x4 AccT[2][2][4][2];

struct EpiInProj {
    static constexpr bool PERM = true;
    bf16* q; bf16* kt; bf16* vt; bf16* uperm;
    __device__ __forceinline__ void operator()(const AccT& acc, const Unit& u, int wr, int wc, int fr, int fq) const {
        const int row0 = u.pm * BM + wr * 64 + fr; const int col0 = u.pn * BM + wc * 32 + 8 * fq;
        const float sc = (u.pn < 2) ? QSCALE : 1.0f;
#pragma unroll
        for (int ai = 0; ai < 2; ++ai)
#pragma unroll
            for (int m = 0; m < 4; ++m) { const int row = row0 + ai * HALF + m * 16; const int b = row >> 12, sq = row & 4095, tl = sq >> 6, s = sq & 63;
#pragma unroll
                for (int bj = 0; bj < 2; ++bj) { const f32x4 v0 = acc[ai][bj][m][0] * sc, v1 = acc[ai][bj][m][1] * sc; const int col = col0 + bj * HALF;
                    v4u w; w.x = cvtpk(v0[0], v0[1]); w.y = cvtpk(v0[2], v0[3]); w.z = cvtpk(v1[0], v1[1]); w.w = cvtpk(v1[2], v1[3]);
                    if (u.pn < 2) *(v4u*)(q + (size_t)row * 512 + col) = w;
                    else if (u.pn < 4) { const int ck = col - 512, h = ck >> 7, sub = (ck >> 6) & 1, ch = (ck & 63) >> 3;
                        *(v4u*)(kt + ((size_t)((((b * 4 + h) * 2 + sub) * 64 + tl) * 8 + ch) * 512 + s * 8)) = w; }
                    else if (u.pn < 6) { const int cv = col - 1024, h = cv >> 7, d0 = (cv & 127) >> 5, c16 = (cv & 31) >> 3;
                        *(v4u*)(vt + ((size_t)(((b * 4 + h) * 64 + tl) * 4 + d0) * 2048 + s * 32 + c16 * 8)) = w; }
                    else { const int cu = col - 1536, g = cu >> 4, ci0 = cu & 15;
                        *(v4u*)(uperm + ((size_t)(g * 512 + b * 64 + tl) * UP_PITCH + s * 16 + ci0)) = w; } } }
    }
};
struct EpiState {
    static constexpr bool PERM = false;
    float* sstate;
    __device__ __forceinline__ void operator()(const AccT& acc, const Unit& u, int wr, int wc, int fr, int fq) const {
        const int row0 = u.pm * BM + wr * 64 + fr; const int col0 = wc * 32 + 4 * fq;
#pragma unroll
        for (int ai = 0; ai < 2; ++ai)
#pragma unroll
            for (int m = 0; m < 4; ++m) { const int row = row0 + ai * HALF + m * 16;
#pragma unroll
                for (int bj = 0; bj < 2; ++bj)
#pragma unroll
                    for (int n = 0; n < 2; ++n) *(f32x4*)(sstate + ((size_t)(u.aux * 512 + row) * 256 + bj * HALF + col0 + n * 16)) = acc[ai][bj][m][n]; }
    }
};
struct EpiSsmOut {
    static constexpr bool PERM = true;
    const bf16* uperm; const float* dvec; bf16* z;
    __device__ __forceinline__ void operator()(const AccT& acc, const Unit& u, int wr, int wc, int fr, int fq) const {
        const int g = u.aux; const int row0 = u.pm * BM + wr * 64 + fr; const int col0 = u.pn * BM + wc * 32 + 8 * fq;
        const int co0 = col0 & 15;
        const f32x4 d0 = *(const f32x4*)(dvec + g * 16 + co0), d1 = *(const f32x4*)(dvec + g * 16 + co0 + 4);
#pragma unroll
        for (int ai = 0; ai < 2; ++ai)
#pragma unroll
            for (int m = 0; m < 4; ++m) { const int row = row0 + ai * HALF + m * 16; const int b = row >> 6, ch = row & 63;
#pragma unroll
                for (int bj = 0; bj < 2; ++bj) { const int col = col0 + bj * HALF; const int t = col >> 4;
                    const v4u uw = *(const v4u*)(uperm + ((size_t)(g * 512 + row) * UP_PITCH + col));
                    const f32x4 a0 = acc[ai][bj][m][0], a1 = acc[ai][bj][m][1];
                    float y[8];
                    y[0] = a0[0] + d0[0] * bf_lo(uw.x); y[1] = a0[1] + d0[1] * bf_hi(uw.x); y[2] = a0[2] + d0[2] * bf_lo(uw.y); y[3] = a0[3] + d0[3] * bf_hi(uw.y);
                    y[4] = a1[0] + d1[0] * bf_lo(uw.z); y[5] = a1[1] + d1[1] * bf_hi(uw.z); y[6] = a1[2] + d1[2] * bf_lo(uw.w); y[7] = a1[3] + d1[3] * bf_hi(uw.w);
#pragma unroll
                    for (int j = 0; j < 8; ++j) y[j] = gelu_tanh(y[j]);
                    v4u w; w.x = cvtpk(y[0], y[1]); w.y = cvtpk(y[2], y[3]); w.z = cvtpk(y[4], y[5]); w.w = cvtpk(y[6], y[7]);
                    *(v4u*)(z + ((size_t)(b * SEQ + ch * 64 + t) * SSMW + g * 16 + co0)) = w; } }
    }
};
struct EpiGlu {
    static constexpr bool PERM = true;
    const bf16* z; const float* bias; bf16* cat;
    __device__ __forceinline__ void operator()(const AccT& acc, const Unit& u, int wr, int wc, int fr, int fq) const {
        const int row0 = u.pm * BM + wr * 64 + fr; const int col0 = u.pn * BM + wc * 32 + 8 * fq;
#pragma unroll
        for (int bj = 0; bj < 2; ++bj) { const int col = col0 + bj * HALF; const f32x4 b0 = *(const f32x4*)(bias + col), b1 = *(const f32x4*)(bias + col + 4);
#pragma unroll
            for (int ai = 0; ai < 2; ++ai)
#pragma unroll
                for (int m = 0; m < 4; ++m) { const int row = row0 + ai * HALF + m * 16;
                    const v4u zw = *(const v4u*)(z + (size_t)row * SSMW + col);
                    const f32x4 a0 = acc[ai][bj][m][0] + b0, a1 = acc[ai][bj][m][1] + b1;
                    float s[8];
                    s[0] = bf_lo(zw.x) * sigmoidf_(a0[0]); s[1] = bf_hi(zw.x) * sigmoidf_(a0[1]); s[2] = bf_lo(zw.y) * sigmoidf_(a0[2]); s[3] = bf_hi(zw.y) * sigmoidf_(a0[3]);
                    s[4] = bf_lo(zw.z) * sigmoidf_(a1[0]); s[5] = bf_hi(zw.z) * sigmoidf_(a1[1]); s[6] = bf_lo(zw.w) * sigmoidf_(a1[2]); s[7] = bf_hi(zw.w) * sigmoidf_(a1[3]);
                    v4u w; w.x = cvtpk(s[0], s[1]); w.y = cvtpk(s[2], s[3]); w.z = cvtpk(s[4], s[5]); w.w = cvtpk(s[6], s[7]);
                    *(v4u*)(cat + (size_t)row * DM + 512 + col) = w; } }
    }
};
struct EpiOutProj {
    static constexpr bool PERM = true;
    const bf16* xb; bf16* pre; f32x2* stats;
    __device__ __forceinline__ void operator()(const AccT& acc, const Unit& u, int wr, int wc, int fr, int fq) const {
        const int row0 = u.pm * BM + wr * 64 + fr; const int col0 = u.pn * BM + wc * 32 + 8 * fq;
#pragma unroll
        for (int ai = 0; ai < 2; ++ai)
#pragma unroll
            for (int m = 0; m < 4; ++m) { const int row = row0 + ai * HALF + m * 16; const size_t off = (size_t)row * DM + col0;
                f32x4 v[2][2]; float s = 0.f;
#pragma unroll
                for (int bj = 0; bj < 2; ++bj) { const v4u xw = __builtin_nontemporal_load((const v4u*)(xb + off + bj * HALF));
                    v[bj][0] = (f32x4){bf_lo(xw.x), bf_hi(xw.x), bf_lo(xw.y), bf_hi(xw.y)} * ALPHA + acc[ai][bj][m][0];
                    v[bj][1] = (f32x4){bf_lo(xw.z), bf_hi(xw.z), bf_lo(xw.w), bf_hi(xw.w)} * ALPHA + acc[ai][bj][m][1];
                    v4u w; w.x = cvtpk(v[bj][0][0], v[bj][0][1]); w.y = cvtpk(v[bj][0][2], v[bj][0][3]); w.z = cvtpk(v[bj][1][0], v[bj][1][1]); w.w = cvtpk(v[bj][1][2], v[bj][1][3]);
                    *(v4u*)(pre + off + bj * HALF) = w;
#pragma unroll
                    for (int n = 0; n < 2; ++n) s += (v[bj][n][0] + v[bj][n][1]) + (v[bj][n][2] + v[bj][n][3]); }
                s = fq_sum(s);
                const float mw = s * (1.0f / 64.0f); float q = 0.f;
#pragma unroll
                for (int bj = 0; bj < 2; ++bj)
#pragma unroll
                    for (int n = 0; n < 2; ++n) { const f32x4 d = v[bj][n] - mw; q += (d[0] * d[0] + d[1] * d[1]) + (d[2] * d[2] + d[3] * d[3]); }
                q = fq_sum(q);
                if (fq == 0) stats[(size_t)row * 16 + u.pn * 4 + wc] = (f32x2){mw, q}; }
    }
};
template <bool WT  > struct EpiMoe1T {
    static constexpr bool PERM = true;
    bf16* hid;
    __device__ __forceinline__ void operator()(const AccT& acc, const Unit& u, int wr, int wc, int fr, int fq) const {
        const int row0 = u.pm * BM + wr * 64 + fr; const int col0 = u.pn * BM + wc * 32 + 8 * fq;
#pragma unroll
        for (int ai = 0; ai < 2; ++ai)
#pragma unroll
            for (int m = 0; m < 4; ++m) { const int row = row0 + ai * HALF + m * 16;
                v2u wv[2];
#pragma unroll
                for (int bj = 0; bj < 2; ++bj) { const f32x4 a0 = acc[ai][bj][m][0], a1 = acc[ai][bj][m][1];
                    const float h0 = a0[0] * sigmoidf_(a0[0]) * a0[1], h1 = a0[2] * sigmoidf_(a0[2]) * a0[3], h2 = a1[0] * sigmoidf_(a1[0]) * a1[1], h3 = a1[2] * sigmoidf_(a1[2]) * a1[3];
                    wv[bj].x = cvtpk(h0, h1); wv[bj].y = cvtpk(h2, h3); }
                if constexpr (WT) {
#pragma unroll
                    for (int bj = 0; bj < 2; ++bj) __hip_atomic_store((GAS unsigned long long*)(hid + (size_t)row * DEXP + ((col0 + bj * HALF) >> 1)), ((unsigned long long)wv[bj].y << 32) | wv[bj].x, __ATOMIC_RELAXED, __HIP_MEMORY_SCOPE_AGENT);
                } else {
                    const auto sx = __builtin_amdgcn_permlane16_swap(wv[0].x, wv[1].x, false, false); const auto sy = __builtin_amdgcn_permlane16_swap(wv[0].y, wv[1].y, false, false);
                    const int bjs = fq & 1; const int colw = ((col0 + bjs * HALF) >> 1) - 4 * bjs;
                    *(v4u*)(hid + (size_t)row * DEXP + colw) = (v4u){sx[0], sy[0], sx[1], sy[1]}; } }
    }
};
typedef EpiMoe1T<false> EpiMoe1;
struct EpiMoe2 {
    static constexpr bool PERM = true;
    const int* eslot; const float* ew; const PG8_LAS int* ecnt; bf16* y2;
    const PG8_LAS v2u* pre; const PG8_LAS int* pre_tile;
    __device__ __forceinline__ void operator()(const AccT& acc, const Unit& u, int wr, int wc, int fr, int fq) const {
        const int e = u.aux & 255, cnt = ecnt[e]; const int row0 = (u.aux >> 8) * BM + wr * 64 + fr; const int col0 = u.pn * BM + wc * 32 + 8 * fq;
        int rr = -1;
#pragma unroll
        for (int k = 0; k < 6; ++k) rr = (pre_tile[k] == u.pm) ? k : rr;
#pragma unroll
        for (int ai = 0; ai < 2; ++ai)
#pragma unroll
            for (int m = 0; m < 4; ++m) { const int idx = row0 + ai * HALF + m * 16; const bool ok = idx < cnt;
                int slot; float wt;
                if (rr >= 0) { const v2u pv = pre[rr * 256 + wr * 64 + fr + ai * HALF + m * 16]; slot = (int)pv.x; wt = __uint_as_float(pv.y); }
                else { slot = ok ? eslot[e * 65536 + idx] : 65536 + (idx & 255); wt = ok ? ew[e * 65536 + idx] : 0.f; }
#pragma unroll
                for (int bj = 0; bj < 2; ++bj) { const f32x4 v0 = acc[ai][bj][m][0] * wt, v1 = acc[ai][bj][m][1] * wt;
                    v4u w; w.x = cvtpk(v0[0], v0[1]); w.y = cvtpk(v0[2], v0[3]); w.z = cvtpk(v1[0], v1[1]); w.w = cvtpk(v1[2], v1[3]);
                    *(v4u*)(y2 + (size_t)slot * DM + col0 + bj * HALF) = w; } }
    }
};
}

__device__ const unsigned char ATT_QB[4][32] = {
    {7, 8, 9, 2, 10, 0, 13, 17, 6, 18, 5, 28, 4, 16, 11, 12, 1, 3, 22, 29, 23, 19, 14, 30, 27, 21, 31, 24, 20, 26, 15, 25},
    {25, 30, 16, 14, 22, 21, 0, 10, 24, 15, 28, 3, 27, 26, 23, 29, 31, 8, 18, 1, 11, 4, 9, 2, 19, 12, 5, 17, 13, 6, 20, 7},
    {10, 3, 5, 14, 13, 6, 9, 0, 8, 17, 7, 15, 4, 2, 1, 12, 16, 28, 11, 22, 24, 25, 18, 26, 20, 30, 29, 19, 31, 21, 27, 23},
    {9, 10, 20, 21, 6, 24, 29, 23, 28, 16, 26, 19, 31, 22, 30, 13, 18, 27, 15, 14, 7, 17, 25, 8, 0, 3, 1, 5, 2, 12, 4, 11}};
namespace att {
__device__ __forceinline__ int crow(int r, int hi) { return (r & 3) + 8 * (r >> 2) + 4 * hi; }
#define SBAR() __builtin_amdgcn_sched_barrier(0)
constexpr int STAGE = 32768, K_OFF = 0, V_OFF = 16384, WS_OFF = 131072 + 4096;
constexpr float THR = 8.0f;
__device__ __forceinline__ void glds16(const void* gsrc, unsigned lds_dst) { unsigned keep;
    asm volatile("s_mov_b32 %0, m0\n\ts_mov_b32 m0, %2\n\ts_nop 0\n\tglobal_load_lds_dwordx4 %1, off\n\ts_mov_b32 m0, %0" : "=&s"(keep) : "v"(gsrc), "s"(lds_dst) : "memory"); }
#define ATT_WAIT_BAR(N) asm volatile("s_waitcnt vmcnt(" #N ") lgkmcnt(0)\n\ts_barrier" ::: "memory")
#define ATT_BAR_L() asm volatile("s_waitcnt lgkmcnt(0)\n\ts_barrier" ::: "memory")

__device__ __forceinline__ float max3f(float a, float b, float c) { return __builtin_fmaxf(__builtin_fmaxf(a, b), c); }
__device__ __forceinline__ float max2f(float a, float b) { return __builtin_fmaxf(a, b); }
__device__ __forceinline__ float rowmax32(const f32x16& p0, const f32x16& p1) {
    float a = max3f(p0[0], p0[1], p1[0]), b = max3f(p0[2], p0[3], p1[1]); a = max3f(a, p1[2], p1[3]);
#pragma unroll
    for (int r = 4; r < 16; r += 4) { a = max3f(a, p0[r], p0[r + 1]); b = max3f(b, p0[r + 2], p0[r + 3]); a = max3f(a, p1[r], p1[r + 1]); b = max3f(b, p1[r + 2], p1[r + 3]); }
    const float m = max2f(a, b);
    auto rr = __builtin_amdgcn_permlane32_swap(__float_as_uint(m), __float_as_uint(m), false, false);
    return max2f(__uint_as_float(rr[0]), __uint_as_float(rr[1]));
}

__device__ __forceinline__ void attn_unit(int b, int h, int qb, const bf16* PROJ, bf16* CAT, char* shm, float lam, const float* subln_g) {
    const int tid = threadIdx.x, lane = tid & 63, r32 = lane & 31, hi = lane >> 5; const int wid = __builtin_amdgcn_readfirstlane(tid >> 6);
    const int sub = wid >> 2, wq = wid & 3;
    const long rowbase = (long)b * SEQ; const int q0 = qb * 128;
    const bf16* Qw = PROJ + (rowbase + q0 + wq * 32) * 512 + h * 128 + sub * 64;
    const bf16* Kh = PROJ + (size_t)TOK * 512 + (size_t)((b * 4 + h) * 2) * 64 * 4096;
    const bf16* Vh = PROJ + (size_t)TOK * 1024 + (size_t)(b * 4 + h) * 64 * 8192;
    const unsigned lds0 = (unsigned)(uintptr_t)shm;
    float* wsf = (float*)(shm + WS_OFF) + wid * 64;
    const bf16* ksrc0 = Kh + wid * 512 + lane * 8;
    const bf16* ksrc1 = ksrc0 + 64 * 4096;
    const unsigned kdst0 = lds0 + K_OFF + wid * 1024, kdst1 = lds0 + K_OFF + 8192 + wid * 1024;
    const bf16* vsrc0 = Vh + wid * 512 + lane * 8;
    const bf16* vsrc1 = vsrc0 + 4096;
    const unsigned vdst0 = lds0 + V_OFF + wid * 1024, vdst1 = vdst0 + 8192;
#define ATT_DMA(t, so) do { const long rk_ = (long)(t) * 4096, rv_ = (long)(t) * 8192; const unsigned so_ = (unsigned)(so); \
        glds16(ksrc0 + rk_, (unsigned)__builtin_amdgcn_readfirstlane(kdst0 + so_)); glds16(ksrc1 + rk_, (unsigned)__builtin_amdgcn_readfirstlane(kdst1 + so_)); \
        glds16(vsrc0 + rv_, (unsigned)__builtin_amdgcn_readfirstlane(vdst0 + so_)); glds16(vsrc1 + rv_, (unsigned)__builtin_amdgcn_readfirstlane(vdst1 + so_)); } while (0)
#define ATT_DMAP(pc, t, so) do { if ((pc) == 0) glds16(ksrc0 + (long)(t) * 4096, (unsigned)__builtin_amdgcn_readfirstlane(kdst0 + (unsigned)(so))); \
        else if ((pc) == 1) glds16(ksrc1 + (long)(t) * 4096, (unsigned)__builtin_amdgcn_readfirstlane(kdst1 + (unsigned)(so))); \
        else if ((pc) == 2) glds16(vsrc0 + (long)(t) * 8192, (unsigned)__builtin_amdgcn_readfirstlane(vdst0 + (unsigned)(so))); \
        else glds16(vsrc1 + (long)(t) * 8192, (unsigned)__builtin_amdgcn_readfirstlane(vdst1 + (unsigned)(so))); } while (0)
    const int NT = 2 * qb + 2; const int my_last = 2 * qb + (wq >> 1);
    ATT_DMA(0, 0); ATT_DMA(1, STAGE); if (NT > 2) { ATT_DMA(2, 2 * STAGE); ATT_DMA(3, 3 * STAGE); }
    bf16x8 qr[4];
#pragma unroll
    for (int d0 = 0; d0 < 4; ++d0) qr[d0] = *reinterpret_cast<const bf16x8*>(&Qw[(long)r32 * 512 + d0 * 16 + hi * 8]);
    float mrun = 0.f, l_reg = 0.f;
    f32x16 o[4];
#pragma unroll
    for (int d = 0; d < 4; ++d) o[d] = f32x16{};
    const int vb0 = (int)(lds0 + V_OFF) + ((lane >> 4) & 1) * 32 + (lane & 3) * 8 + (4 * hi + ((lane & 15) >> 2)) * 64;
    const char* kbase = shm + K_OFF + sub * 8192 + hi * 1024 + r32 * 16;
    const int kb32 = (int)(lds0 + K_OFF) + sub * 8192 + hi * 1024 + r32 * 16;
    if (NT > 2) ATT_WAIT_BAR(8); else ATT_WAIT_BAR(0);
    asm volatile("" :: "v"(qr[0]), "v"(qr[1]), "v"(qr[2]), "v"(qr[3]));
#define ATT_QK(P0, P1, soff) do { const char* kb_ = kbase + (soff); f32x16 negm; _Pragma("unroll") for (int r = 0; r < 16; ++r) negm[r] = -mrun;     \
        _Pragma("unroll") for (int d0 = 0; d0 < 4; ++d0) { \
            const bf16x8 b0_ = *reinterpret_cast<const bf16x8*>(kb_ + d0 * 2048); const bf16x8 b1_ = *reinterpret_cast<const bf16x8*>(kb_ + d0 * 2048 + 512); \
            if (d0 == 0) { P0 = __builtin_amdgcn_mfma_f32_32x32x16_bf16(b0_, qr[0], negm, 0, 0, 0); P1 = __builtin_amdgcn_mfma_f32_32x32x16_bf16(b1_, qr[0], negm, 0, 0, 0); } \
            else { P0 = __builtin_amdgcn_mfma_f32_32x32x16_bf16(b0_, qr[d0], P0, 0, 0, 0); P1 = __builtin_amdgcn_mfma_f32_32x32x16_bf16(b1_, qr[d0], P1, 0, 0, 0); } } } while (0)
    f32x16 pS0, pS1;
    ATT_QK(pS0, pS1, 0);
    v4u pw[4];
#define ATT_PACK() do { \
        pw[0] = (v4u){cvtpk(pS0[0], pS0[1]), cvtpk(pS0[2], pS0[3]), cvtpk(pS0[4], pS0[5]), cvtpk(pS0[6], pS0[7])}; \
        pw[1] = (v4u){cvtpk(pS0[8], pS0[9]), cvtpk(pS0[10], pS0[11]), cvtpk(pS0[12], pS0[13]), cvtpk(pS0[14], pS0[15])}; \
        pw[2] = (v4u){cvtpk(pS1[0], pS1[1]), cvtpk(pS1[2], pS1[3]), cvtpk(pS1[4], pS1[5]), cvtpk(pS1[6], pS1[7])}; \
        pw[3] = (v4u){cvtpk(pS1[8], pS1[9]), cvtpk(pS1[10], pS1[11]), cvtpk(pS1[12], pS1[13]), cvtpk(pS1[14], pS1[15])}; } while (0)
    {
        const float rm = rowmax32(pS0, pS1); mrun = rm; float sacc = 0.f;
#pragma unroll
        for (int r = 0; r < 16; ++r) { pS0[r] = fexp2(pS0[r] - rm); pS1[r] = fexp2(pS1[r] - rm); sacc += pS0[r] + pS1[r]; }
        l_reg = sacc;
        ATT_PACK();
    }
    int cur = 0;
#define ATT_RDVK(L, H, ks) do { _Pragma("unroll") for (int d0 = 0; d0 < 4; ++d0) { \
                    asm volatile("ds_read_b64_tr_b16 %0,%1 offset:%c2" : "=&v"(L[d0]) : "v"(vb), "i"(d0 * 4096 + (ks) * 1024) : "memory"); \
                    asm volatile("ds_read_b64_tr_b16 %0,%1 offset:%c2" : "=&v"(H[d0]) : "v"(vb), "i"(d0 * 4096 + (ks) * 1024 + 512) : "memory"); } } while (0)
#define ATT_PK(L, H, k) (bf16x8){L[k][0], L[k][1], L[k][2], L[k][3], H[k][0], H[k][1], H[k][2], H[k][3]}
#define ATT_PVK1(L, H, ks, d0) o[d0] = __builtin_amdgcn_mfma_f32_32x32x16_bf16(__builtin_bit_cast(bf16x8, pw[ks]), ATT_PK(L, H, d0), o[d0], 0, 0, 0)
#define ATT_KRD(D0, D1, d0) do { asm volatile("ds_read_b128 %0,%1 offset:%c2" : "=&v"(D0) : "v"(ka), "i"((d0) * 2048) : "memory"); \
                                 asm volatile("ds_read_b128 %0,%1 offset:%c2" : "=&v"(D1) : "v"(ka), "i"((d0) * 2048 + 512) : "memory"); } while (0)
#define ATT_SOFT(g) do { \
        _Pragma("unroll") for (int e_ = 3 * (g); e_ < 3 * (g) + 3; ++e_) { if (e_ < 16) pS0[e_ & 15] = fexp2(pS0[e_ & 15]); else if (e_ < 32) pS1[e_ & 15] = fexp2(pS1[e_ & 15]); } \
        _Pragma("unroll") for (int e_ = 3 * (g); e_ < 3 * (g) + 3; ++e_) { if (e_ < 16) sacc += pS0[e_ & 15]; else if (e_ < 32) sacc += pS1[e_ & 15]; } } while (0)
#define ATT_WAITV(n, L, H) asm volatile("s_waitcnt lgkmcnt(" #n ")" : "+v"(L[0]), "+v"(L[1]), "+v"(L[2]), "+v"(L[3]), "+v"(H[0]), "+v"(H[1]), "+v"(H[2]), "+v"(H[3]) :: "memory")
#define ATT_WAITK(n, A, B) asm volatile("s_waitcnt lgkmcnt(" #n ")" : "+v"(A), "+v"(B) :: "memory")
#define ATT_PIN1(x) asm volatile("" : "+v"(x))
#define ATT_PIN2(x, y) asm volatile("" : "+v"(x), "+v"(y))
    int prv = 3 * STAGE;
    for (int t = 0; t < NT; ++t) {
        const int nx1 = (cur == 3 * STAGE) ? 0 : cur + STAGE;
        const bool dma = (t >= 1) && (t + 3 < NT);
        if (t + 1 <= my_last) {
            const int vb = vb0 + cur; const int ka = kb32 + nx1;
            s16x4 la[4], ha[4], lb[4], hb[4]; bf16x8 kA0, kA1, kB0, kB1;
            ATT_RDVK(la, ha, 0);
            ATT_KRD(kA0, kA1, 0); ATT_KRD(kB0, kB1, 1);
#pragma unroll
            for (int r = 0; r < 16; ++r) { pS0[r] = -mrun; pS1[r] = -mrun; }
            ATT_WAITK(2, kA0, kA1); SBAR();
            pS0 = __builtin_amdgcn_mfma_f32_32x32x16_bf16(kA0, qr[0], pS0, 0, 0, 0); pS1 = __builtin_amdgcn_mfma_f32_32x32x16_bf16(kA1, qr[0], pS1, 0, 0, 0); ATT_PIN2(pS0, pS1); SBAR();
            ATT_KRD(kA0, kA1, 2);
            ATT_WAITK(2, kB0, kB1); SBAR();
            pS0 = __builtin_amdgcn_mfma_f32_32x32x16_bf16(kB0, qr[1], pS0, 0, 0, 0); pS1 = __builtin_amdgcn_mfma_f32_32x32x16_bf16(kB1, qr[1], pS1, 0, 0, 0); ATT_PIN2(pS0, pS1); SBAR();
            ATT_KRD(kB0, kB1, 3);
            ATT_WAITK(2, kA0, kA1); SBAR();
            pS0 = __builtin_amdgcn_mfma_f32_32x32x16_bf16(kA0, qr[2], pS0, 0, 0, 0); pS1 = __builtin_amdgcn_mfma_f32_32x32x16_bf16(kA1, qr[2], pS1, 0, 0, 0); ATT_PIN2(pS0, pS1); SBAR();
            ATT_RDVK(lb, hb, 1);
            ATT_WAITK(8, kB0, kB1); SBAR();
            pS0 = __builtin_amdgcn_mfma_f32_32x32x16_bf16(kB0, qr[3], pS0, 0, 0, 0); pS1 = __builtin_amdgcn_mfma_f32_32x32x16_bf16(kB1, qr[3], pS1, 0, 0, 0); SBAR();
            ATT_WAITV(8, la, ha); SBAR();
            ATT_PVK1(la, ha, 0, 0); SBAR();
            if (dma) ATT_DMAP(0, t + 3, prv);
            float ma = max3f(pS0[0], pS0[1], pS0[2]), mb = max3f(pS0[3], pS0[4], pS0[5]); ma = max3f(ma, pS0[6], pS0[7]); mb = max3f(mb, pS0[8], pS0[9]); ATT_PIN2(ma, mb); SBAR();
            ATT_PVK1(la, ha, 0, 1); SBAR();
            if (dma) ATT_DMAP(1, t + 3, prv);
            ma = max3f(ma, pS0[10], pS0[11]); mb = max3f(mb, pS0[12], pS0[13]); ma = max3f(ma, pS0[14], pS0[15]); mb = max3f(mb, pS1[0], pS1[1]); ATT_PIN2(ma, mb); SBAR();
            ATT_PVK1(la, ha, 0, 2); SBAR();
            if (dma) ATT_DMAP(2, t + 3, prv);
            ma = max3f(ma, pS1[2], pS1[3]); mb = max3f(mb, pS1[4], pS1[5]); ma = max3f(ma, pS1[6], pS1[7]); mb = max3f(mb, pS1[8], pS1[9]); ATT_PIN2(ma, mb); SBAR();
            ATT_PVK1(la, ha, 0, 3); SBAR();
            ATT_RDVK(la, ha, 2);
            if (dma) ATT_DMAP(3, t + 3, prv);
            ma = max3f(ma, pS1[10], pS1[11]); mb = max3f(mb, pS1[12], pS1[13]); ma = max3f(ma, pS1[14], pS1[15]); ma = max2f(ma, mb);
            float rm; { auto rr = __builtin_amdgcn_permlane32_swap(__float_as_uint(ma), __float_as_uint(ma), false, false); rm = max2f(__uint_as_float(rr[0]), __uint_as_float(rr[1])); }
            bool resc = false;
            if (__any(rm > THR)) {
                const float dl = fmaxf(rm, 0.f); mrun += dl;
#pragma unroll
                for (int r = 0; r < 16; ++r) { pS0[r] -= dl; pS1[r] -= dl; }
                const float f = fexp2(-dl); l_reg *= f; if (hi == 0) wsf[r32] = f; resc = true;
            }
            float sacc = 0.f;
            ATT_WAITV(8, lb, hb); SBAR();
            ATT_PVK1(lb, hb, 1, 0); SBAR(); ATT_SOFT(0); ATT_PIN1(sacc); SBAR();
            ATT_PVK1(lb, hb, 1, 1); SBAR(); ATT_SOFT(1); ATT_PIN1(sacc); SBAR();
            ATT_PVK1(lb, hb, 1, 2); SBAR(); ATT_SOFT(2); ATT_PIN1(sacc); SBAR();
            ATT_PVK1(lb, hb, 1, 3); SBAR(); ATT_RDVK(lb, hb, 3); ATT_SOFT(3); ATT_PIN1(sacc); SBAR();
            ATT_WAITV(8, la, ha); SBAR();
            ATT_PVK1(la, ha, 2, 0); SBAR(); ATT_SOFT(4); ATT_PIN1(sacc); SBAR();
            ATT_PVK1(la, ha, 2, 1); SBAR(); ATT_SOFT(5); ATT_PIN1(sacc); SBAR();
            ATT_PVK1(la, ha, 2, 2); SBAR(); ATT_SOFT(6); ATT_PIN1(sacc); SBAR();
            ATT_PVK1(la, ha, 2, 3); SBAR(); ATT_SOFT(7); ATT_PIN1(sacc); SBAR();
            ATT_WAITV(0, lb, hb); SBAR();
            ATT_PVK1(lb, hb, 3, 0); SBAR(); ATT_SOFT(8); ATT_PIN1(sacc); SBAR();
            ATT_PVK1(lb, hb, 3, 1); SBAR(); ATT_SOFT(9); ATT_PIN1(sacc); SBAR();
            ATT_PVK1(lb, hb, 3, 2); SBAR(); ATT_SOFT(10); ATT_PIN1(sacc); SBAR();
            ATT_PVK1(lb, hb, 3, 3); SBAR();
            l_reg += sacc;
            ATT_PACK();
            ATT_PIN2(pw[0], pw[1]); ATT_PIN2(pw[2], pw[3]);
            if (resc) { LDS_WAIT();
#pragma unroll
                for (int r = 0; r < 16; ++r) { const float f = wsf[crow(r, hi)];
#pragma unroll
                    for (int d = 0; d < 4; ++d) o[d][r] *= f; } }
        } else if (t <= my_last) {
            const int vb = vb0 + cur;
            s16x4 la[4], ha[4], lb[4], hb[4];
            ATT_RDVK(la, ha, 0); ATT_RDVK(lb, hb, 1);
            ATT_WAITV(8, la, ha); SBAR();
            ATT_PVK1(la, ha, 0, 0); ATT_PVK1(la, ha, 0, 1); ATT_PVK1(la, ha, 0, 2); ATT_PVK1(la, ha, 0, 3); SBAR();
            ATT_RDVK(la, ha, 2);
            ATT_WAITV(8, lb, hb); SBAR();
            ATT_PVK1(lb, hb, 1, 0); ATT_PVK1(lb, hb, 1, 1); ATT_PVK1(lb, hb, 1, 2); ATT_PVK1(lb, hb, 1, 3); SBAR();
            ATT_RDVK(lb, hb, 3);
            ATT_WAITV(8, la, ha); SBAR();
            ATT_PVK1(la, ha, 2, 0); ATT_PVK1(la, ha, 2, 1); ATT_PVK1(la, ha, 2, 2); ATT_PVK1(la, ha, 2, 3); SBAR();
            ATT_WAITV(0, lb, hb); SBAR();
            ATT_PVK1(lb, hb, 3, 0); ATT_PVK1(lb, hb, 3, 1); ATT_PVK1(lb, hb, 3, 2); ATT_PVK1(lb, hb, 3, 3);
        }
        if (t + 3 < NT) ATT_WAIT_BAR(4); else ATT_WAIT_BAR(0);
        prv = cur; cur = nx1;
    }
#undef ATT_WAITV
#undef ATT_WAITK
#undef ATT_PIN1
#undef ATT_PIN2
#undef ATT_QK
#undef ATT_RDVK
#undef ATT_PK
#undef ATT_PVK1
#undef ATT_KRD
#undef ATT_SOFT
#undef ATT_PACK
    { auto rr = __builtin_amdgcn_permlane32_swap(__float_as_uint(l_reg), __float_as_uint(l_reg), false, false); l_reg = __uint_as_float(rr[0]) + __uint_as_float(rr[1]); }
    if (hi == 0) wsf[32 + r32] = l_reg;
    LDS_WAIT();
    float rli[16];
#pragma unroll
    for (int r = 0; r < 16; ++r) rli[r] = frcp(wsf[32 + crow(r, hi)]);
    float* stg = (float*)shm + wq * 4096;
    if (sub == 1) {
#pragma unroll
        for (int r = 0; r < 16; ++r) { const int orow = crow(r, hi);
#pragma unroll
            for (int d = 0; d < 4; ++d) stg[orow * 128 + d * 32 + r32] = o[d][r] * rli[r]; }
    }
    ATT_WAIT_BAR(0);
    if (sub == 0) {
#pragma unroll
        for (int r = 0; r < 16; ++r) { const int orow = crow(r, hi);
#pragma unroll
            for (int d = 0; d < 4; ++d) { const float v = o[d][r] * rli[r] - lam * stg[orow * 128 + d * 32 + r32]; stg[orow * 128 + d * 32 + r32] = v; } }
        LDS_WAIT();
        const int c8 = (lane & 15) * 8;
        const f32x4 g0 = *(const f32x4*)(subln_g + c8), g1 = *(const f32x4*)(subln_g + c8 + 4);
        bf16* Ow = CAT + (rowbase + q0 + wq * 32) * DM + h * 128 + c8;
#pragma unroll
        for (int i = 0; i < 8; ++i) { const int row = i * 4 + (lane >> 4);
            const f32x4 a = *(const f32x4*)(stg + row * 128 + c8), c = *(const f32x4*)(stg + row * 128 + c8 + 4);
            float ss = (a[0] * a[0] + a[1] * a[1]) + (a[2] * a[2] + a[3] * a[3]) + (c[0] * c[0] + c[1] * c[1]) + (c[2] * c[2] + c[3] * c[3]);
            ss = row16_sum(ss);
            const float sc = (1.0f - LAM_INIT) * __builtin_amdgcn_rsqf(ss * (1.0f / 128.0f) + RMS_EPS);
            v4u w; w.x = cvtpk(a[0] * sc * g0[0], a[1] * sc * g0[1]); w.y = cvtpk(a[2] * sc * g0[2], a[3] * sc * g0[3]);
            w.z = cvtpk(c[0] * sc * g1[0], c[1] * sc * g1[1]); w.w = cvtpk(c[2] * sc * g1[2], c[3] * sc * g1[3]);
            __builtin_nontemporal_store(w, (v4u*)(Ow + (long)row * DM)); }
    }
    ATT_BAR_L();
#undef ATT_DMA
#undef ATT_DMAP
}
#undef SBAR
}

#define XB_TMO      128
#define XB_XCNT(j)  (256  + 64 * (j))
#define XB_XSUB(j)  (1280 + 64 * (j))
#define XB_XGEN(j)  (2304 + 64 * (j))
#define XB_TOP      3328
#define XB_TOPGEN   3392
#define XCD_BAR_WORDS 3456
#define XB_SPIN_CAP (1u << 18)
__device__ __forceinline__ unsigned xb_ld(unsigned* p)              { return __hip_atomic_load(p, __ATOMIC_RELAXED, __HIP_MEMORY_SCOPE_AGENT); }
__device__ __forceinline__ unsigned xb_add(unsigned* p, unsigned v) { return __hip_atomic_fetch_add(p, v, __ATOMIC_RELAXED, __HIP_MEMORY_SCOPE_AGENT); }
__device__ __forceinline__ unsigned xb_xcc_id() { return (unsigned)__builtin_amdgcn_s_getreg((3 << 11) | 20) & 0xFu; }
#define XB_SPIN(cond, bar) do { unsigned _sp = 0; while (cond) { __builtin_amdgcn_s_sleep(1); \
    if ((++_sp & 255u) == 0u) { if (xb_ld(&(bar)[XB_TMO])) break; if (_sp > XB_SPIN_CAP) { atomicAdd(&(bar)[XB_TMO], 1u); break; } } } } while (0)
struct XcdBarrier { unsigned* bar; unsigned x; volatile LAS unsigned* st; };
__device__ __forceinline__ XcdBarrier xcd_barrier_post(unsigned* bar, volatile LAS unsigned* st) {
    XcdBarrier b; b.bar = bar; b.x = xb_xcc_id(); b.st = st;
    if (threadIdx.x == 0) (void)xb_add(&bar[XB_XCNT(b.x)], 1u);
    return b;
}
__device__ __forceinline__ void xcd_barrier_complete(unsigned* bar, unsigned x, unsigned& nloc, unsigned& nx) {
    const unsigned G = gridDim.x * gridDim.y * gridDim.z;
    unsigned sum, cnt, mine, sp = 0u;
    for (;;) {
        sum = 0u; cnt = 0u; mine = 0u;
#pragma unroll
        for (unsigned j = 0; j < 16; ++j) { const unsigned c = xb_ld(&bar[XB_XCNT(j)]); sum += c; cnt += (c > 0u) ? 1u : 0u; mine = (j == x) ? c : mine; }
        if (sum == G) break;
        __builtin_amdgcn_s_sleep(1);
        if ((++sp & 255u) == 0u) { if (xb_ld(&bar[XB_TMO])) break; if (sp > XB_SPIN_CAP) { atomicAdd(&bar[XB_TMO], 1u); break; } }
    }
    nloc = mine > 0u ? mine : 1u; nx = cnt > 0u ? cnt : 1u;
}
__device__ __forceinline__ void xcd_barrier_t0(const XcdBarrier& b) {
    if (threadIdx.x == 0) {
        unsigned* bar = b.bar;
        __builtin_amdgcn_s_waitcnt(0);
        unsigned nloc = b.st[0], nx = b.st[1];
        if (nloc == 0u) { xcd_barrier_complete(bar, b.x, nloc, nx); b.st[0] = nloc; b.st[1] = nx; }
        const unsigned old = xb_add(&bar[XB_XSUB(b.x)], 1u);
        const unsigned gen = old / nloc;
        if (old + 1u == (gen + 1u) * nloc) {
            __builtin_amdgcn_fence(__ATOMIC_RELEASE, "agent");
            asm volatile("s_waitcnt vmcnt(0)" ::: "memory");
            const unsigned og = xb_add(&bar[XB_TOP], 1u);
            const unsigned tg = og / nx;
            if (og + 1u != (tg + 1u) * nx) XB_SPIN(xb_ld(&bar[XB_TOP]) < (tg + 1u) * nx, bar);
            __builtin_amdgcn_fence(__ATOMIC_ACQUIRE, "agent");
            xb_add(&bar[XB_XGEN(b.x)], 1u);
            asm volatile("s_waitcnt vmcnt(0)" ::: "memory");
        } else {
            XB_SPIN(xb_ld(&bar[XB_XGEN(b.x)]) <= gen, bar);
            __builtin_amdgcn_fence(__ATOMIC_ACQUIRE, "agent");
            asm volatile("s_waitcnt vmcnt(0)" ::: "memory");
        }
    }
}
__device__ __forceinline__ void xcd_barrier_arrive_t0(const XcdBarrier& b) {
    if (threadIdx.x == 0) {
        unsigned* bar = b.bar;
        __builtin_amdgcn_s_waitcnt(0);
        unsigned nloc = b.st[0], nx = b.st[1];
        if (nloc == 0u) { xcd_barrier_complete(bar, b.x, nloc, nx); b.st[0] = nloc; b.st[1] = nx; }
        const unsigned old = xb_add(&bar[XB_XSUB(b.x)], 1u);
        const unsigned gen = old / nloc; unsigned lead = 0u;
        if (old + 1u == (gen + 1u) * nloc) {
            __builtin_amdgcn_fence(__ATOMIC_RELEASE, "agent");
            asm volatile("s_waitcnt vmcnt(0)" ::: "memory");
            (void)xb_add(&bar[XB_TOP], 1u); lead = 1u;
            asm volatile("s_waitcnt vmcnt(0)" ::: "memory");
        }
        b.st[2] = gen; b.st[3] = lead;
    }
}
__device__ __forceinline__ void xcd_barrier_wait_t0(const XcdBarrier& b) {
    if (threadIdx.x == 0) {
        unsigned* bar = b.bar;
        const unsigned nx = b.st[1], gen = b.st[2], lead = b.st[3];
        { unsigned sp_ = 0; while (xb_ld(&bar[XB_TOP]) < (gen + 1u) * nx) { __builtin_amdgcn_s_sleep(16);
            if ((++sp_ & 63u) == 0u) { if (xb_ld(&bar[XB_TMO])) break; if (sp_ > XB_SPIN_CAP) { atomicAdd(&bar[XB_TMO], 1u); break; } } } }
        __builtin_amdgcn_fence(__ATOMIC_ACQUIRE, "agent");
        if (lead) (void)xb_add(&bar[XB_XGEN(b.x)], 1u);
        asm volatile("s_waitcnt vmcnt(0)" ::: "memory");
    }
}
__device__ __forceinline__ void xcd_barrier(const XcdBarrier& b) {
    asm volatile("s_waitcnt vmcnt(0)" ::: "memory");
    __syncthreads();
    xcd_barrier_t0(b);
    __syncthreads();
}

constexpr int NWAVES = 8;
constexpr int NPHASES = 11;
struct Args { const void* in[27]; float* out; unsigned char* ws; int ph_lo, ph_hi, li, pad; };

struct Frame {
    LAS unsigned char* lds; unsigned char* ws; int tid, lane, wave, G, bid;
};

__device__ __forceinline__ void p0_transpose_tile(const float* W, int K, int N, bf16* WT, int row_off, int rmul, LAS float* scr, int tile, int tid) {
    const int nnb = N / 512, kb = tile / nnb, nb = tile % nnb, k0 = 64 * kb, n0 = 512 * nb;
    const int c4 = tid & 127, rr = tid >> 7;
    f32x4 v[16];
#pragma unroll
    for (int i = 0; i < 16; ++i) v[i] = __builtin_nontemporal_load((const GAS f32x4*)(W + (size_t)(k0 + 4 * i + rr) * N + n0 + 4 * c4));
#pragma unroll
    for (int i = 0; i < 16; ++i) { const int k = 4 * i + rr; *(LAS f32x4*)(scr + k * 512 + ((4 * c4) ^ (4 * ((k >> 3) & 7)))) = v[i]; }
    __syncthreads();
    const int c = tid & 7, dn = tid >> 3;
#pragma unroll
    for (int j = 0; j < 8; ++j) { const int n = 64 * j + dn; const LAS float* sp = scr + (8 * c) * 512 + (n ^ (4 * c));
        v4u o; o.x = cvtpk(sp[0 * 512], sp[1 * 512]); o.y = cvtpk(sp[2 * 512], sp[3 * 512]); o.z = cvtpk(sp[4 * 512], sp[5 * 512]); o.w = cvtpk(sp[6 * 512], sp[7 * 512]);
        __builtin_nontemporal_store(o, (GAS v4u*)(WT + (size_t)(row_off + rmul * (n0 + n)) * K + k0 + 8 * c)); }
    __syncthreads();
}

__device__ __forceinline__ void p0_ssm_job(Frame& F, const Args& a, int job) {
    const int g = job >> 3, i = job & 7, tid = F.tid;
    const float* a_re = (const float*)a.in[7]; const float* a_im = (const float*)a.in[8]; const float* log_dt = (const float*)a.in[9];
    const float* b_re = (const float*)a.in[10]; const float* b_im = (const float*)a.in[11]; const float* c_re = (const float*)a.in[12]; const float* c_im = (const float*)a.in[13];
    LAS float* PW = (LAS float*)(F.lds);
    LAS float* BB = (LAS float*)(F.lds + 33280);
    LAS float* CC = (LAS float*)(F.lds + 41472);
    LAS bf16* KT = (LAS bf16*)(F.lds + 49664);
    LAS float* FF = (LAS float*)(F.lds + 51712);
    float bre[2], bim[2];
#pragma unroll
    for (int k = 0; k < 2; ++k) { bre[k] = b_re[g * 1024 + tid + 512 * k]; bim[k] = b_im[g * 1024 + tid + 512 * k]; }
    if (tid < 64) {
        const int p = tid; const float are = a_re[g * 64 + p], aim = a_im[g * 64 + p]; const float dt = expf(log_dt[g]);
        const float mag = expf(are * dt), th = aim * dt; const float lr = mag * cosf(th), li = mag * sinf(th);
        float pr = 1.0f, pi = 0.0f;
        for (int j = 0; j <= 32; ++j) { PW[(j * 64 + p) * 2] = pr; PW[(j * 64 + p) * 2 + 1] = pi; const float nr = pr * lr - pi * li, ni = pr * li + pi * lr; pr = nr; pi = ni; }
        const float den = are * are + aim * aim; const float nr_ = lr - 1.0f, ni_ = li;
        const float fr_ = (nr_ * are + ni_ * aim) / den, fi_ = (ni_ * are - nr_ * aim) / den;
        FF[p * 2] = fr_; FF[p * 2 + 1] = fi_;
    }
    for (int e = tid; e < 1024; e += 512) { CC[e * 2] = c_re[g * 1024 + e]; CC[e * 2 + 1] = c_im[g * 1024 + e]; }
    __syncthreads();
#pragma unroll
    for (int k = 0; k < 2; ++k) { const int q = tid + 512 * k; const float fr_ = FF[(q >> 4) * 2], fi_ = FF[(q >> 4) * 2 + 1];
        BB[q * 2] = fr_ * bre[k] - fi_ * bim[k]; BB[q * 2 + 1] = fr_ * bim[k] + fi_ * bre[k]; }
    __syncthreads();
    {
        const int ci = tid & 15, c2 = (tid >> 4) & 1, jq = tid >> 5, co = 2 * i + c2;
        float acc[2] = {0.f, 0.f};
        for (int p = 0; p < 64; ++p) { const float cr = CC[(co * 64 + p) * 2], cim = CC[(co * 64 + p) * 2 + 1], br = BB[(p * 16 + ci) * 2], bi = BB[(p * 16 + ci) * 2 + 1];
            const float xr = cr * br - cim * bi, xi = cr * bi + cim * br;
#pragma unroll
            for (int q = 0; q < 2; ++q) { const int j = 2 * jq + q; acc[q] += xr * PW[(j * 64 + p) * 2] - xi * PW[(j * 64 + p) * 2 + 1]; } }
#pragma unroll
        for (int q = 0; q < 2; ++q) { const int j = 2 * jq + q; KT[(j * 2 + c2) * 16 + ci] = (bf16)(cvtpk(acc[q], 0.f) & 0xffffu); }
    }
    __syncthreads();
    bf16* toep = (bf16*)(F.ws + WS_TOEP) + (size_t)g * 1024 * UP_PITCH;
    for (int q = tid; q < 128 * 64; q += 512) { const int rl = q >> 6, chn = q & 63; const int t = rl >> 1, c2 = rl & 1, s = (t & 32) + (chn >> 1), half = chn & 1; const int n = t * 16 + 2 * i + c2;
        v4u w = (v4u){0u, 0u, 0u, 0u};
        if (t >= s) w = *(const LAS v4u*)(KT + ((t - s) * 2 + c2) * 16 + half * 8);
        *(GAS v4u*)(toep + (size_t)n * UP_PITCH + s * 16 + half * 8) = w; }
    for (int q = tid; q < 128 * 64; q += 512) { const int rl = q >> 6, p = q & 63; const int t = rl >> 1, c2 = rl & 1, co = 2 * i + c2; const int n = t * 16 + co; const int j = (t & 31) + 1;
        const float cr = CC[(co * 64 + p) * 2], cim = CC[(co * 64 + p) * 2 + 1], wr_ = PW[(j * 64 + p) * 2], wi_ = PW[(j * 64 + p) * 2 + 1];
        const float re = cr * wr_ - cim * wi_, im = cr * wi_ + cim * wr_;
        bf16* d = toep + (size_t)n * UP_PITCH + 1024 + 128 * (t >> 5) + p;
        d[0] = (bf16)(cvtpk(re, 0.f) & 0xffffu); d[64] = (bf16)(cvtpk(-im, 0.f) & 0xffffu); }
    bf16* wsin = (bf16*)(F.ws + WS_WSIN) + (size_t)g * 256 * 1024;
    for (int q = tid; q < 32 * 128; q += 512) { const int rl = q >> 7, k8 = (q & 127) * 8; const int pp = 32 * i + rl, p = pp & 63, s = k8 >> 4, ci0 = k8 & 15;
        float v[8];
#pragma unroll
        for (int c = 0; c < 8; ++c) v[c] = 0.f;
        if ((s >> 5) == (pp >> 7)) { const int j = 31 - (s & 31); const float wr_ = PW[(j * 64 + p) * 2], wi_ = PW[(j * 64 + p) * 2 + 1];
#pragma unroll
            for (int c = 0; c < 8; ++c) { const float br = BB[(p * 16 + ci0 + c) * 2], bi = BB[(p * 16 + ci0 + c) * 2 + 1]; v[c] = ((pp & 64) == 0) ? (wr_ * br - wi_ * bi) : (wr_ * bi + wi_ * br); } }
        *(GAS v4u*)(wsin + (size_t)pp * 1024 + k8) = (v4u){cvtpk(v[0], v[1]), cvtpk(v[2], v[3]), cvtpk(v[4], v[5]), cvtpk(v[6], v[7])}; }
    if (i == 0 && tid < 64) { float* lamb = (float*)(F.ws + WS_LAMB) + (g * 64 + tid) * 2; lamb[0] = PW[(32 * 64 + tid) * 2]; lamb[1] = PW[(32 * 64 + tid) * 2 + 1]; }
    __syncthreads();
}

__device__ __forceinline__ void p0_prologue(Frame& F, const Args& a) {
    LAS float* scr = (LAS float*)(F.lds);
    const float* w_in = (const float*)a.in[1]; const float* w_glu = (const float*)a.in[15]; const float* w_out = (const float*)a.in[17];
    constexpr int I_IN = 16 * 4, I_GLU = 8 * 1, I_OUT = 16 * 2;
    constexpr int NTILES = I_IN + I_GLU + I_OUT;
    const float* x = (const float*)a.in[0]; bf16* xb = (bf16*)(F.ws + WS_XB);
    constexpr int NTAB8 = 3;
    const bool split = F.G >= 2, fine = (F.G % 64) == 0;
    const int grp = (F.bid >> 3) & 7;
    const bool r_tab = !split || (fine ? grp < NTAB8 : (F.bid & 1) == 0), r_x = !split || !(fine ? grp < NTAB8 : (F.bid & 1) == 0);
    const int ntab = !split ? 1 : fine ? (F.G / 64) * NTAB8 * 8 : (F.G + 1) / 2, nxw = !split ? 1 : fine ? (F.G / 64) * (8 - NTAB8) * 8 : F.G / 2;
    const int me = !split ? 0 : !fine ? (F.bid >> 1) : r_tab ? (F.bid >> 6) * NTAB8 * 8 + grp * 8 + (F.bid & 7) : (F.bid >> 6) * (8 - NTAB8) * 8 + (grp - NTAB8) * 8 + (F.bid & 7);
    if (r_tab) {
#pragma unroll 1
        for (int job = me; job < 256; job += ntab) p0_ssm_job(F, a, job);
    }
    if (r_x) {
        for (int it = me; it < NTILES; it += nxw) {
            int r = it;
            if (r < I_IN) { p0_transpose_tile(w_in, 1024, 2048, (bf16*)(F.ws + WS_WIN_T), 0, 1, scr, r, F.tid); continue; } r -= I_IN;
            if (r < I_GLU) { p0_transpose_tile(w_glu, 512, 512, (bf16*)(F.ws + WS_WGLU_T), 0, 1, scr, r, F.tid); continue; } r -= I_GLU;
            p0_transpose_tile(w_out, 1024, 1024, (bf16*)(F.ws + WS_WOUT_T), 0, 1, scr, r, F.tid);
        }
        const int gw = me * NWAVES + F.wave, NGW = nxw * NWAVES;
        for (int m = gw; m < TOK / 4; m += NGW) {
            const GAS f32x4* xr = (const GAS f32x4*)(x + (size_t)m * 4 * DM) + F.lane; GAS v4u* o16 = (GAS v4u*)(xb + (size_t)m * 4 * DM);
            f32x4 v[16];
#pragma unroll
            for (int j = 0; j < 16; ++j) v[j] = __builtin_nontemporal_load(xr + 64 * j);
            const bool odd = (F.lane & 1) != 0; const int pr = F.lane >> 1;
#pragma unroll
            for (int p2 = 0; p2 < 8; ++p2) {
                const unsigned a0 = cvtpk(v[2 * p2][0], v[2 * p2][1]), a1 = cvtpk(v[2 * p2][2], v[2 * p2][3]), b0 = cvtpk(v[2 * p2 + 1][0], v[2 * p2 + 1][1]), b1 = cvtpk(v[2 * p2 + 1][2], v[2 * p2 + 1][3]);
                const unsigned s0 = odd ? a0 : b0, s1 = odd ? a1 : b1;
                const unsigned r0 = __builtin_amdgcn_update_dpp(0u, s0, 0xB1, 0xf, 0xf, true), r1 = __builtin_amdgcn_update_dpp(0u, s1, 0xB1, 0xf, 0xf, true);
                const v4u w = odd ? (v4u){r0, r1, b0, b1} : (v4u){a0, a1, r0, r1};
                o16[32 * (2 * p2 + (odd ? 1 : 0)) + pr] = w; }
        }
    }
}

__device__ __forceinline__ void moe_tiles_slice(Frame& F, const Args& a, int third) {
    const float* wg = (const float*)a.in[22]; const float* wu = (const float*)a.in[23]; const float* wd = (const float*)a.in[24]; LAS float* scr = (LAS float*)(F.lds);
    constexpr int NGU = NEXP * 32, NDN = NEXP * 16;
    int tid = threadIdx.x; asm volatile("" : "+v"(tid));
    const int ngu = F.bid < NGU ? (NGU - 1 - F.bid) / F.G + 1 : 0, ndn = F.bid < NDN ? (NDN - 1 - F.bid) / F.G + 1 : 0, tot = ngu + ndn;
    const int lo = tot * third / 3, hi = tot * (third + 1) / 3;
#pragma unroll 1
    for (int n = lo; n < hi; ++n) {
        if (n < ngu) { const int it = F.bid + n * F.G; const int e = it >> 5, r = it & 31;
            p0_transpose_tile((r < 16 ? wg : wu) + (size_t)e * 1024 * 512, 1024, 512, (bf16*)(F.ws + WS_WG1) + (size_t)e * 1024 * 1024, r < 16 ? 0 : 1, 2, scr, r & 15, tid); }
        else { const int it = F.bid + (n - ngu) * F.G; const int e = it >> 4, r = it & 15;
            p0_transpose_tile(wd + (size_t)e * 512 * 1024, 512, 1024, (bf16*)(F.ws + WS_WD) + (size_t)e * 1024 * 512, 0, 1, scr, r, tid); }
    }
}

__device__ __forceinline__ void p3_scan(Frame& F, const float* sstate, int g, int pm) {
    const int tid = F.tid, lane = F.lane, wave = F.wave;
    const unsigned lds0 = (unsigned)(uintptr_t)(F.lds);
    LAS float* SB = (LAS float*)F.lds;
    LAS bf16* HS = (LAS bf16*)(F.lds + 98304);
    const float* ss = sstate + (size_t)(g * 512 + 4 * pm * 64) * 256;
    bf16* up = (bf16*)(F.ws + WS_UPERM) + (size_t)(g * 512 + 4 * pm * 64) * UP_PITCH + 1024;
#define P3_DMA(k, buf) do { _Pragma("unroll") for (int q_ = 0; q_ < 8; ++q_) { const int r_ = 8 * wave + q_; \
        att::glds16(ss + (size_t)((r_ >> 3) * 64 + 8 * (k) + (r_ & 7)) * 256 + lane * 4, (unsigned)__builtin_amdgcn_readfirstlane(lds0 + (buf) * 32768 + r_ * 1024)); } } while (0)
    if (wave < 4) {
        const int bb = tid >> 6, p = tid & 63;
        const float* lamb = (const float*)(F.ws + WS_LAMB) + (g * 64 + p) * 2; const float lr = lamb[0], li = lamb[1];
        asm volatile("s_waitcnt vmcnt(0)" :: "v"(lr), "v"(li) : "memory");
        float hr = 0.f, hi_ = 0.f;
        P3_DMA(0, 0); P3_DMA(1, 1);
        int buf = 0;
        for (int k = 0; k < 8; ++k) {
            if (k < 7) asm volatile("s_waitcnt vmcnt(8) lgkmcnt(0)\n\ts_barrier" ::: "memory"); else asm volatile("s_waitcnt vmcnt(0) lgkmcnt(0)\n\ts_barrier" ::: "memory");
            if (k + 2 < 8) { const int b2 = (buf >= 1) ? buf - 1 : buf + 2; P3_DMA(k + 2, b2); }
            const LAS float* sb = SB + buf * 8192 + bb * 8 * 256 + p; LAS bf16* hs = HS + (k & 1) * 8192 + bb * 8 * 256 + p;
#pragma unroll
            for (int j = 0; j < 8; ++j) { const float s0r = sb[j * 256], s0i = sb[j * 256 + 64], s1r = sb[j * 256 + 128], s1i = sb[j * 256 + 192];
                hs[j * 256] = (bf16)(cvtpk(hr, 0.f) & 0xffffu); hs[j * 256 + 64] = (bf16)(cvtpk(hi_, 0.f) & 0xffffu);
                float nr = lr * hr - li * hi_ + s0r, ni = lr * hi_ + li * hr + s0i; hr = nr; hi_ = ni;
                hs[j * 256 + 128] = (bf16)(cvtpk(hr, 0.f) & 0xffffu); hs[j * 256 + 192] = (bf16)(cvtpk(hi_, 0.f) & 0xffffu);
                nr = lr * hr - li * hi_ + s1r; ni = lr * hi_ + li * hr + s1i; hr = nr; hi_ = ni; }
            asm volatile("s_waitcnt lgkmcnt(0)\n\ts_barrier" ::: "memory");
            buf = (buf == 2) ? 0 : buf + 1;
        }
    } else {
        const int t2 = tid - 256;
        for (int k = 0; k < 8; ++k) {
            asm volatile("s_waitcnt lgkmcnt(0)\n\ts_barrier" ::: "memory");
            asm volatile("s_waitcnt lgkmcnt(0)\n\ts_barrier" ::: "memory");
#pragma unroll
            for (int q = 0; q < 4; ++q) { const int idx = t2 + 256 * q; const int r = idx >> 5, ch = idx & 31;
                const v4u w = *(const LAS v4u*)(HS + (k & 1) * 8192 + r * 256 + ch * 8);
                *(GAS v4u*)(up + (size_t)((r >> 3) * 64 + 8 * k + (r & 7)) * UP_PITCH + ch * 8) = w; }
        }
    }
#undef P3_DMA
    VM_WAIT(); LDS_WAIT(); __syncthreads();
}

__device__ __forceinline__ void p6_job(Frame& F, const Args& a, int job) {
    const int tid = F.tid, lane = F.lane, wave = F.wave;
    LAS _Float16* WR = (LAS _Float16*)F.lds;
    LAS float* LG = (LAS float*)(F.lds + 99072) + wave * 768;
    LAS int* SLE = (LAS int*)(F.lds + 99072 + 24576);
    LAS float* SLW = (LAS float*)(F.lds + 99072 + 24576 + 1024);
    LAS int* LCNT = (LAS int*)(F.lds + 99072 + 24576 + 2048);
    LAS int* LBASE = LCNT + 32; LAS int* LRANK = LCNT + 64;
    const bf16* pre = (const bf16*)(F.ws + WS_PREB); const f32x2* stats = (const f32x2*)(F.ws + WS_STATS);
    const float* g1 = (const float*)a.in[18]; const float* b1 = (const float*)a.in[19];
    bf16* hb = (bf16*)(F.ws + WS_HB);
    if (tid < 32) LCNT[tid] = 0;
    const int r0 = job * 128 + wave * 16; const int row = r0 + (lane & 15), kg = lane >> 4;
    float mean, rstd;
    { const f32x4* sp = (const f32x4*)(stats + (size_t)row * 16); float ms = 0.f; f32x4 q[8];
#pragma unroll
        for (int j = 0; j < 8; ++j) { q[j] = sp[j]; ms += q[j][0] + q[j][2]; }
        mean = ms * (1.0f / 16.0f); float m2 = 0.f;
#pragma unroll
        for (int j = 0; j < 8; ++j) { const float d0 = q[j][0] - mean, d1 = q[j][2] - mean; m2 += q[j][1] + q[j][3] + 64.0f * (d0 * d0 + d1 * d1); }
        rstd = 1.0f / sqrtf(m2 * (1.0f / 1024.0f) + LN_EPS); }
    f32x4 acc[3] = {(f32x4){0.f, 0.f, 0.f, 0.f}, (f32x4){0.f, 0.f, 0.f, 0.f}, (f32x4){0.f, 0.f, 0.f, 0.f}};
    const LAS float* GL = (const LAS float*)(F.lds + LDSCTL_OFF + 4096);
    v4u xq[8];
#pragma unroll
    for (int j = 0; j < 8; ++j) xq[j] = __builtin_nontemporal_load((const v4u*)(pre + (size_t)row * DM + j * 32 + kg * 8));
#pragma unroll 1
    for (int kb = 0; kb < 4; ++kb) {
#pragma unroll
        for (int j = 0; j < 8; ++j) {
            const int ks = kb * 8 + j; const int col = ks * 32 + kg * 8;
            const v4u xw = xq[j];
            if (kb < 3) xq[j] = __builtin_nontemporal_load((const v4u*)(pre + (size_t)row * DM + col + 256));
            const f32x4 x0 = (f32x4){bf_lo(xw.x), bf_hi(xw.x), bf_lo(xw.y), bf_hi(xw.y)}, x1 = (f32x4){bf_lo(xw.z), bf_hi(xw.z), bf_lo(xw.w), bf_hi(xw.w)};
            const f32x4 ga = *(const LAS f32x4*)(GL + col), gb = *(const LAS f32x4*)(GL + col + 4), ba = *(const LAS f32x4*)(GL + 1024 + col), bb = *(const LAS f32x4*)(GL + 1024 + col + 4);
            const f32x4 h0 = (x0 - mean) * rstd * ga + ba, h1 = (x1 - mean) * rstd * gb + bb;
            v4u w; w.x = cvtpk(h0[0], h0[1]); w.y = cvtpk(h0[2], h0[3]); w.z = cvtpk(h1[0], h1[1]); w.w = cvtpk(h1[2], h1[3]);
            *(v4u*)(hb + (size_t)row * DM + col) = w;
            f16x8 af; af[0] = (_Float16)h0[0]; af[1] = (_Float16)h0[1]; af[2] = (_Float16)h0[2]; af[3] = (_Float16)h0[3]; af[4] = (_Float16)h1[0]; af[5] = (_Float16)h1[1]; af[6] = (_Float16)h1[2]; af[7] = (_Float16)h1[3];
#pragma unroll
            for (int ntile = 0; ntile < 3; ++ntile) { const f16x8 bf = *(const LAS f16x8*)(WR + (ntile * 16 + (lane & 15)) * 1032 + col);
                acc[ntile] = __builtin_amdgcn_mfma_f32_16x16x32_f16(af, bf, acc[ntile], 0, 0, 0); }
        }
    }
#pragma unroll
    for (int ntile = 0; ntile < 3; ++ntile)
#pragma unroll
        for (int i = 0; i < 4; ++i) LG[(4 * kg + i) * 48 + ntile * 16 + (lane & 15)] = acc[ntile][i];
    LDS_WAIT(); asm volatile("" ::: "memory");
    if (lane < 16) {
        const LAS float* L = LG + lane * 48;
        float gm = L[0]; int gi = 0;
#pragma unroll
        for (int j = 1; j < 4; ++j) { const float v = L[j]; if (v > gm) { gm = v; gi = j; } }
        float gs = 0.f;
#pragma unroll
        for (int j = 0; j < 4; ++j) gs += __expf(L[j] - gm);
        const float gp = 1.0f / gs;
        float ev[8];
#pragma unroll
        for (int j = 0; j < 8; ++j) ev[j] = L[4 + gi * 8 + j];
        float m1 = ev[0]; int i1 = 0;
#pragma unroll
        for (int j = 1; j < 8; ++j) if (ev[j] > m1) { m1 = ev[j]; i1 = j; }
        float m2 = -INFINITY; int i2 = 0;
#pragma unroll
        for (int j = 0; j < 8; ++j) if (j != i1 && ev[j] > m2) { m2 = ev[j]; i2 = j; }
        const float ex = __expf(m2 - m1); const float w1 = 1.0f / (1.0f + ex), w2 = ex * w1;
        const int sl = (wave * 16 + lane) * 2;
        SLE[sl] = gi * 8 + i1; SLE[sl + 1] = gi * 8 + i2; SLW[sl] = gp * w1; SLW[sl + 1] = gp * w2;
    }
    __syncthreads();
    int e = 0;
    if (tid < 256) { e = SLE[tid]; LRANK[tid] = __hip_atomic_fetch_add(LCNT + e, 1, __ATOMIC_RELAXED, __HIP_MEMORY_SCOPE_WORKGROUP); }
    __syncthreads();
    if (tid < 32) LBASE[tid] = (int)__hip_atomic_fetch_add((gu32*)(F.ws + WS_CTL) + CW_GCNT + tid, (unsigned)LCNT[tid], RLX_AGENT);
    __syncthreads();
    if (tid < 256) { const int pos = LBASE[e] + LRANK[tid];
        ((int*)(F.ws + WS_ESLOT))[e * 65536 + pos] = job * 256 + tid; ((float*)(F.ws + WS_EW))[e * 65536 + pos] = SLW[tid]; }
    __syncthreads();
}

__device__ __forceinline__ int moe_layout(Frame& F, LAS int* pstart) {
    LAS int* tile_e = (LAS int*)(F.lds + TILE_E_OFF); LAS int* ecnt = pstart + 40;
    if (F.tid < 64) { const int e = F.tid & 31;
        const int c = (int)__hip_atomic_load((gu32*)(F.ws + WS_CTL) + CW_GCNT + e, RLX_AGENT); const int nf = c >> 8, hp = (c & 255) ? 1 : 0;
        int inf = nf, inp = hp;
#pragma unroll
        for (int o = 1; o < 32; o <<= 1) { const int v = __shfl_up(inf, o, 32), w = __shfl_up(inp, o, 32); if (e >= o) { inf += v; inp += w; } }
        const int totf = __shfl(inf, 31, 32), totp = __shfl(inp, 31, 32);
        if (F.tid < 32) { ecnt[e] = c; if (e == 0) pstart[32] = (totf + totp) << 8;
            const int sf = inf - nf; for (int t = 0; t < nf; ++t) tile_e[sf + t] = e | (t << 8);
            if (hp) tile_e[totf + inp - 1] = e | (nf << 8); } }
    __syncthreads();
    return pstart[NEXP] >> 8;
}

__global__ void __launch_bounds__(NWAVES * 64, 2) trunk_fwd(Args args) {
    extern __shared__ __attribute__((aligned(16))) unsigned char lds[];
    Frame F; F.lds = (LAS unsigned char*)lds; F.ws = args.ws; F.tid = threadIdx.x; F.lane = F.tid & 63; F.wave = __builtin_amdgcn_readfirstlane(F.tid >> 6); F.G = gridDim.x; F.bid = blockIdx.x;
    volatile LAS unsigned* MISC = (volatile LAS unsigned*)(F.lds + MISC_OFF);
    LAS int* PSTART = (LAS int*)(F.lds + LDSCTL_OFF);
    for (int u = F.tid; u < (LDS_BYTES - LDSCTL_OFF) / 4; u += NWAVES * 64) ((LAS unsigned*)(F.lds + LDSCTL_OFF))[u] = 0u;
    __syncthreads();
    gu32* ctl = (gu32*)(args.ws + WS_CTL);
    const int lo = args.ph_lo, hi = args.ph_hi;
    const bool multi = (hi - lo) > 1;
    XcdBarrier bar; bar.bar = (unsigned*)ctl + CW_BAR + args.li * XCD_BAR_WORDS; bar.x = 0; bar.st = nullptr;
    if (multi) bar = xcd_barrier_post((unsigned*)ctl + CW_BAR + args.li * XCD_BAR_WORDS, MISC + 8);
#define IN(k) (lo <= (k) && (k) < hi)
#define SEAM(k) do { if (IN(k) && IN((k) + 1)) xcd_barrier(bar); } while (0)
#define SEAM_OV(k, ...) do { if (IN(k) && IN((k) + 1)) { asm volatile("s_waitcnt vmcnt(0)" ::: "memory"); __syncthreads(); if (F.wave == 0) xcd_barrier_t0(bar); else { __VA_ARGS__ } __syncthreads(); } \
                              else if (IN((k) + 1)) { if (F.wave != 0) { __VA_ARGS__ } __syncthreads(); } } while (0)
    bf16* const XB = (bf16*)(args.ws + WS_XB); bf16* const PROJ = (bf16*)(args.ws + WS_PROJ); bf16* const UPERM = (bf16*)(args.ws + WS_UPERM);
    bf16* const ZB = (bf16*)(args.ws + WS_Z); bf16* const CAT = (bf16*)(args.ws + WS_CAT); bf16* const HB = (bf16*)(args.ws + WS_HB);
    bf16* const HID = (bf16*)(args.ws + WS_HID); bf16* const Y2 = (bf16*)(args.ws + WS_Y2); bf16* const PREB = (bf16*)(args.ws + WS_PREB);

    if (IN(0)) { p0_prologue(F, args); }
    SEAM(0);
    if (IN(1)) {
        pg8::DenseOrder S; S.init(XB, args.ws + WS_WIN_T, 1024, 1024, TOK, NPROJ, F.G, F.bid);
        pg8::EpiInProj E{PROJ, PROJ + (size_t)TOK * 512, PROJ + (size_t)TOK * 1024, UPERM};
        pg8::gemm_phase<pg8::EpiInProj, pg8::DenseOrder, true>(F.lds, 1024, 1024, 1024, S, E);
    }
    SEAM_OV(1, { if (F.wave == 1) {
        const float* lq1 = (const float*)args.in[2]; const float* lk1 = (const float*)args.in[3]; const float* lq2 = (const float*)args.in[4]; const float* lk2 = (const float*)args.in[5];
        const float s1 = wave_sum(lq1[F.lane] * lk1[F.lane]), s2 = wave_sum(lq2[F.lane] * lk2[F.lane]);
        if (F.lane == 0) MISC[22] = __float_as_uint(expf(s1) - expf(s2) + LAM_INIT); } });
    if (IN(2)) {
        for (int u = F.bid; u < 64; u += F.G) {
            const int g = u >> 1, pm = u & 1;
            pg8::OneUnit S; S.A = (const char*)(UPERM + (size_t)(g * 512 + pm * 256) * UP_PITCH); S.Bt = (const char*)((bf16*)(args.ws + WS_WSIN) + (size_t)g * 256 * 1024); S.u0 = pg8::Unit{pm, 0, g};
            pg8::EpiState E{args.out};
            pg8::gemm_phase<pg8::EpiState, pg8::OneUnit, true>(F.lds, 1024, UP_PITCH, 1024, S, E);
            p3_scan(F, args.out, g, pm);
            asm volatile("s_waitcnt vmcnt(0)" ::: "memory"); __syncthreads();
            if (F.tid == 0) { __builtin_amdgcn_fence(__ATOMIC_RELEASE, "agent"); asm volatile("s_waitcnt vmcnt(0)" ::: "memory");
                __hip_atomic_store(ctl + CW_SCANFLAG + u, 1u, RLX_AGENT); }
        }
        const float lam = __uint_as_float(MISC[22]);
        const int vcu = (F.G % 8 == 0) ? (F.bid % 8) * (F.G / 8) + F.bid / 8 : F.bid;
        const bool split3 = IN(3) && IN(4);
        bool ssm_pending = true;
        for (int v = vcu; v < 256; v += F.G) {
            const int xg = v >> 5, j = v & 31;
#pragma unroll 1
            for (int s5 = 0; s5 < 5; ++s5) {
                if (s5 == 3) {
                    if (ssm_pending) { ssm_pending = false;
                    for (int u = F.bid; u < 256; u += F.G) {
                        const int g = 4 * (u & 7) + (u >> 6), pm = (u >> 5) & 1, pn = (u >> 3) & 3;
                        if (F.tid == 0) { gu32* fw = ctl + CW_SCANFLAG + (g * 2 + pm); unsigned sp = 0;
                            while (__hip_atomic_load(fw, RLX_AGENT) == 0u) { __builtin_amdgcn_s_sleep(2); if (++sp > (1u << 22)) break; }
                            __builtin_amdgcn_fence(__ATOMIC_ACQUIRE, "agent"); asm volatile("s_waitcnt vmcnt(0)" ::: "memory"); }
                        __syncthreads();
                        pg8::SsmUnit S; S.A = (const char*)(UPERM + (size_t)(g * 512 + pm * 256) * UP_PITCH); S.Bt = (const char*)((bf16*)(args.ws + WS_TOEP) + (size_t)(g * 1024 + pn * 256) * UP_PITCH); S.u0 = pg8::Unit{pm, pn, g}; S.first = 8 * (pn >> 1); S.cnt = 4 * (pn & 1) + 4; S.st = 16 + 2 * (pn >> 1);
                        pg8::EpiSsmOut E{UPERM, (const float*)args.in[14], ZB};
                        pg8::gemm_phase<pg8::EpiSsmOut, pg8::SsmUnit, true>(F.lds, UP_PITCH, UP_PITCH, UP_PITCH, S, E);
                    }
                        if (split3) { asm volatile("s_waitcnt vmcnt(0)" ::: "memory"); __syncthreads(); xcd_barrier_arrive_t0(bar); }
                    }
                    continue;
                }
                const int i = s5 - (s5 > 3 ? 1 : 0); const int bh = xg * 4 + i; const int qb = ATT_QB[i][j];
                if (i > 0) moe_tiles_slice(F, args, i - 1);
                att::attn_unit(bh >> 2, bh & 3, qb, PROJ, CAT, (char*)lds, lam, (const float*)args.in[6]);
            }
        }
        if (split3) { __syncthreads(); xcd_barrier_wait_t0(bar); __syncthreads(); }
    }
    if (!IN(2)) SEAM(3);
    if (IN(4)) {
        pg8::EpiGlu E{ZB, (const float*)args.in[16], CAT};
        for (;;) {
            __syncthreads();
            if (F.tid == 0) MISC[13] = __hip_atomic_fetch_add(ctl + CW_P4Q, 1u, __ATOMIC_RELAXED, __HIP_MEMORY_SCOPE_AGENT);
            __syncthreads();
            const unsigned t4 = MISC[13];
            if (t4 >= (unsigned)((TOK / 256) * (SSMW / 256))) break;
            const int pm = (int)(t4 >> 1), pn = (int)(t4 & 1u);
            pg8::OneUnit S; S.A = (const char*)(ZB + (size_t)pm * 256 * 512); S.Bt = (const char*)((const bf16*)(args.ws + WS_WGLU_T) + (size_t)pn * 256 * 512); S.u0 = pg8::Unit{pm, pn, 0};
            pg8::gemm_phase<pg8::EpiGlu, pg8::OneUnit, true>(F.lds, 512, 512, 512, S, E);
        }
    }
    SEAM(4);
    if (IN(5)) {
        pg8::DenseOrder S; S.init(CAT, args.ws + WS_WOUT_T, 1024, 1024, TOK, DM, F.G, F.bid);
        pg8::EpiOutProj E{XB, PREB, (f32x2*)(args.ws + WS_STATS)};
        pg8::gemm_phase<pg8::EpiOutProj, pg8::DenseOrder, true>(F.lds, 1024, 1024, 1024, S, E);
    }
    SEAM_OV(5, {
            const int t1 = F.tid - 64;
            LAS _Float16* WR = (LAS _Float16*)F.lds; const float* wrg = (const float*)args.in[20]; const float* wre = (const float*)args.in[21];
            for (int q = t1; q < 1024 * 4; q += 448) { const int k = q >> 2, n = q & 3; WR[n * 1032 + k] = (_Float16)wrg[q]; }
            for (int q = t1; q < 1024 * 32; q += 448) { const int k = q >> 5, n = q & 31; WR[(4 + n) * 1032 + k] = (_Float16)wre[q]; }
            for (int q = t1; q < 12 * 1032; q += 448) WR[36 * 1032 + q] = (_Float16)0.f;
            LAS float* GL = (LAS float*)(F.lds + LDSCTL_OFF + 4096); const float* g1_ = (const float*)args.in[18]; const float* b1_ = (const float*)args.in[19];
            for (int q = t1; q < 1024; q += 448) { GL[q] = g1_[q]; GL[1024 + q] = b1_[q]; } });
    if (IN(6)) {
        for (int job = F.bid; job < 256; job += F.G) p6_job(F, args, job);
    }
    SEAM(6);
    if (IN(8)) {
        const int ntiles = moe_layout(F, PSTART);
        if (F.tid == 0) MISC[16] = (unsigned)ntiles;
        pg8::MoeOrder<true> S; S.A = (const char*)HB; S.W = (const char*)(args.ws + WS_WG1); S.eslot = (const int*)(args.ws + WS_ESLOT); S.tile_e = (const LAS int*)(F.lds + TILE_E_OFF); S.ecnt = PSTART + 40; S.ntiles = ntiles; S.G = F.G; S.c = F.bid; S.lda = 1024; S.ldb = 1024;
        { const int per = F.G >> 5, chunk = (ntiles + 7) >> 3; S.lt_lim = (chunk / per) * per; }
        {   LAS int* TOKR = (LAS int*)(F.lds + LDSCTL_OFF + 4096); LAS int* PRE_TILE = (LAS int*)(F.lds + LDSCTL_OFF + 3968);
            for (int q = F.tid; q < 6 * 256; q += NWAVES * 64) { const int i = q >> 8, row = q & 255; pg8::Unit u;
                if (S.next(i, u)) { const int e = u.aux & 255, idx = (u.aux >> 8) * 256 + row; TOKR[q] = (idx < S.ecnt[e]) ? (S.eslot[e * 65536 + idx] >> 1) : 0; } }
            if (F.tid < 8) { pg8::Unit u; PRE_TILE[F.tid] = (F.tid < 6 && S.next(F.tid, u)) ? u.pm : -1; }
            __syncthreads();
            S.tokr = TOKR; S.pre_tile = PRE_TILE; }
        pg8::EpiMoe1 E{HID};
        pg8::gemm_phase<pg8::EpiMoe1, pg8::MoeOrder<true>, true>(F.lds, 1024, 1024, 1024, S, E);
    }
    SEAM_OV(8, {
            const int ntiles_ = (int)MISC[16]; const int x_ = F.bid & 7, j_ = F.bid >> 3, per_ = F.G >> 5, chunk_ = (ntiles_ + 7) >> 3, ltm_ = (chunk_ / per_) * per_;
            int tx_ = ntiles_ - x_ * chunk_; tx_ = tx_ < 0 ? 0 : (tx_ > chunk_ ? chunk_ : tx_);
            const int tail0_ = ltm_ < tx_ ? ltm_ : tx_; const int P_ = 4 * (tx_ - tail0_), U_ = 4 * tx_;
            const int tot_ = U_ + P_, E2_ = tot_ >> 5, rem_ = tot_ & 31, A2_ = 32 - rem_;
            const int sA_ = P_ < A2_ ? P_ : A2_, sB_ = P_ < A2_ ? A2_ : P_;
            const int quota_ = E2_ - 1 + (j_ >= sA_ ? 1 : 0) + (j_ >= sB_ ? 1 : 0);
            pg8::MoeRounds S_; S_.tile0 = x_ * chunk_; S_.j = j_; S_.E = E2_; S_.sA = sA_; S_.sB = sB_;
            const LAS int* tile_e_ = (const LAS int*)(F.lds + TILE_E_OFF); const LAS int* ecnt_ = PSTART + 40;
            LAS v2u* PRE_ = (LAS v2u*)(F.lds + LDSCTL_OFF + 4096); LAS int* PRE_TILE_ = (LAS int*)(F.lds + LDSCTL_OFF + 3968);
            const int npre_ = quota_ < 6 ? quota_ : 6; const int* eslot_ = (const int*)(args.ws + WS_ESLOT); const float* ew_ = (const float*)(args.ws + WS_EW); const int t1 = F.tid - 64;
            for (int q = t1; q < npre_ * 256; q += 448) { const int r = q >> 8, row = q & 255; const int aux = tile_e_[S_.tile0 + S_.lt_of(r)]; const int e = aux & 255, idx = (aux >> 8) * 256 + row; const bool ok = idx < ecnt_[e];
                v2u pv; pv.x = ok ? (unsigned)eslot_[e * 65536 + idx] : (unsigned)(65536 + (idx & 255)); pv.y = ok ? __float_as_uint(ew_[e * 65536 + idx]) : 0u; PRE_[q] = pv; }
            if (t1 < 8) PRE_TILE_[t1] = t1 < npre_ ? S_.tile0 + S_.lt_of(t1) : -1; });
    if (IN(9)) {
        const int ntiles = IN(8) ? (int)MISC[16] : moe_layout(F, PSTART);
        const int x = F.bid & 7, j = F.bid >> 3, per = F.G >> 5, chunk = (ntiles + 7) >> 3, lt_main = (chunk / per) * per;
        int tiles_x = ntiles - x * chunk; tiles_x = tiles_x < 0 ? 0 : (tiles_x > chunk ? chunk : tiles_x);
        const int tail0 = lt_main < tiles_x ? lt_main : tiles_x; const int P = 4 * (tiles_x - tail0), U = 4 * tiles_x;
        const LAS int* tile_e = (const LAS int*)(F.lds + TILE_E_OFF);
        if (j < P) {
            pg8::MoeUnits<true> S; S.A = (const char*)HB; S.W = (const char*)(args.ws + WS_WG1); S.eslot = (const int*)(args.ws + WS_ESLOT); S.tile_e = tile_e; S.ecnt = PSTART + 40;
            S.tile0 = x * chunk; S.u_lo = 4 * tail0 + j; S.u_hi = S.u_lo + 1; S.lda = 1024; S.ldb = 1024;
            pg8::EpiMoe1T<true> E{HID};
            pg8::gemm_phase<pg8::EpiMoe1T<true>, pg8::MoeUnits<true>, true>(F.lds, 1024, 1024, 1024, S, E);
            if (F.tid == 0) __hip_atomic_fetch_add(ctl + CW_TAILCNT + x * chunk + tail0 + (j >> 2), 1u, RLX_AGENT);
        }
        const int tot = U + P, E_ = tot >> 5, rem = tot & 31, A_ = 32 - rem;
        const int sA = P < A_ ? P : A_, sB = P < A_ ? A_ : P;
        const int quota = E_ - 1 + (j >= sA ? 1 : 0) + (j >= sB ? 1 : 0);
        pg8::MoeRounds S; S.A = (const char*)HID; S.W = (const char*)(args.ws + WS_WD); S.tile_e = tile_e; S.ecnt = PSTART + 40; S.tile0 = x * chunk; S.j = j; S.E = E_; S.sA = sA; S.sB = sB; S.lda = 512; S.ldb = 512;
        int r_split = quota; for (int r = quota - 1; r >= 0; --r) if (S.lt_of(r) >= tail0) r_split = r;
        LAS v2u* PRE = (LAS v2u*)(F.lds + LDSCTL_OFF + 4096); LAS int* PRE_TILE = (LAS int*)(F.lds + LDSCTL_OFF + 3968);
        if (!IN(8)) {
            const int npre = quota < 6 ? quota : 6; const int* eslot_ = (const int*)(args.ws + WS_ESLOT); const float* ew_ = (const float*)(args.ws + WS_EW); const LAS int* ecnt_ = PSTART + 40;
            for (int q = F.tid; q < npre * 256; q += NWAVES * 64) { const int r = q >> 8, row = q & 255; const int aux = tile_e[S.tile0 + S.lt_of(r)]; const int e = aux & 255, idx = (aux >> 8) * 256 + row; const bool ok = idx < ecnt_[e];
                v2u pv; pv.x = ok ? (unsigned)eslot_[e * 65536 + idx] : (unsigned)(65536 + (idx & 255)); pv.y = ok ? __float_as_uint(ew_[e * 65536 + idx]) : 0u; PRE[q] = pv; }
            if (F.tid < 8) PRE_TILE[F.tid] = F.tid < npre ? S.tile0 + S.lt_of(F.tid) : -1;
            __syncthreads(); }
        pg8::EpiMoe2 E{(const int*)(args.ws + WS_ESLOT), (const float*)(args.ws + WS_EW), PSTART + 40, Y2, PRE, PRE_TILE};
        S.r_lo = 0; S.r_hi = r_split;
        pg8::gemm_phase<pg8::EpiMoe2, pg8::MoeRounds, true>(F.lds, 512, 512, 512, S, E);
        if (quota > r_split) {
            if (F.tid == 0) {
                for (int r = r_split; r < quota; ++r) { gu32* cw = ctl + CW_TAILCNT + x * chunk + S.lt_of(r); unsigned sp = 0;
                    while (__hip_atomic_load(cw, RLX_AGENT) < 4u) { __builtin_amdgcn_s_sleep(2); if (++sp > (1u << 22)) break; } }
                __builtin_amdgcn_fence(__ATOMIC_ACQUIRE, "agent"); asm volatile("s_waitcnt vmcnt(0)" ::: "memory");
            }
            __syncthreads();
            S.r_lo = r_split; S.r_hi = quota;
            pg8::gemm_phase<pg8::EpiMoe2, pg8::MoeRounds, true>(F.lds, 512, 512, 512, S, E);
        }
    }
    SEAM_OV(9, {
            LAS float* GL2 = (LAS float*)F.lds; const float* g2_ = (const float*)args.in[25]; const float* b2_ = (const float*)args.in[26];
            for (int q = F.tid - 64; q < 1024; q += 448) { GL2[q] = g2_[q]; GL2[1024 + q] = b2_[q]; } });
    if (IN(10)) {
        const int gw = F.bid * NWAVES + F.wave, NGW = F.G * NWAVES;
        const float* g2 = (const float*)args.in[25]; const float* b2 = (const float*)args.in[26];
        f32x4 gg[4], bb[4];
#pragma unroll
        for (int j = 0; j < 2; ++j)
#pragma unroll
            for (int k = 0; k < 2; ++k) { gg[2 * j + k] = *((const LAS f32x4*)F.lds + (64 * j + F.lane) * 2 + k); bb[2 * j + k] = *((const LAS f32x4*)(F.lds + 4096) + (64 * j + F.lane) * 2 + k); }
        for (int m = gw; m < TOK; m += NGW) {
            const GAS v4u* hr = (const GAS v4u*)(HB + (size_t)m * DM) + F.lane; const GAS v4u* y0 = (const GAS v4u*)(Y2 + (size_t)(2 * m) * DM) + F.lane; const GAS v4u* y1 = (const GAS v4u*)(Y2 + (size_t)(2 * m + 1) * DM) + F.lane;
            f32x4 v[4]; float s = 0.f;
#pragma unroll
            for (int j = 0; j < 2; ++j) { const v4u a = __builtin_nontemporal_load(hr + 64 * j), b = __builtin_nontemporal_load(y0 + 64 * j), c = __builtin_nontemporal_load(y1 + 64 * j);
                v[2 * j][0] = ALPHA * bf_lo(a.x) + bf_lo(b.x) + bf_lo(c.x); v[2 * j][1] = ALPHA * bf_hi(a.x) + bf_hi(b.x) + bf_hi(c.x);
                v[2 * j][2] = ALPHA * bf_lo(a.y) + bf_lo(b.y) + bf_lo(c.y); v[2 * j][3] = ALPHA * bf_hi(a.y) + bf_hi(b.y) + bf_hi(c.y);
                v[2 * j + 1][0] = ALPHA * bf_lo(a.z) + bf_lo(b.z) + bf_lo(c.z); v[2 * j + 1][1] = ALPHA * bf_hi(a.z) + bf_hi(b.z) + bf_hi(c.z);
                v[2 * j + 1][2] = ALPHA * bf_lo(a.w) + bf_lo(b.w) + bf_lo(c.w); v[2 * j + 1][3] = ALPHA * bf_hi(a.w) + bf_hi(b.w) + bf_hi(c.w);
                s += ((v[2 * j][0] + v[2 * j][1]) + (v[2 * j][2] + v[2 * j][3])) + ((v[2 * j + 1][0] + v[2 * j + 1][1]) + (v[2 * j + 1][2] + v[2 * j + 1][3])); }
            const float mean = wave_sum(s) * (1.f / DM); float s2 = 0.f;
#pragma unroll
            for (int j = 0; j < 4; ++j) { v[j] = v[j] - mean; s2 += (v[j][0] * v[j][0] + v[j][1] * v[j][1]) + (v[j][2] * v[j][2] + v[j][3] * v[j][3]); }
            const float rstd = 1.f / sqrtf(wave_sum(s2) * (1.f / DM) + LN_EPS);
            GAS f32x4* o = (GAS f32x4*)(args.out + (size_t)m * DM);
#pragma unroll
            for (int j = 0; j < 2; ++j)
#pragma unroll
                for (int k = 0; k < 2; ++k) __builtin_nontemporal_store(v[2 * j + k] * rstd * gg[2 * j + k] + bb[2 * j + k], o + (64 * j + F.lane) * 2 + k);
        }
    }
#undef IN
#undef SEAM
}

extern "C" void kernel_launch(void* const* d_in, const int* in_sizes, int n_in, void* d_out, int out_size, void* d_ws, size_t ws_size, hipStream_t stream) {
    static int grid = 0;
    if (grid == 0) {
        if (n_in != 27 || in_sizes[0] != TOK * DM || out_size != TOK * DM || ws_size < WS_END) { fprintf(stderr, "kernel_launch: unexpected shapes (n_in %d, in0 %d, out %d, ws %zu); nothing launched\n", n_in, n_in > 0 ? in_sizes[0] : -1, out_size, ws_size); grid = -1; return; }
        int dev = 0, cus = 0, per_cu = 0;
        if (hipGetDevice(&dev) != hipSuccess || hipDeviceGetAttribute(&cus, hipDeviceAttributeMultiprocessorCount, dev) != hipSuccess) { fprintf(stderr, "kernel_launch: device query failed\n"); grid = -1; return; }
        if (hipFuncSetAttribute((const void*)trunk_fwd, hipFuncAttributeMaxDynamicSharedMemorySize, LDS_BYTES) != hipSuccess) { fprintf(stderr, "kernel_launch: hipFuncSetAttribute failed\n"); grid = -1; return; }
        if (hipOccupancyMaxActiveBlocksPerMultiprocessor(&per_cu, (const void*)trunk_fwd, NWAVES * 64, LDS_BYTES) != hipSuccess || per_cu < 1) { fprintf(stderr, "kernel_launch: occupancy query reports %d blocks per CU\n", per_cu); per_cu = 1; }
        (void)hipGetLastError();
        grid = cus > 256 ? 256 : cus;
        if (grid != 256) fprintf(stderr, "kernel_launch: note: %d CUs (kernel tuned for 256)\n", grid);
    }
    if (grid < 0) return;
    (void)hipMemsetAsync((char*)d_ws + WS_CTL, 0, CTL_ZERO_BYTES, stream);
    Args a{};
    for (int i = 0; i < 27; ++i) a.in[i] = d_in[i];
    a.out = (float*)d_out; a.ws = (unsigned char*)d_ws;
    if (PROBE_DUP >= 0) { a.ph_lo = 0; a.ph_hi = PROBE_DUP + 1; a.li = 0; hipLaunchKernelGGL(trunk_fwd, dim3(grid), dim3(NWAVES * 64), LDS_BYTES, stream, a);
        a.ph_lo = PROBE_DUP; a.ph_hi = NPHASES; a.li = 1; hipLaunchKernelGGL(trunk_fwd, dim3(grid), dim3(NWAVES * 64), LDS_BYTES, stream, a); }
    else if (MK_N_LAUNCHES == 1) { a.ph_lo = 0; a.ph_hi = NPHASES; hipLaunchKernelGGL(trunk_fwd, dim3(grid), dim3(NWAVES * 64), LDS_BYTES, stream, a); }
    else { for (int p = 0; p < NPHASES; ++p) { a.ph_lo = p; a.ph_hi = p + 1; hipLaunchKernelGGL(trunk_fwd, dim3(grid), dim3(NWAVES * 64), LDS_BYTES, stream, a); } }
}
```
